# Optimizing an MI355X kernel written in HIP

```python
import jax, jax.numpy as jnp
from jax import lax
import numpy as np

D_MODEL = 2048
BATCH = 4
SEQ = 2048
DEPTH = 1
DEC_BATCH = 128
DEC_SEQ = 8
PAST_LEN = 16384
PAGE_SIZE = 128

E_A = D_MODEL // 2
HA = 4
DA = E_A // HA
CHUNK = 128
HB = 4
E_B = D_MODEL // 2
DV = E_B // HB
DK = DV // 2
K_B = HB * DK
GATE_RANK = 16
GATE_TAU = 16.0
GLA_CHUNK = 16
PLE_DIM = 256
EPS = 1e-6
SPLIT_SIZES = (E_A, E_A, E_A, K_B, K_B, E_B, E_B, GATE_RANK, D_MODEL, D_MODEL)
N_IN = sum(SPLIT_SIZES)

kernel_name = "hybrid_gmlp_gla_gated_merge_step"


def rms_norm(x, g):
    xf = x.astype(jnp.float32)
    y = xf * lax.rsqrt(jnp.mean(xf * xf, axis=-1, keepdims=True) + EPS)
    return (y * g.astype(jnp.float32)).astype(x.dtype)


def split_cols(t):
    outs, off = [], 0
    for s in SPLIT_SIZES:
        outs.append(t[..., off:off + s])
        off += s
    return outs


def chunk_spatial_gate(u, v, w_s, b_s):
    B, L, _ = v.shape
    n_c = -(-L // CHUNK)
    pad = n_c * CHUNK - L
    vp = jnp.pad(v, ((0, 0), (0, pad), (0, 0))).reshape(B, n_c, CHUNK, HA, DA)
    mask = jnp.tril(jnp.ones((CHUNK, CHUNK), dtype=bool))
    w = jnp.where(mask[None], w_s, jnp.zeros((), w_s.dtype))
    s = jnp.einsum('gts,bcsgd->bctgd', w, vp) + b_s.T[None, None, :, :, None]
    s = s.reshape(B, n_c * CHUNK, E_A)[:, :L]
    return u * s


def gla(q, k, v, log_a, s0):
    B, L = q.shape[:2]
    n_c = -(-L // GLA_CHUNK)
    pad = n_c * GLA_CHUNK - L

    def blocks(t):
        t = jnp.pad(t, ((0, 0), (0, pad), (0, 0), (0, 0)))
        return t.reshape(B, n_c, GLA_CHUNK, HB, t.shape[-1]).transpose(1, 0, 3, 2, 4)

    qc, kc, vc, ac = blocks(q), blocks(k), blocks(v), blocks(log_a)
    mask = jnp.tril(jnp.ones((GLA_CHUNK, GLA_CHUNK), dtype=bool))

    def step(S, inp):
        qb, kb, vb, ab = inp
        qb = qb.astype(jnp.float32)
        kb = kb.astype(jnp.float32)
        vb = vb.astype(jnp.float32)
        b = jnp.cumsum(ab.astype(jnp.float32), axis=-2)
        q_t = qb * jnp.exp(b)
        k_t = kb * jnp.exp(-b)
        att = jnp.where(mask, jnp.einsum('bhtd,bhsd->bhts', q_t, k_t), 0.0)
        o = jnp.einsum('bhts,bhsv->bhtv', att, vb) + jnp.einsum('bhtd,bhdv->bhtv', q_t, S)
        b_last = b[..., -1:, :]
        k_d = kb * jnp.exp(b_last - b)
        S = jnp.exp(b_last[..., 0, :])[..., None] * S + jnp.einsum('bhsd,bhsv->bhdv', k_d, vb)
        return S, o

    S, o = lax.scan(step, s0.astype(jnp.float32), (qc, kc, vc, ac))
    o = o.transpose(1, 0, 3, 2, 4).reshape(B, n_c * GLA_CHUNK, HB, DV)[:, :L]
    return o.astype(v.dtype), S.astype(s0.dtype)


def layer(x, p, s0, g_pre, w_in, g_v, w_s, b_s, w_a2, b_a, g_o, w_pa, w_pb, w_o, g_post, w_pg, w_pe):
    B, L, _ = x.shape
    xn = rms_norm(x, g_pre)
    u_a, v_a, z_a, q_b, k_b, v_b, z_b, a_lr, m_a, m_b = split_cols(xn @ w_in)
    v_a = rms_norm(v_a, g_v)
    y_a = chunk_spatial_gate(u_a, v_a, w_s, b_s) * jax.nn.silu(z_a)
    log_a = jax.nn.log_sigmoid((a_lr @ w_a2 + b_a).astype(jnp.float32)) / GATE_TAU
    q = q_b.reshape(B, L, HB, DK) * (DK ** -0.5)
    k = k_b.reshape(B, L, HB, DK)
    v = v_b.reshape(B, L, HB, DV)
    o, s_new = gla(q, k, v, log_a.reshape(B, L, HB, DK), s0)
    y_b = rms_norm(o, g_o).reshape(B, L, E_B) * jax.nn.silu(z_b)
    m = jax.nn.sigmoid(m_a) * (y_a @ w_pa) + jax.nn.sigmoid(m_b) * (y_b @ w_pb)
    h = x + rms_norm(m @ w_o, g_post)
    h = h + jax.nn.sigmoid(h @ w_pg) * (p @ w_pe)
    return h, s_new, v_a


def setup_inputs(seed: int = 0) -> dict:
    key = jax.random.key(seed)
    ks = jax.random.split(key, 20)
    f32 = jnp.float32
    nrm = lambda k, shape, scale: jax.random.normal(k, shape, f32) * scale
    return {
        "x_prompt": nrm(ks[0], (BATCH, SEQ, D_MODEL), 1.0),
        "x_sample": nrm(ks[1], (DEC_BATCH, DEC_SEQ, D_MODEL), 1.0),
        "p_prompt": nrm(ks[2], (DEPTH, BATCH, SEQ, PLE_DIM), 1.0),
        "p_sample": nrm(ks[3], (DEPTH, DEC_BATCH, DEC_SEQ, PLE_DIM), 1.0),
        "state_gla": nrm(ks[4], (DEPTH, DEC_BATCH, HB, DK, DV), 0.5),
        "g_pre": 1.0 + nrm(ks[5], (DEPTH, D_MODEL), 0.05),
        "w_in": nrm(ks[6], (DEPTH, D_MODEL, N_IN), D_MODEL ** -0.5),
        "g_v": 1.0 + nrm(ks[7], (DEPTH, E_A), 0.05),
        "w_s": nrm(ks[8], (DEPTH, HA, CHUNK, CHUNK), CHUNK ** -0.5),
        "b_s": 1.0 + nrm(ks[9], (DEPTH, HA, CHUNK), 0.1),
        "w_a2": nrm(ks[10], (DEPTH, GATE_RANK, K_B), GATE_RANK ** -0.5),
        "b_a": nrm(ks[11], (DEPTH, K_B), 0.1),
        "g_o": 1.0 + nrm(ks[12], (DEPTH, HB, DV), 0.05),
        "w_pa": nrm(ks[13], (DEPTH, E_A, D_MODEL), E_A ** -0.5),
        "w_pb": nrm(ks[14], (DEPTH, E_B, D_MODEL), E_B ** -0.5),
        "w_o": nrm(ks[15], (DEPTH, D_MODEL, D_MODEL), D_MODEL ** -0.5),
        "g_post": 1.0 + nrm(ks[16], (DEPTH, D_MODEL), 0.05),
        "w_pg": nrm(ks[17], (DEPTH, D_MODEL, D_MODEL), D_MODEL ** -0.5),
        "w_pe": nrm(ks[18], (DEPTH, PLE_DIM, D_MODEL), PLE_DIM ** -0.5),
    }


def reference(x_prompt, x_sample, p_prompt, p_sample, state_gla, g_pre, w_in, g_v, w_s, b_s,
              w_a2, b_a, g_o, w_pa, w_pb, w_o, g_post, w_pg, w_pe):
    hp, hs = x_prompt, x_sample
    sp_list, ss_list, cv_list = [], [], []
    for i in range(DEPTH):
        wts = (g_pre[i], w_in[i], g_v[i], w_s[i], b_s[i], w_a2[i], b_a[i], g_o[i],
               w_pa[i], w_pb[i], w_o[i], g_post[i], w_pg[i], w_pe[i])
        s0_prompt = jnp.zeros((hp.shape[0], HB, DK, DV), hp.dtype)
        hp, s_p, _ = layer(hp, p_prompt[i], s0_prompt, *wts)
        hs, s_s, v_s = layer(hs, p_sample[i], state_gla[i], *wts)
        sp_list.append(s_p)
        ss_list.append(s_s)
        cv_list.append(v_s)
    state_gla_prompt = jnp.stack(sp_list)
    state_gla_sample = jnp.stack(ss_list)
    chunk_v_sample = jnp.stack(cv_list)
    return (hp, hs, state_gla_prompt, state_gla_sample, chunk_v_sample)
```

```cpp
#include <hip/hip_runtime.h>
#include <cstdio>
#include <cstdint>

#ifndef MK_N_LAUNCHES
#define MK_N_LAUNCHES 1
#endif

namespace pg8 {
#define PG8_LAS __attribute__((address_space(3)))
typedef unsigned short bf16_t;
typedef short bf16x8 __attribute__((ext_vector_type(8)));
typedef float f32x4 __attribute__((ext_vector_type(4)));
typedef unsigned u32x4 __attribute__((ext_vector_type(4)));
typedef unsigned u32x2 __attribute__((ext_vector_type(2)));
constexpr int BM = 256, BK = 64, HALF = 128, HTB = HALF * BK * 2, STAGE_BYTES = 8 * HTB, NXCD = 8, WGM = 12;

__host__ __device__ __forceinline__ int lds_byte(int r, int c) { const int st = (r >> 4) * 2 + (c >> 5), rr = r & 15, cc = c & 31, ob = rr * 64 + cc * 2; return st * 1024 + (ob ^ (((ob >> 9) & 1) << 5)); }
__host__ __device__ __forceinline__ void stage_rc(int b, int& R, int& C) { const int st = b / 1024, sb = b % 1024, swz = sb ^ (((sb >> 9) & 1) << 5); R = (st >> 1) * 16 + swz / 64; C = (st & 1) * 32 + (swz % 64) / 2; }
__host__ __device__ __forceinline__ int perm32(int rho) { const int n = rho >> 4, i = rho & 15; return 8 * (i >> 2) + 4 * n + (i & 3); }

struct Unit { int pm, pn, kt0, nkt, kind; };
struct Gemm { const bf16_t* A; const bf16_t* Bt; int lda, ldb; };

struct StaticOrder {
    int nM, nN, nwg, G, c, nkt;
    __host__ __device__ void init(int M, int N, int K, int G_, int c_) { nM = M / BM; nN = N / BM; nwg = nM * nN; G = G_; c = c_; nkt = K / BK; }
    __host__ __device__ bool next(int i, Unit& u) const {
        const long L = (long)i * G + c; if (L >= nwg) return false;
        int wgid = (int)L; { const int q = nwg / NXCD, r = nwg % NXCD, xcd = wgid % NXCD, off = wgid / NXCD; wgid = (xcd < r ? xcd * (q + 1) : r * (q + 1) + (xcd - r) * q) + off; }
        const int nig = WGM * nN, gid = wgid / nig, fm = gid * WGM, gsz = (nM - fm) < WGM ? (nM - fm) : WGM;
        u.pm = fm + ((wgid % nig) % gsz); u.pn = (wgid % nig) / gsz; u.kt0 = 0; u.nkt = nkt; u.kind = 0; return true;
    }
};
struct TailOrder {
    int G, c, swap;
    __host__ __device__ bool next(int i, Unit& u) const {
        long L = (long)i * G + c; if (swap && G == 256 && i < 2) L = (long)(1 - i) * G + c;
        if (L < 256) { const int x = (int)L & 7, kk = (int)L >> 3; u.pm = 4 * x + (kk >> 3); u.pn = kk & 7; u.kt0 = 0; u.nkt = 32; u.kind = 0; return true; }
        if (L < 512) { const int l2 = (int)L - 256, x = l2 & 7, kk = l2 >> 3; u.pm = 32 + (kk >> 3); u.pn = kk & 7; u.kt0 = 4 * x; u.nkt = 4; u.kind = 1; return true; }
        return false;
    }
};
struct EPromptOrder {
    int G, c;
    __host__ __device__ bool next(int i, Unit& u) const {
        const long L = (long)i * G + c; if (L >= 256) return false;
        const int x = (int)L & 7, kk = (int)L >> 3; u.pm = 4 * x + (kk >> 3); u.pn = kk & 7; u.kt0 = 0; u.nkt = 4; u.kind = 0; return true; }
};
struct ESampleOrder {
    int G2, c2;
    __host__ __device__ bool next(int i, Unit& u) const {
        if (c2 < 0 || G2 <= 0) return false; const long L = (long)i * G2 + c2; if (L >= 32) return false;
        u.pm = 32 + ((int)L >> 3); u.pn = (int)L & 7; u.kt0 = 0; u.nkt = 4; u.kind = 0; return true; }
};

typedef __bf16 bf2_t __attribute__((ext_vector_type(2)));
typedef float f2_t __attribute__((ext_vector_type(2)));
__device__ __forceinline__ unsigned cvt_pk_bf16(float lo, float hi) { return __builtin_bit_cast(unsigned, __builtin_convertvector((f2_t){lo, hi}, bf2_t)); }

template <class Epi, class Sched>
__device__ __forceinline__ void gemm_phase(PG8_LAS unsigned char* lds, const Gemm g, const Sched& S, const Epi& E) {
    const int tid = threadIdx.x, wid = __builtin_amdgcn_readfirstlane(tid >> 6), lane = tid & 63, wr = wid >> 2, wc = wid & 3, fr = lane & 15, fq = lane >> 4;
    unsigned voffA[2], voffB[2];
#pragma unroll
    for (int i = 0; i < 2; ++i) { int R, C; stage_rc(tid * 16 + i * 8192, R, C); const int Rb = Epi::PERM ? ((R & ~31) + perm32(R & 31)) : R;
        voffA[i] = (unsigned)(R * g.lda + C) * 2u; voffB[i] = (unsigned)(Rb * g.ldb + C) * 2u; }
    const size_t kstep = (size_t)(BK * 2);
    const size_t hstepA = (size_t)HALF * g.lda * 2, hstepB = (size_t)HALF * g.ldb * 2;
    const size_t tstepA = 2 * hstepA, tstepB = 2 * hstepB;
    const unsigned ldsw = (unsigned)wid * 1024u;
    const int aoff = lds_byte(wr * 64 + fr, fq * 8), boff = lds_byte(wc * 32 + fr, fq * 8);
#define PG8_SA(b, h) (((b) * 2 + (h)) * HTB)
#define PG8_SB(b, h) ((4 + (b) * 2 + (h)) * HTB)
#define PG8_STAGE(bufoff, gbase, voff) do { _Pragma("unroll") for (int _i = 0; _i < 2; ++_i) \
        __builtin_amdgcn_global_load_lds((const unsigned*)((const char*)(gbase) + (voff)[_i]), (PG8_LAS unsigned*)(lds + (bufoff) + ldsw + _i * 8192), 16, 0, 0); } while (0)
#define PG8_LDA(dst, b, h) do { _Pragma("unroll") for (int m = 0; m < 4; ++m) _Pragma("unroll") for (int k = 0; k < 2; ++k) dst[m][k] = *(const PG8_LAS bf16x8*)(lds + PG8_SA(b, h) + aoff + m * 2048 + k * 1024); } while (0)
#define PG8_LDB(dst, b, h) do { _Pragma("unroll") for (int n = 0; n < 2; ++n) _Pragma("unroll") for (int k = 0; k < 2; ++k) dst[n][k] = *(const PG8_LAS bf16x8*)(lds + PG8_SB(b, h) + boff + n * 2048 + k * 1024); } while (0)
#define PG8_MMA(ai, bj, At, Bt) do { __builtin_amdgcn_s_setprio(1); _Pragma("unroll") for (int m = 0; m < 4; ++m) _Pragma("unroll") for (int n = 0; n < 2; ++n) _Pragma("unroll") for (int k = 0; k < 2; ++k) \
        acc[ai][bj][m][n] = __builtin_amdgcn_mfma_f32_16x16x32_bf16(Bt[n][k], At[m][k], acc[ai][bj][m][n], 0, 0, 0); __builtin_amdgcn_s_setprio(0); } while (0)
#define PG8_WAIT_V(n) asm volatile("s_waitcnt vmcnt(" #n ")" ::: "memory")
#define PG8_WAIT_L(n) asm volatile("s_waitcnt lgkmcnt(" #n ")" ::: "memory")
#define PG8_BAR __builtin_amdgcn_s_barrier()
#define PG8_SCHED __builtin_amdgcn_sched_barrier(0)
    Unit cur, nxt; int ui = 0;
    if (!S.next(0, cur)) return;
    f32x4 acc[2][2][4][2];
#pragma unroll
    for (int a = 0; a < 2; ++a)
#pragma unroll
        for (int b = 0; b < 2; ++b)
#pragma unroll
            for (int m = 0; m < 4; ++m)
#pragma unroll
                for (int n = 0; n < 2; ++n) acc[a][b][m][n] = (f32x4){0.f, 0.f, 0.f, 0.f};
    bf16x8 At[4][2], B0[2][2], B1[2][2];
    const char* cA = (const char*)g.A + (size_t)cur.pm * tstepA + (size_t)cur.kt0 * kstep; const char* cB = (const char*)g.Bt + (size_t)cur.pn * tstepB + (size_t)cur.kt0 * kstep;
    int nt = cur.nkt; asm volatile("" : "+s"(nt));
    PG8_STAGE(PG8_SB(0, 0), cB, voffB); PG8_STAGE(PG8_SB(0, 1), cB + hstepB, voffB); PG8_STAGE(PG8_SA(0, 0), cA, voffA); PG8_STAGE(PG8_SA(0, 1), cA + hstepA, voffA);
    if (wr == 1) PG8_BAR;
    PG8_WAIT_V(2); PG8_BAR;
    PG8_STAGE(PG8_SB(1, 0), cB + kstep, voffB); PG8_STAGE(PG8_SA(1, 0), cA + kstep, voffA); PG8_STAGE(PG8_SB(1, 1), cB + hstepB + kstep, voffB);
    PG8_WAIT_V(6); PG8_BAR;
    for (;;) {
        const bool has_next = S.next(ui + 1, nxt);
        const char* nA = has_next ? (const char*)g.A + (size_t)nxt.pm * tstepA + (size_t)nxt.kt0 * kstep : cA; const char* nB = has_next ? (const char*)g.Bt + (size_t)nxt.pn * tstepB + (size_t)nxt.kt0 * kstep : cB;
        for (int t = 0; t < nt; t += 2) {
            const bool last = (t == nt - 2);
            const char* a1 = cA + (size_t)(t + 1) * kstep;
            const char* a2 = last ? nA : cA + (size_t)(t + 2) * kstep; const char* b2 = last ? nB : cB + (size_t)(t + 2) * kstep;
            const char* a3 = a2 + kstep; const char* b3 = b2 + kstep;
            if constexpr (Epi::HAS_MID) { if (cur.kind == 0 && t == (nt >> 1)) E.mid(acc, cur, wr, wc, fr, fq); }
            PG8_LDB(B0, 0, 0); PG8_LDB(B1, 0, 1); PG8_SCHED; PG8_LDA(At, 0, 0); PG8_STAGE(PG8_SA(1, 1), a1 + hstepA, voffA);
            PG8_WAIT_V(8); PG8_WAIT_L(0); PG8_BAR; PG8_MMA(0, 0, At, B0); PG8_MMA(0, 1, At, B1); PG8_BAR; PG8_SCHED;
            PG8_LDA(At, 0, 1); PG8_STAGE(PG8_SB(0, 0), b2, voffB); PG8_STAGE(PG8_SB(0, 1), b2 + hstepB, voffB); PG8_STAGE(PG8_SA(0, 0), a2, voffA);
            PG8_WAIT_V(8); PG8_WAIT_L(0); PG8_BAR; PG8_MMA(1, 0, At, B0); PG8_MMA(1, 1, At, B1); PG8_BAR; PG8_SCHED;
            PG8_LDB(B0, 1, 0); PG8_LDB(B1, 1, 1); PG8_SCHED; PG8_LDA(At, 1, 0); PG8_STAGE(PG8_SA(0, 1), a2 + hstepA, voffA);
            PG8_WAIT_V(8); PG8_WAIT_L(0); PG8_BAR; PG8_MMA(0, 0, At, B0); PG8_MMA(0, 1, At, B1); PG8_BAR; PG8_SCHED;
            PG8_LDA(At, 1, 1); PG8_STAGE(PG8_SB(1, 0), b3, voffB); PG8_STAGE(PG8_SB(1, 1), b3 + hstepB, voffB); PG8_STAGE(PG8_SA(1, 0), a3, voffA);
            PG8_WAIT_V(8); PG8_WAIT_L(0); PG8_BAR; PG8_MMA(1, 0, At, B0); PG8_MMA(1, 1, At, B1); PG8_BAR; PG8_SCHED;
        }
        if (wr == 0) PG8_BAR;
        E(acc, cur, wr, wc, fr, fq);
        if (!has_next) break;
#pragma unroll
        for (int a = 0; a < 2; ++a)
#pragma unroll
            for (int b = 0; b < 2; ++b)
#pragma unroll
                for (int m = 0; m < 4; ++m)
#pragma unroll
                    for (int n = 0; n < 2; ++n) acc[a][b][m][n] = (f32x4){0.f, 0.f, 0.f, 0.f};
        cur = nxt; cA = nA; cB = nB; ++ui; nt = cur.nkt; asm volatile("" : "+s"(nt));
        if (wr == 1) PG8_BAR;
    }
    PG8_WAIT_V(0);
    PG8_BAR;
#undef PG8_SA
#undef PG8_SB
#undef PG8_STAGE
#undef PG8_LDA
#undef PG8_LDB
#undef PG8_MMA
#undef PG8_WAIT_V
#undef PG8_WAIT_L
#undef PG8_BAR
#undef PG8_SCHED
}
}

constexpr int NWAVES = 8, NTHR = 512;
constexpr int DM = 2048, MP = 8192, MS = 1024, MT = 9216, SEQ = 2048, NBAT = 4, DBAT = 128, DSEQ = 8;
constexpr int EA = 1024, KBW = 512, EB = 1024, NIN = 10256, N1 = 10752, PLE = 256;
constexpr int HB = 4, DK = 128, DV = 256, GR = 16, CH = 128, GC = 64  , NCH = SEQ / GC;
constexpr float EPS = 1e-6f;
constexpr int C_ALR = 6144, C_MA = 6160;

constexpr size_t OUT_Y = 0, OUT_SP = (size_t)MT * DM, OUT_SS = OUT_SP + (size_t)NBAT * HB * DK * DV, OUT_CV = OUT_SS + (size_t)DBAT * HB * DK * DV;

constexpr size_t MiB = 1u << 20;
constexpr size_t WS_CTL = 0, CTL_ZERO_BYTES = 64 * 1024;
constexpr size_t WS_WPE = 1 * MiB, WS_WPAB = 2 * MiB, WS_WO = 10 * MiB, WS_WPG = 18 * MiB, WS_PBF = 26 * MiB;
constexpr size_t WS_VSS = 30 * MiB + 512 * 1024;
constexpr size_t WS_TSS = WS_VSS + (size_t)MT * 16 * 4;
constexpr size_t WS_RSTD = WS_TSS + (size_t)MT * 32 * 4;
constexpr size_t WS_DEC = 33 * MiB;
constexpr size_t WS_W1T = 34 * MiB;
constexpr size_t WS_QT = 34 * MiB, WS_ATT = 42 * MiB, WS_KTT = 50 * MiB;
constexpr size_t WS_E = 34 * MiB;
constexpr size_t WS_XN = 76 * MiB, WS_Y = 76 * MiB;
constexpr size_t WS_U = 112 * MiB  , WS_V = 130 * MiB, WS_Q = 166 * MiB, WS_KB = 175 * MiB, WS_VB = 184 * MiB, WS_SZB = 202 * MiB, WS_GA = 220 * MiB, WS_GB = 256 * MiB;
constexpr size_t WS_LA = 292 * MiB;
constexpr size_t WS_O = 58 * MiB;
constexpr size_t WS_SLABA = 112 * MiB;
constexpr size_t WS_M = 148 * MiB;
constexpr size_t WS_T = 184 * MiB;
constexpr size_t WS_H = 112 * MiB;
constexpr size_t WS_ES = 312 * MiB;
constexpr size_t WS_END = 316 * MiB;
static_assert(WS_RSTD + (size_t)MT * 4 <= WS_DEC && WS_DEC + 16 * 32 * 128 * 4 <= WS_W1T && WS_W1T + (size_t)N1 * 2048 * 2 <= WS_XN, "ws map");
constexpr int CW_GRP = 8192;
constexpr int CW_PAN = 9216;
constexpr int CW_BAR = 4096;

constexpr int LDS_BYTES = 155648;
constexpr int MISC_OFF = LDS_BYTES - 256;

#define GAS __attribute__((address_space(1)))
#define LAS __attribute__((address_space(3)))
typedef unsigned short bf16;
typedef unsigned v4u __attribute__((ext_vector_type(4)));
typedef unsigned v2u __attribute__((ext_vector_type(2)));
typedef float f32x4 __attribute__((ext_vector_type(4)));
typedef short bf16x8 __attribute__((ext_vector_type(8)));
typedef GAS unsigned gu32;
#define RLX_AGENT __ATOMIC_RELAXED, __HIP_MEMORY_SCOPE_AGENT
__device__ __forceinline__ unsigned pk2(float lo, float hi) { return pg8::cvt_pk_bf16(lo, hi); }
__device__ __forceinline__ unsigned f2bf(float f) { return pg8::cvt_pk_bf16(f, 0.f) & 0xffffu; }
__device__ __forceinline__ float bflo(unsigned w) { return __uint_as_float(w << 16); }
__device__ __forceinline__ float bfhi(unsigned w) { return __uint_as_float(w & 0xffff0000u); }
__device__ __forceinline__ float bf2f(bf16 h) { return __uint_as_float((unsigned)h << 16); }
__device__ __forceinline__ float sigm(float x) { return __builtin_amdgcn_rcpf(1.f + __expf(-x)); }
__device__ __forceinline__ float wave_sum(float v) {
#pragma unroll
    for (int o = 1; o < 64; o <<= 1) v += __shfl_xor(v, o);
    return v;
}

#define XB_TMO      128
#define XB_XCNT(j)  (256  + 64 * (j))
#define XB_XSUB(j)  (1280 + 64 * (j))
#define XB_XGEN(j)  (2304 + 64 * (j))
#define XB_TOP      3328
#define XB_TOPGEN   3392
#define XCD_BAR_WORDS 3456
#define XB_SPIN_CAP (1u << 18)
__device__ __forceinline__ unsigned xb_ld(unsigned* p)              { return __hip_atomic_load(p, __ATOMIC_RELAXED, __HIP_MEMORY_SCOPE_AGENT); }
__device__ __forceinline__ unsigned xb_add(unsigned* p, unsigned v) { return __hip_atomic_fetch_add(p, v, __ATOMIC_RELAXED, __HIP_MEMORY_SCOPE_AGENT); }
__device__ __forceinline__ unsigned xb_xcc_id() { return (unsigned)__builtin_amdgcn_s_getreg((3 << 11) | 20) & 0xFu; }
#define XB_SPIN(cond, bar) do { unsigned _sp = 0; while (cond) { __builtin_amdgcn_s_sleep(1); \
    if ((++_sp & 255u) == 0u) { if (xb_ld(&(bar)[XB_TMO])) break; if (_sp > XB_SPIN_CAP) { atomicAdd(&(bar)[XB_TMO], 1u); break; } } } } while (0)
struct XcdBarrier { unsigned* bar; unsigned x; volatile LAS unsigned* st; };
__device__ __forceinline__ XcdBarrier xcd_barrier_post(unsigned* bar, volatile LAS unsigned* st) {
    XcdBarrier b; b.bar = bar; b.x = xb_xcc_id(); b.st = st;
    if (threadIdx.x == 0) (void)xb_add(&bar[XB_XCNT(b.x)], 1u);
    return b;
}
__device__ __forceinline__ void xcd_barrier_complete(unsigned* bar, unsigned x, unsigned& nloc, unsigned& nx) {
    const unsigned G = gridDim.x * gridDim.y * gridDim.z;
    unsigned sum, cnt, mine, sp = 0u;
    for (;;) {
        sum = 0u; cnt = 0u; mine = 0u;
#pragma unroll
        for (unsigned j = 0; j < 16; ++j) { const unsigned c = xb_ld(&bar[XB_XCNT(j)]); sum += c; cnt += (c > 0u) ? 1u : 0u; mine = (j == x) ? c : mine; }
        if (sum == G) break;
        __builtin_amdgcn_s_sleep(1);
        if ((++sp & 255u) == 0u) { if (xb_ld(&bar[XB_TMO])) break; if (sp > XB_SPIN_CAP) { atomicAdd(&bar[XB_TMO], 1u); break; } }
    }
    nloc = mine > 0u ? mine : 1u; nx = cnt > 0u ? cnt : 1u;
}
__device__ __forceinline__ void xcd_barrier(const XcdBarrier& b) {
    asm volatile("s_waitcnt vmcnt(0)" ::: "memory");
    __syncthreads();
    if (threadIdx.x == 0) {
        unsigned* bar = b.bar;
        __builtin_amdgcn_s_waitcnt(0);
        unsigned nloc = b.st[0], nx = b.st[1];
        if (nloc == 0u) { xcd_barrier_complete(bar, b.x, nloc, nx); b.st[0] = nloc; b.st[1] = nx; }
        const unsigned old = xb_add(&bar[XB_XSUB(b.x)], 1u);
        const unsigned gen = old / nloc;
        if (old + 1u == (gen + 1u) * nloc) {
            __builtin_amdgcn_fence(__ATOMIC_RELEASE, "agent");
            asm volatile("s_waitcnt vmcnt(0)" ::: "memory");
            const unsigned og = xb_add(&bar[XB_TOP], 1u);
            const unsigned tg = og / nx;
            if (og + 1u == (tg + 1u) * nx) xb_add(&bar[XB_TOPGEN], 1u);
            else XB_SPIN(xb_ld(&bar[XB_TOPGEN]) == tg, bar);
            __builtin_amdgcn_fence(__ATOMIC_ACQUIRE, "agent");
            xb_add(&bar[XB_XGEN(b.x)], 1u);
            asm volatile("s_waitcnt vmcnt(0)" ::: "memory");
        } else {
            XB_SPIN(xb_ld(&bar[XB_XGEN(b.x)]) == gen, bar);
            __builtin_amdgcn_fence(__ATOMIC_ACQUIRE, "agent");
            asm volatile("s_waitcnt vmcnt(0)" ::: "memory");
        }
    }
    __syncthreads();
}

struct Frame {
    LAS unsigned char* lds;
    unsigned char* ws;
    int wave, vcu, G;
    const float *xp, *xs, *pp, *ps, *st0, *g_pre, *w_in, *g_v, *w_s, *b_s, *w_a2, *b_a, *g_o, *w_pa, *w_pb, *w_o, *g_post, *w_pg, *w_pe;
    float* out;
};
__device__ __forceinline__ const float* xrow(const Frame& F, int m) { return m < MP ? F.xp + (size_t)m * DM : F.xs + (size_t)(m - MP) * DM; }

struct ConvItem { const float* src; bf16* dst; int spitch, dpitch; };
constexpr int I_IN = 32 * 320, I_PA = 16 * 64, I_PB = 16 * 64, I_O = 32 * 64, I_PG = 32 * 64, I_PE = 4 * 64, NITEMS = I_IN + I_PA + I_PB + I_O + I_PG + I_PE;
__device__ __forceinline__ void conv_item(const Frame& F, int it, ConvItem& d) {
    int r = it;
    if (r < I_IN) { const int kb = r / 320, n0 = (r % 320) * 32;
        const int src = n0 < 2048 ? ((n0 & 128) ? 2048 + 128 * (n0 >> 8) + (n0 & 127) : 128 * (n0 >> 8) + (n0 & 127)) : n0 < 3072 ? n0 - 1024 : n0 + (n0 >= C_ALR ? GR : 0);
        d.src = F.w_in + (size_t)(kb * 64) * NIN + src; d.spitch = NIN; d.dst = (bf16*)(F.ws + WS_W1T) + (size_t)n0 * 2048 + kb * 64; d.dpitch = 2048; return; } r -= I_IN;
    const int k0 = (r / 64) * 64, n0 = (r % 64) * 32; d.spitch = DM; d.dpitch = 2048;
    if (r < I_PA) { d.src = F.w_pa + (size_t)k0 * DM + n0; d.dst = (bf16*)(F.ws + WS_WPAB) + (size_t)n0 * 2048 + k0; return; } r -= I_PA;
    { const int k1 = (r / 64) * 64, n1 = (r % 64) * 32;
      if (r < I_PB) { d.src = F.w_pb + (size_t)k1 * DM + n1; d.dst = (bf16*)(F.ws + WS_WPAB) + (size_t)n1 * 2048 + 1024 + k1; return; } } r -= I_PB;
    { const int k1 = (r / 64) * 64, n1 = (r % 64) * 32;
      if (r < I_O) { d.src = F.w_o + (size_t)k1 * DM + n1; d.dst = (bf16*)(F.ws + WS_WO) + (size_t)n1 * 2048 + k1; return; } } r -= I_O;
    { const int k1 = (r / 64) * 64, n1 = (r % 64) * 32;
      if (r < I_PG) { d.src = F.w_pg + (size_t)k1 * DM + n1; d.dst = (bf16*)(F.ws + WS_WPG) + (size_t)n1 * 2048 + k1; return; } } r -= I_PG;
    { const int k1 = (r / 64) * 64, n1 = (r % 64) * 32; d.src = F.w_pe + (size_t)k1 * DM + n1; d.dst = (bf16*)(F.ws + WS_WPE) + (size_t)n1 * 256 + k1; d.dpitch = 256; }
}
__device__ __forceinline__ void conv_load(const ConvItem& d, f32x4 (&v)[8], int lane) {
    const int r = lane >> 3, c4 = (lane & 7) * 4;
#pragma unroll
    for (int i = 0; i < 8; ++i) v[i] = __builtin_nontemporal_load((const GAS f32x4*)(d.src + (size_t)(8 * i + r) * d.spitch + c4));
}
__device__ __forceinline__ void conv_finish(const ConvItem& d, const f32x4 (&v)[8], LAS float* scr, int lane) {
    const int r = lane >> 3, c4 = (lane & 7) * 4;
#pragma unroll
    for (int i = 0; i < 8; ++i) { LAS float* p = scr + (8 * i + r) * 33 + c4; p[0] = v[i].x; p[1] = v[i].y; p[2] = v[i].z; p[3] = v[i].w; }
    asm volatile("s_waitcnt lgkmcnt(0)" ::: "memory");
    const int c = lane & 7;
#pragma unroll
    for (int j = 0; j < 4; ++j) { const int n = (lane >> 3) + 8 * j; const LAS float* s = scr + (8 * c) * 33 + n;
        v4u o; o.x = pk2(s[0 * 33], s[1 * 33]); o.y = pk2(s[2 * 33], s[3 * 33]); o.z = pk2(s[4 * 33], s[5 * 33]); o.w = pk2(s[6 * 33], s[7 * 33]);
        *(GAS v4u*)(d.dst + (size_t)n * d.dpitch + 8 * c) = o; }
    asm volatile("s_waitcnt lgkmcnt(0)" ::: "memory");
}
__device__ __forceinline__ void p0_prologue(Frame& F) {
    LAS float* scr = (LAS float*)(F.lds + F.wave * 16384);
    const int gw = F.vcu * NWAVES + F.wave, NGW = F.G * NWAVES, ln = (int)(threadIdx.x & 63u);
    bf16* W1T = (bf16*)(F.ws + WS_W1T);
    { f32x4 va[8], vb[8]; ConvItem da, db; int it = gw; bool ha = it < NITEMS;
      if (ha) { conv_item(F, it, da); conv_load(da, va, ln); }
      while (ha) {
          const int it2 = it + NGW; const bool hb = it2 < NITEMS;
          if (hb) { conv_item(F, it2, db); conv_load(db, vb, ln); }
          conv_finish(da, va, scr, ln);
          if (!hb) break;
          it = it2 + NGW; ha = it < NITEMS;
          if (ha) { conv_item(F, it, da); conv_load(da, va, ln); }
          conv_finish(db, vb, scr, ln);
      } }
    {
        const int gt = F.vcu * NTHR + ((int)threadIdx.x), NGT = F.G * NTHR;
        for (int p = gt; p < 512 * 256; p += NGT) { const int ch = p & 511, k0 = (p >> 9) * 8; float wa[16];
#pragma unroll
            for (int r = 0; r < 16; ++r) wa[r] = F.w_a2[r * KBW + ch];
            float t[8];
#pragma unroll
            for (int i = 0; i < 8; ++i) { const GAS f32x4* wr4 = (const GAS f32x4*)(F.w_in + (size_t)(k0 + i) * NIN + C_ALR); float a = 0.f;
#pragma unroll
                for (int r4 = 0; r4 < 4; ++r4) { const f32x4 w = wr4[r4]; a += w.x * wa[4 * r4] + w.y * wa[4 * r4 + 1] + w.z * wa[4 * r4 + 2] + w.w * wa[4 * r4 + 3]; }
                t[i] = a; }
            v4u o; o.x = pk2(t[0], t[1]); o.y = pk2(t[2], t[3]); o.z = pk2(t[4], t[5]); o.w = pk2(t[6], t[7]);
            *(GAS v4u*)(W1T + (size_t)(10240 + ch) * 2048 + k0) = o; }
        bf16* PBF = (bf16*)(F.ws + WS_PBF);
        for (int p = gt; p < MT * PLE / 8; p += NGT) { const size_t e = (size_t)p * 8; const float* src = e < (size_t)MP * PLE ? F.pp + e : F.ps + (e - (size_t)MP * PLE);
            const f32x4 a = __builtin_nontemporal_load((const GAS f32x4*)src), b = __builtin_nontemporal_load((const GAS f32x4*)(src + 4)); v4u o; o.x = pk2(a.x, a.y); o.y = pk2(a.z, a.w); o.z = pk2(b.x, b.y); o.w = pk2(b.z, b.w);
            *(GAS v4u*)(PBF + e) = o; }
    }
    bf16* XN = (bf16*)(F.ws + WS_XN);
    { const GAS f32x4* gr = (const GAS f32x4*)F.g_pre + ln; f32x4 va[8], vb[8]; int m = gw; bool ha = m < MT;
#define XN_LOAD(v, mm) do { const GAS f32x4* xr_ = (const GAS f32x4*)xrow(F, (mm)) + ln; _Pragma("unroll") for (int j_ = 0; j_ < 8; ++j_) v[j_] = __builtin_nontemporal_load(xr_ + 64 * j_); } while (0)
#define XN_FINISH(v, mm) do { float s_ = 0.f; _Pragma("unroll") for (int j_ = 0; j_ < 8; ++j_) s_ += (v[j_].x * v[j_].x + v[j_].y * v[j_].y) + (v[j_].z * v[j_].z + v[j_].w * v[j_].w); \
        const float rstd_ = 1.0f / sqrtf(wave_sum(s_) * (1.f / DM) + EPS); GAS v2u* o8_ = (GAS v2u*)(XN + (size_t)(mm) * DM) + ln; \
        _Pragma("unroll") for (int j_ = 0; j_ < 8; ++j_) { const f32x4 gg_ = gr[64 * j_]; v2u o_; o_.x = pk2(v[j_].x * rstd_ * gg_.x, v[j_].y * rstd_ * gg_.y); o_.y = pk2(v[j_].z * rstd_ * gg_.z, v[j_].w * rstd_ * gg_.w); o8_[64 * j_] = o_; } } while (0)
      if (ha) XN_LOAD(va, m);
      while (ha) {
          const int m2 = m + NGW; const bool hb = m2 < MT;
          if (hb) XN_LOAD(vb, m2);
          XN_FINISH(va, m);
          if (!hb) break;
          m = m2 + NGW; ha = m < MT;
          if (ha) XN_LOAD(va, m);
          XN_FINISH(vb, m2);
      }
#undef XN_LOAD
#undef XN_FINISH
    }
}

using pg8::Unit;
template <int ACT>
__device__ __forceinline__ void g1_store(const pg8::f32x4 (&acc)[2][2][4][2], bf16* base, int ldc, int row0, int col0, float* vss, int wc, int fq) {
#pragma unroll
    for (int ai = 0; ai < 2; ++ai)
#pragma unroll
        for (int m = 0; m < 4; ++m) { const int row = row0 + ai * 128 + m * 16; bf16* rowp = base + (size_t)row * ldc + col0; float ss = 0.f;
#pragma unroll
            for (int bj = 0; bj < 2; ++bj) { float v[8];
#pragma unroll
                for (int e = 0; e < 8; ++e) { float x = acc[ai][bj][m][e >> 2][e & 3];
                    if (ACT == 1) x = x * sigm(x); else if (ACT == 2) x = sigm(x); else if (ACT == 3) x = x * 0.08838834764831845f;
                    if (ACT == 4) ss += x * x; v[e] = x; }
                v4u w; w.x = pg8::cvt_pk_bf16(v[0], v[1]); w.y = pg8::cvt_pk_bf16(v[2], v[3]); w.z = pg8::cvt_pk_bf16(v[4], v[5]); w.w = pg8::cvt_pk_bf16(v[6], v[7]);
                *(GAS v4u*)(rowp + bj * 128) = w; }
            if (ACT == 4) { ss += __shfl_xor(ss, 16); ss += __shfl_xor(ss, 32); if (fq == 0) vss[(size_t)row * 16 + wc] = ss; } }
}
__device__ __forceinline__ float log_sigmoid(float z) { return -(fmaxf(-z, 0.f) + __logf(1.f + __expf(-fabsf(z)))); }
__device__ __forceinline__ unsigned q8(float x) { const unsigned q = (unsigned)__builtin_fmaf(sigm(x), 255.f, 0.5f); return q < 1u ? 1u : q; }
__device__ __forceinline__ void g1_store_u8(const pg8::f32x4 (&acc)[2][2][4][2], unsigned char* base, int row0, int col0) {
#pragma unroll
    for (int ai = 0; ai < 2; ++ai)
#pragma unroll
        for (int m = 0; m < 4; ++m) { unsigned char* rowp = base + (size_t)(row0 + ai * 128 + m * 16) * DM + col0;
#pragma unroll
            for (int bj = 0; bj < 2; ++bj) { const pg8::f32x4 a = acc[ai][bj][m][0], b = acc[ai][bj][m][1]; v2u w;
                w.x = q8(a.x) | (q8(a.y) << 8) | (q8(a.z) << 16) | (q8(a.w) << 24); w.y = q8(b.x) | (q8(b.y) << 8) | (q8(b.z) << 16) | (q8(b.w) << 24);
                *(GAS v2u*)(rowp + bj * 128) = w; } }
}
__device__ __forceinline__ void u8x8_to_f32(v2u w, float (&f)[8]) {
    f[0] = (float)(w.x & 0xffu); f[1] = (float)((w.x >> 8) & 0xffu); f[2] = (float)((w.x >> 16) & 0xffu); f[3] = (float)(w.x >> 24);
    f[4] = (float)(w.y & 0xffu); f[5] = (float)((w.y >> 8) & 0xffu); f[6] = (float)((w.y >> 16) & 0xffu); f[7] = (float)(w.y >> 24);
}
struct EpiG1 {
    static constexpr bool PERM = true, HAS_MID = false;
    unsigned char* ws; const float* b_a;
    __device__ __forceinline__ void operator()(const pg8::f32x4 (&acc)[2][2][4][2], const Unit& u, int wr, int wc, int fr, int fq) const {
        const int pn = u.pn, row0 = u.pm * 256 + wr * 64 + fr, cin = wc * 32 + 8 * fq;
        if (pn < 8) {
            bf16* UZ = (bf16*)(ws + WS_U);
#pragma unroll
            for (int ai = 0; ai < 2; ++ai)
#pragma unroll
                for (int m = 0; m < 4; ++m) { const pg8::f32x4 u0 = acc[ai][0][m][0], u1 = acc[ai][0][m][1], z0 = acc[ai][1][m][0], z1 = acc[ai][1][m][1]; v4u w;
                    w.x = pg8::cvt_pk_bf16(u0.x * z0.x * sigm(z0.x), u0.y * z0.y * sigm(z0.y)); w.y = pg8::cvt_pk_bf16(u0.z * z0.z * sigm(z0.z), u0.w * z0.w * sigm(z0.w));
                    w.z = pg8::cvt_pk_bf16(u1.x * z1.x * sigm(z1.x), u1.y * z1.y * sigm(z1.y)); w.w = pg8::cvt_pk_bf16(u1.z * z1.z * sigm(z1.z), u1.w * z1.w * sigm(z1.w));
                    *(GAS v4u*)(UZ + (size_t)(row0 + ai * 128 + m * 16) * EA + pn * 128 + cin) = w; } }
        else if (pn < 12) g1_store<4>(acc, (bf16*)(ws + WS_V), 1024, row0, (pn - 8) * 256 + cin, (float*)(ws + WS_VSS) + (pn - 8) * 4, wc, fq);
        else if (pn < 14) g1_store<3>(acc, (bf16*)(ws + WS_Q), 512, row0, (pn - 12) * 256 + cin, nullptr, wc, fq);
        else if (pn < 16) g1_store<0>(acc, (bf16*)(ws + WS_KB), 512, row0, (pn - 14) * 256 + cin, nullptr, wc, fq);
        else if (pn < 20) g1_store<0>(acc, (bf16*)(ws + WS_VB), 1024, row0, (pn - 16) * 256 + cin, nullptr, wc, fq);
        else if (pn < 24) g1_store<1>(acc, (bf16*)(ws + WS_SZB), 1024, row0, (pn - 20) * 256 + cin, nullptr, wc, fq);
        else if (pn < 32) g1_store_u8(acc, ws + WS_GA, row0, (pn - 24) * 256 + cin);
        else if (pn < 40) g1_store_u8(acc, ws + WS_GB, row0, (pn - 32) * 256 + cin);
        else {
            float* la = (float*)(ws + WS_LA); const int c0 = (pn - 40) * 256 + cin;
            pg8::f32x4 bb[2][2];
#pragma unroll
            for (int bj = 0; bj < 2; ++bj) { bb[bj][0] = *(const GAS pg8::f32x4*)(b_a + c0 + bj * 128); bb[bj][1] = *(const GAS pg8::f32x4*)(b_a + c0 + bj * 128 + 4); }
#pragma unroll
            for (int ai = 0; ai < 2; ++ai)
#pragma unroll
                for (int m = 0; m < 4; ++m) { float* rp = la + (size_t)(row0 + ai * 128 + m * 16) * KBW + c0;
#pragma unroll
                    for (int bj = 0; bj < 2; ++bj)
#pragma unroll
                        for (int n = 0; n < 2; ++n) { const pg8::f32x4 z = acc[ai][bj][m][n] + bb[bj][n]; pg8::f32x4 o;
                            o.x = log_sigmoid(z.x) * 0.0625f; o.y = log_sigmoid(z.y) * 0.0625f; o.z = log_sigmoid(z.z) * 0.0625f; o.w = log_sigmoid(z.w) * 0.0625f;
                            *(GAS pg8::f32x4*)(rp + bj * 128 + n * 4) = o; } }
        }
    }
};
struct EpiBf {
    static constexpr bool PERM = true, HAS_MID = false;
    bf16* O; int ldc;
    __device__ __forceinline__ void operator()(const pg8::f32x4 (&acc)[2][2][4][2], const Unit& u, int wr, int wc, int fr, int fq) const {
        g1_store<0>(acc, O, ldc, u.pm * 256 + wr * 64 + fr, u.pn * 256 + wc * 32 + 8 * fq, nullptr, wc, fq);
    }
};
template <bool PERM>
__device__ __forceinline__ void slab_store(const pg8::f32x4 (&acc)[2][2][4][2], bf16* lo, bf16* hi, const Unit& u, int wr, int wc, int fr, int fq) {
    const int ks = u.kt0 >> 2; bf16* sl = ks < 4 ? lo + (size_t)ks * MS * DM : hi + (size_t)(ks - 4) * MS * DM;
    const int row0 = (u.pm - 32) * 256 + wr * 64 + fr, col0 = u.pn * 256 + wc * 32 + (PERM ? 8 : 4) * fq;
#pragma unroll
    for (int ai = 0; ai < 2; ++ai)
#pragma unroll
        for (int m = 0; m < 4; ++m) { bf16* rp = sl + (size_t)(row0 + ai * 128 + m * 16) * DM + col0;
#pragma unroll
            for (int bj = 0; bj < 2; ++bj) {
                if (PERM) { const pg8::f32x4 a = acc[ai][bj][m][0], b = acc[ai][bj][m][1]; *(GAS v4u*)(rp + bj * 128) = (v4u){pk2(a.x, a.y), pk2(a.z, a.w), pk2(b.x, b.y), pk2(b.z, b.w)}; }
                else {
#pragma unroll
                    for (int n = 0; n < 2; ++n) { const pg8::f32x4 a = acc[ai][bj][m][n]; *(GAS v2u*)(rp + bj * 128 + n * 16) = (v2u){pk2(a.x, a.y), pk2(a.z, a.w)}; } } } }
}
__device__ __forceinline__ const bf16* slab_ptr(const bf16* lo, const bf16* hi, int ks) { return ks < 4 ? lo + (size_t)ks * MS * DM : hi + (size_t)(ks - 4) * MS * DM; }
__device__ __forceinline__ void slab_sum8(const bf16* lo, const bf16* hi, size_t off, int k0, int k1, pg8::f32x4& s0, pg8::f32x4& s1) {
    s0 = (pg8::f32x4){0.f, 0.f, 0.f, 0.f}; s1 = s0;
#pragma unroll
    for (int ks = 0; ks < 8; ++ks) if (ks >= k0 && ks < k1) { const v4u w = *(const GAS v4u*)(slab_ptr(lo, hi, ks) + off);
        s0.x += bflo(w.x); s0.y += bfhi(w.x); s0.z += bflo(w.y); s0.w += bfhi(w.y); s1.x += bflo(w.z); s1.y += bfhi(w.z); s1.z += bflo(w.w); s1.w += bfhi(w.w); }
}
__device__ __forceinline__ pg8::f32x4 slab_sum4(const bf16* lo, const bf16* hi, size_t off) {
    pg8::f32x4 a = (pg8::f32x4){0.f, 0.f, 0.f, 0.f};
#pragma unroll
    for (int ks = 0; ks < 8; ++ks) { const v2u w = *(const GAS v2u*)(slab_ptr(lo, hi, ks) + off); a.x += bflo(w.x); a.y += bfhi(w.x); a.z += bflo(w.y); a.w += bfhi(w.y); }
    return a;
}
struct EpiG2 {
    static constexpr bool PERM = true, HAS_MID = true;
    const unsigned char* GA; const unsigned char* GB; bf16* Mo; bf16* slo; bf16* shi;
    __device__ __forceinline__ void mid(pg8::f32x4 (&acc)[2][2][4][2], const Unit& u, int wr, int wc, int fr, int fq) const {
        asm volatile("" : "+v"(fr));
        const unsigned off0 = (unsigned)((u.pm * 256 + wr * 64 + fr) * DM + u.pn * 256 + wc * 32 + 8 * fq);
#pragma unroll
        for (int ai = 0; ai < 2; ++ai)
#pragma unroll
            for (int m = 0; m < 4; ++m) { const unsigned off = off0 + (unsigned)((ai * 128 + m * 16) * DM);
#pragma unroll
                for (int bj = 0; bj < 2; ++bj) { const v2u a = *(const GAS v2u*)(GA + off + bj * 128), b = *(const GAS v2u*)(GB + off + bj * 128); float fa[8], fb[8]; u8x8_to_f32(a, fa); u8x8_to_f32(b, fb);
#pragma unroll
                    for (int e = 0; e < 8; ++e) acc[ai][bj][m][e >> 2][e & 3] *= fa[e] * __builtin_amdgcn_rcpf(fb[e]); }
                if (m == 3) asm volatile("" ::: "memory"); }
    }
    __device__ __forceinline__ void operator()(const pg8::f32x4 (&acc)[2][2][4][2], const Unit& u, int wr, int wc, int fr, int fq) const {
        if (u.kind) { slab_store<true>(acc, slo, shi, u, wr, wc, fr, fq); return; }
        const int row0 = u.pm * 256 + wr * 64 + fr, col0 = u.pn * 256 + wc * 32 + 8 * fq;
#pragma unroll
        for (int ai = 0; ai < 2; ++ai)
#pragma unroll
            for (int m = 0; m < 4; ++m) { const size_t off = (size_t)(row0 + ai * 128 + m * 16) * DM + col0;
#pragma unroll
                for (int bj = 0; bj < 2; ++bj) { const v2u b = *(const GAS v2u*)(GB + off + bj * 128); float fb[8]; u8x8_to_f32(b, fb); unsigned w[4];
#pragma unroll
                    for (int p = 0; p < 4; ++p) w[p] = pg8::cvt_pk_bf16(acc[ai][bj][m][p >> 1][(p & 1) * 2] * (fb[2 * p] * (1.f / 255.f)), acc[ai][bj][m][p >> 1][(p & 1) * 2 + 1] * (fb[2 * p + 1] * (1.f / 255.f)));
                    *(GAS v4u*)(Mo + off + bj * 128) = (v4u){w[0], w[1], w[2], w[3]}; }
                if (m & 1) asm volatile("" ::: "memory"); }
    }
};
struct EpiG3 {
    static constexpr bool PERM = true, HAS_MID = false;
    bf16* T; float* tss; bf16* slo; bf16* shi;
    int fused; bf16* H; float* xs; unsigned* cnt; const float* xp; const float* gpost; LAS unsigned char* lx;
    __device__ __forceinline__ void operator()(const pg8::f32x4 (&acc)[2][2][4][2], const Unit& u, int wr, int wc, int fr, int fq) const {
        if (u.kind) { slab_store<true>(acc, slo, shi, u, wr, wc, fr, fq); return; }
        const int row0 = u.pm * 256 + wr * 64 + fr, col0 = u.pn * 256 + wc * 32 + 8 * fq;
        if (!fused) {
#pragma unroll
            for (int ai = 0; ai < 2; ++ai)
#pragma unroll
                for (int m = 0; m < 4; ++m) { const int row = row0 + ai * 128 + m * 16; bf16* rowp = T + (size_t)row * DM + col0; float ss = 0.f;
#pragma unroll
                    for (int bj = 0; bj < 2; ++bj) { const pg8::f32x4 a = acc[ai][bj][m][0], b = acc[ai][bj][m][1];
                        ss += (a.x * a.x + a.y * a.y) + (a.z * a.z + a.w * a.w) + (b.x * b.x + b.y * b.y) + (b.z * b.z + b.w * b.w);
                        v4u w; w.x = pg8::cvt_pk_bf16(a.x, a.y); w.y = pg8::cvt_pk_bf16(a.z, a.w); w.z = pg8::cvt_pk_bf16(b.x, b.y); w.w = pg8::cvt_pk_bf16(b.z, b.w);
                        *(GAS v4u*)(rowp + bj * 128) = w; }
                    ss += __shfl_xor(ss, 16); ss += __shfl_xor(ss, 32); if (fq == 0) tss[(size_t)row * 32 + u.pn * 4 + wc] = ss; }
            return;
        }
        LAS float* P = (LAS float*)lx; LAS float* S = P + 1024; volatile LAS unsigned* flag = (volatile LAS unsigned*)(S + 256);
        const int tid = threadIdx.x, lane = tid & 63, wid = __builtin_amdgcn_readfirstlane(tid >> 6);
#pragma unroll
        for (int ai = 0; ai < 2; ++ai)
#pragma unroll
            for (int m = 0; m < 4; ++m) { float ss = 0.f;
#pragma unroll
                for (int bj = 0; bj < 2; ++bj) { const pg8::f32x4 a = acc[ai][bj][m][0], b = acc[ai][bj][m][1]; ss += (a.x * a.x + a.y * a.y) + (a.z * a.z + a.w * a.w) + (b.x * b.x + b.y * b.y) + (b.z * b.z + b.w * b.w); }
                ss += __shfl_xor(ss, 16); ss += __shfl_xor(ss, 32); if (fq == 0) P[(ai * 128 + wr * 64 + m * 16 + fr) * 4 + wc] = ss; }
        asm volatile("s_waitcnt lgkmcnt(0)" ::: "memory"); __builtin_amdgcn_s_barrier(); asm volatile("" ::: "memory");
        if (tid < 256) { const pg8::f32x4 p = *(const LAS pg8::f32x4*)(P + tid * 4);
            __hip_atomic_store(xs + (size_t)(u.pm * 256 + tid) * 8 + u.pn, (p.x + p.y) + (p.z + p.w), __ATOMIC_RELAXED, __HIP_MEMORY_SCOPE_AGENT); }
        asm volatile("s_waitcnt vmcnt(0)" ::: "memory");
        if (tid < 256 && lane == 0) (void)__hip_atomic_fetch_add(cnt + 64 * u.pm, 1u, __ATOMIC_RELAXED, __HIP_MEMORY_SCOPE_AGENT);
        if (wid == 0) { unsigned sp = 0;
            while ((unsigned)__builtin_amdgcn_readfirstlane(__hip_atomic_load(cnt + 64 * u.pm, __ATOMIC_RELAXED, __HIP_MEMORY_SCOPE_AGENT)) < 32u) { __builtin_amdgcn_s_sleep(2); if (++sp > (1u << 20)) break; }
            __builtin_amdgcn_fence(__ATOMIC_ACQUIRE, "agent"); asm volatile("s_waitcnt vmcnt(0)" ::: "memory"); if (lane == 0) flag[0] = 1u; }
        asm volatile("s_waitcnt lgkmcnt(0)" ::: "memory"); __builtin_amdgcn_s_barrier(); asm volatile("" ::: "memory");
        if (tid < 256) { const float* sl = xs + (size_t)(u.pm * 256 + tid) * 8; float t = 0.f;
#pragma unroll
            for (int q = 0; q < 8; ++q) t += __hip_atomic_load(sl + q, __ATOMIC_RELAXED, __HIP_MEMORY_SCOPE_AGENT);
            S[tid] = 1.0f / sqrtf(t * (1.f / DM) + EPS); }
        asm volatile("s_waitcnt lgkmcnt(0)" ::: "memory"); __builtin_amdgcn_s_barrier(); asm volatile("" ::: "memory");
        pg8::f32x4 gp[2][2];
#pragma unroll
        for (int bj = 0; bj < 2; ++bj) { gp[bj][0] = *(const GAS pg8::f32x4*)(gpost + col0 + bj * 128); gp[bj][1] = *(const GAS pg8::f32x4*)(gpost + col0 + bj * 128 + 4); }
#pragma unroll
        for (int ai = 0; ai < 2; ++ai)
#pragma unroll
            for (int m = 0; m < 4; ++m) { const int rl = ai * 128 + wr * 64 + m * 16 + fr; const float rs = S[rl]; const size_t off = (size_t)(u.pm * 256 + rl) * DM + col0;
#pragma unroll
                for (int bj = 0; bj < 2; ++bj) { const pg8::f32x4 x0 = *(const GAS pg8::f32x4*)(xp + off + bj * 128), x1 = *(const GAS pg8::f32x4*)(xp + off + bj * 128 + 4); const pg8::f32x4 a = acc[ai][bj][m][0], b = acc[ai][bj][m][1], g0 = gp[bj][0], g1 = gp[bj][1];
                    v4u w; w.x = pg8::cvt_pk_bf16(x0.x + a.x * rs * g0.x, x0.y + a.y * rs * g0.y); w.y = pg8::cvt_pk_bf16(x0.z + a.z * rs * g0.z, x0.w + a.w * rs * g0.w);
                    w.z = pg8::cvt_pk_bf16(x1.x + b.x * rs * g1.x, x1.y + b.y * rs * g1.y); w.w = pg8::cvt_pk_bf16(x1.z + b.z * rs * g1.z, x1.w + b.w * rs * g1.w);
                    *(GAS v4u*)(H + off + bj * 128) = w; }
                if (m & 1) asm volatile("" ::: "memory"); }
    }
};
struct EpiG4 {
    static constexpr bool PERM = false, HAS_MID = false;
    const bf16 *H, *E; float* out; bf16* slo; bf16* shi;
    __device__ __forceinline__ void operator()(const pg8::f32x4 (&acc)[2][2][4][2], const Unit& u, int wr, int wc, int fr, int fq) const {
        if (u.kind) { slab_store<false>(acc, slo, shi, u, wr, wc, fr, fq); return; }
        const int row0 = u.pm * 256 + wr * 64 + fr, col0 = u.pn * 256 + wc * 32 + 4 * fq;
#pragma unroll
        for (int ai = 0; ai < 2; ++ai)
#pragma unroll
            for (int m = 0; m < 4; ++m) { const size_t off = (size_t)(row0 + ai * 128 + m * 16) * DM + col0;
#pragma unroll
                for (int bj = 0; bj < 2; ++bj)
#pragma unroll
                    for (int n = 0; n < 2; ++n) { const size_t o2 = off + bj * 128 + n * 16;
                        const v2u hv = __builtin_nontemporal_load((const GAS v2u*)(H + o2)), ev = __builtin_nontemporal_load((const GAS v2u*)(E + o2)); const pg8::f32x4 a = acc[ai][bj][m][n];
                        pg8::f32x4 o; o.x = bflo(hv.x) + sigm(a.x) * bflo(ev.x); o.y = bfhi(hv.x) + sigm(a.y) * bfhi(ev.x); o.z = bflo(hv.y) + sigm(a.z) * bflo(ev.y); o.w = bfhi(hv.y) + sigm(a.w) * bfhi(ev.y);
                        __builtin_nontemporal_store(o, (GAS pg8::f32x4*)(out + o2)); }
                asm volatile("" ::: "memory"); }
    }
};

constexpr int GWP = 136, GVP = 68;
__device__ __forceinline__ void gate_prompt_unit(Frame& F, int unit) {
    int tid = ((int)threadIdx.x); asm volatile("" : "+v"(tid));
    const int g = unit & 3, c = (unit >> 2) & 15, b = unit >> 6, r0 = b * SEQ + c * CH, lane = tid & 63, wave = F.wave, fr = lane & 15, fq = lane >> 4;
    LAS bf16* WL = (LAS bf16*)F.lds;
    LAS unsigned* VT = (LAS unsigned*)(F.lds + 128 * GWP * 2);
    LAS float* RS = (LAS float*)(F.lds + 128 * GWP * 2 + 256 * GVP * 4);
    const bf16* U = (const bf16*)(F.ws + WS_U); const bf16* V = (const bf16*)(F.ws + WS_V); const float* VSS = (const float*)(F.ws + WS_VSS);
    bf16* Y = (bf16*)(F.ws + WS_Y);
    __syncthreads();
    if (tid < 128) { const GAS f32x4* p = (const GAS f32x4*)(VSS + (size_t)(r0 + tid) * 16); const f32x4 a = p[0], b4 = p[1], c4 = p[2], d4 = p[3];
        const float ss = ((a.x + a.y) + (a.z + a.w)) + ((b4.x + b4.y) + (b4.z + b4.w)) + ((c4.x + c4.y) + (c4.z + c4.w)) + ((d4.x + d4.y) + (d4.z + d4.w));
        RS[tid] = 1.0f / sqrtf(ss * (1.f / EA) + EPS); }
    { const float* W = F.w_s + (size_t)g * CH * CH;
#pragma unroll
      for (int i = 0; i < 4; ++i) { const int p = tid + NTHR * i, t = p >> 4, s8 = (p & 15) * 8; const f32x4 w0 = *(const GAS f32x4*)(W + t * CH + s8), w1 = *(const GAS f32x4*)(W + t * CH + s8 + 4); v4u o;
          o.x = pk2(s8 <= t ? w0.x : 0.f, s8 + 1 <= t ? w0.y : 0.f); o.y = pk2(s8 + 2 <= t ? w0.z : 0.f, s8 + 3 <= t ? w0.w : 0.f);
          o.z = pk2(s8 + 4 <= t ? w1.x : 0.f, s8 + 5 <= t ? w1.y : 0.f); o.w = pk2(s8 + 6 <= t ? w1.z : 0.f, s8 + 7 <= t ? w1.w : 0.f);
          *(LAS v4u*)(WL + t * GWP + s8) = o; } }
    __syncthreads();
#pragma unroll
    for (int i = 0; i < 4; ++i) { const int idx = tid + NTHR * i, cg = ((idx >> 5) & 3) * 8 + (idx & 7), sp = (idx >> 7) * 4 + ((idx >> 3) & 3), s0 = 2 * sp;
        const v4u ra = *(const GAS v4u*)(V + (size_t)(r0 + s0) * EA + g * DV + 8 * cg), rb = *(const GAS v4u*)(V + (size_t)(r0 + s0 + 1) * EA + g * DV + 8 * cg);
        const GAS f32x4* gv = (const GAS f32x4*)(F.g_v + g * DV + 8 * cg); const f32x4 g0 = gv[0], g1 = gv[1]; const float ra_s = RS[s0], rb_s = RS[s0 + 1];
        const float gg[8] = {g0.x, g0.y, g0.z, g0.w, g1.x, g1.y, g1.z, g1.w}; const unsigned wa[4] = {ra.x, ra.y, ra.z, ra.w}, wb[4] = {rb.x, rb.y, rb.z, rb.w};
        LAS unsigned* dst = VT + (8 * cg) * GVP + (sp ^ (4 * (cg & 7)));
#pragma unroll
        for (int e = 0; e < 4; ++e) { dst[(2 * e) * GVP] = pk2(bflo(wa[e]) * ra_s * gg[2 * e], bflo(wb[e]) * rb_s * gg[2 * e]); dst[(2 * e + 1) * GVP] = pk2(bfhi(wa[e]) * ra_s * gg[2 * e + 1], bfhi(wb[e]) * rb_s * gg[2 * e + 1]); } }
    __syncthreads();
    pg8::f32x4 acc[16];
#pragma unroll
    for (int q = 0; q < 16; ++q) acc[q] = (pg8::f32x4){0.f, 0.f, 0.f, 0.f};
    const int nkk = (wave >> 1) + 1;
    for (int kk = 0; kk < nkk; ++kk) { const bf16x8 bw = *(const LAS bf16x8*)(WL + (16 * wave + fr) * GWP + 32 * kk + 8 * fq);
#pragma unroll
        for (int q = 0; q < 16; ++q) { const int d = 64 * (q >> 2) + 16 * (fr >> 2) + 4 * (q & 3) + (fr & 3);
            const bf16x8 af = *(const LAS bf16x8*)(VT + d * GVP + ((16 * kk + 4 * fq) ^ (4 * ((d >> 3) & 7))));
            acc[q] = __builtin_amdgcn_mfma_f32_16x16x32_bf16(af, bw, acc[q], 0, 0, 0); } }
    { const int t = 16 * wave + fr; const float bs = F.b_s[g * CH + t];
#pragma unroll
      for (int G4 = 0; G4 < 4; ++G4) { const size_t o1 = (size_t)(r0 + t) * EA + g * DV + 64 * G4 + 16 * fq; const v4u u0 = *(const GAS v4u*)(U + o1), u1 = *(const GAS v4u*)(U + o1 + 8);
          const unsigned uw[8] = {u0.x, u0.y, u0.z, u0.w, u1.x, u1.y, u1.z, u1.w}; unsigned yw[8];
#pragma unroll
          for (int n = 0; n < 4; ++n) { const pg8::f32x4 sv = acc[G4 * 4 + n];
              yw[2 * n] = pk2(bflo(uw[2 * n]) * (sv.x + bs), bfhi(uw[2 * n]) * (sv.y + bs));
              yw[2 * n + 1] = pk2(bflo(uw[2 * n + 1]) * (sv.z + bs), bfhi(uw[2 * n + 1]) * (sv.w + bs)); }
          bf16* yp = Y + (size_t)(r0 + t) * DM + g * DV + 64 * G4 + 16 * fq;
          *(GAS v4u*)yp = (v4u){yw[0], yw[1], yw[2], yw[3]}; *(GAS v4u*)(yp + 8) = (v4u){yw[4], yw[5], yw[6], yw[7]}; } }
}

__device__ __forceinline__ void sample_unit(Frame& F, int unit) {
    int tid = ((int)threadIdx.x); asm volatile("" : "+v"(tid));
    const int h = unit & 3, sb = unit >> 2, r0 = MP + sb * DSEQ, lane = tid & 63, wave = F.wave;
    LAS float* L = (LAS float*)F.lds;
    LAS float* QT = L; LAS float* KT = L + 1024; LAS float* KD = L + 2048; LAS float* DC = L + 3072; LAS float* ATT = L + 3200; LAS float* RS = L + 3264; LAS float* QS = L + 3400; LAS float* RED = L + 4608;
    const bf16* Vb = (const bf16*)(F.ws + WS_V); const bf16* U = (const bf16*)(F.ws + WS_U); const float* VSS = (const float*)(F.ws + WS_VSS);
    const bf16* Q = (const bf16*)(F.ws + WS_Q); const bf16* KBp = (const bf16*)(F.ws + WS_KB); const bf16* VB = (const bf16*)(F.ws + WS_VB); const bf16* SZB = (const bf16*)(F.ws + WS_SZB);
    const float* LAg = (const float*)(F.ws + WS_LA); bf16* Y = (bf16*)(F.ws + WS_Y);
    const int d = tid & 255, th = tid >> 8, col = h * DV + d, v4 = lane, dg = wave, chp = h * DK + (tid & 127);
    f32x4 ssv[4]; float bsv = 0.f; if (tid < 8) { const GAS f32x4* p = (const GAS f32x4*)(VSS + (size_t)(r0 + tid) * 16); ssv[0] = p[0]; ssv[1] = p[1]; ssv[2] = p[2]; ssv[3] = p[3]; bsv = F.b_s[h * CH + tid]; }
    float wsv = 0.f; if (tid < 64) wsv = F.w_s[(size_t)h * CH * CH + (tid >> 3) * CH + (tid & 7)];
    bf16 vraw[8], uraw[4];
#pragma unroll
    for (int s2 = 0; s2 < 8; ++s2) vraw[s2] = Vb[(size_t)(r0 + s2) * EA + col];
#pragma unroll
    for (int i = 0; i < 4; ++i) uraw[i] = U[(size_t)(r0 + th * 4 + i) * EA + col];
    const float gv = F.g_v[col];
    float laraw[8]; bf16 qraw[8], kraw[8];
    if (tid < 128) {
#pragma unroll
        for (int t = 0; t < 8; ++t) { laraw[t] = LAg[(size_t)(r0 + t) * KBW + chp]; qraw[t] = Q[(size_t)(r0 + t) * KBW + chp]; kraw[t] = KBp[(size_t)(r0 + t) * KBW + chp]; } }
    v2u vvraw[8];
#pragma unroll
    for (int s2 = 0; s2 < 8; ++s2) vvraw[s2] = *(const GAS v2u*)(VB + (size_t)(r0 + s2) * EB + h * DV + 4 * v4);
    const v2u zz = *(const GAS v2u*)(SZB + (size_t)(r0 + wave) * EB + h * DV + 4 * v4); const f32x4 go = *(const GAS f32x4*)(F.g_o + h * DV + 4 * v4);
    const float* S0 = F.st0 + ((size_t)(sb * HB + h) * DK) * DV; float* SN = F.out + OUT_SS + ((size_t)(sb * HB + h) * DK) * DV;
    f32x4 s0r[16];
#pragma unroll
    for (int dd = 0; dd < 16; ++dd) s0r[dd] = __builtin_nontemporal_load((const GAS f32x4*)(S0 + (size_t)(dg * 16 + dd) * DV + 4 * v4));
    __syncthreads();
    if (tid < 8) { const f32x4 a = ssv[0], b4 = ssv[1], c4 = ssv[2], d4 = ssv[3];
        const float ss = ((a.x + a.y) + (a.z + a.w)) + ((b4.x + b4.y) + (b4.z + b4.w)) + ((c4.x + c4.y) + (c4.z + c4.w)) + ((d4.x + d4.y) + (d4.z + d4.w));
        RS[tid] = 1.0f / sqrtf(ss * (1.f / EA) + EPS); RS[8 + tid] = bsv; }
    if (tid < 64) RS[16 + tid] = wsv;
    __syncthreads();
    {
        float vn[8];
#pragma unroll
        for (int s2 = 0; s2 < 8; ++s2) vn[s2] = bf2f(vraw[s2]) * RS[s2] * gv;
#pragma unroll
        for (int i = 0; i < 4; ++i) { const int t = th * 4 + i; float S = RS[8 + t];
#pragma unroll
            for (int s2 = 0; s2 < 8; ++s2) if (s2 <= t) S += RS[16 + t * 8 + s2] * vn[s2];
            Y[(size_t)(r0 + t) * DM + col] = (bf16)f2bf(bf2f(uraw[i]) * S);
            float vt = 0.f;
#pragma unroll
            for (int s2 = 0; s2 < 8; ++s2) vt = (s2 == t) ? vn[s2] : vt;
            F.out[OUT_CV + (size_t)(sb * DSEQ + t) * EA + col] = vt; }
    }
    if (tid < 128) { const int dq = tid; float bc[8]; float run = 0.f;
#pragma unroll
        for (int t = 0; t < 8; ++t) { run += laraw[t]; bc[t] = run; }
        const float dcv = __expf(run); DC[dq] = dcv;
#pragma unroll
        for (int t = 0; t < 8; ++t) { const float q = bf2f(qraw[t]), k = bf2f(kraw[t]);
            const float eb = __expf(bc[t]), ek = __builtin_amdgcn_rcpf(eb); const float qt = q * eb, kt = k * ek; QT[dq * 8 + t] = qt; QS[t * 128 + dq] = qt; KT[t * 128 + dq] = kt; KD[dq * 8 + t] = kt * dcv; }
    }
    __syncthreads();
    { const int p = tid >> 3, part = tid & 7, t = p >> 3, s2 = p & 7; float a = 0.f;
      if (s2 <= t) {
#pragma unroll
          for (int dd = 0; dd < 16; ++dd) a += QS[t * 128 + part * 16 + dd] * KT[s2 * 128 + part * 16 + dd]; }
      a += __shfl_xor(a, 1); a += __shfl_xor(a, 2); a += __shfl_xor(a, 4);
      if (part == 0) ATT[p] = a; }
    f32x4 vv[8];
#pragma unroll
    for (int s2 = 0; s2 < 8; ++s2) vv[s2] = (f32x4){bflo(vvraw[s2].x), bfhi(vvraw[s2].x), bflo(vvraw[s2].y), bfhi(vvraw[s2].y)};
    f32x4 oacc[8];
#pragma unroll
    for (int t = 0; t < 8; ++t) oacc[t] = (f32x4){0.f, 0.f, 0.f, 0.f};
#pragma unroll
    for (int dd = 0; dd < 16; ++dd) { const int dr = dg * 16 + dd; const f32x4 s0 = s0r[dd];
        const f32x4 q0 = *(const LAS f32x4*)(QT + dr * 8), q1 = *(const LAS f32x4*)(QT + dr * 8 + 4), k0 = *(const LAS f32x4*)(KD + dr * 8), k1 = *(const LAS f32x4*)(KD + dr * 8 + 4);
        oacc[0] += q0.x * s0; oacc[1] += q0.y * s0; oacc[2] += q0.z * s0; oacc[3] += q0.w * s0; oacc[4] += q1.x * s0; oacc[5] += q1.y * s0; oacc[6] += q1.z * s0; oacc[7] += q1.w * s0;
        f32x4 sn = DC[dr] * s0; sn += k0.x * vv[0]; sn += k0.y * vv[1]; sn += k0.z * vv[2]; sn += k0.w * vv[3]; sn += k1.x * vv[4]; sn += k1.y * vv[5]; sn += k1.z * vv[6]; sn += k1.w * vv[7];
        __builtin_nontemporal_store(sn, (GAS f32x4*)(SN + (size_t)dr * DV + 4 * v4)); }
#pragma unroll
    for (int t = 0; t < 8; ++t) *(LAS f32x4*)(RED + (dg * 8 + t) * 256 + 4 * v4) = oacc[t];
    __syncthreads();
    { const int t = wave; f32x4 o = (f32x4){0.f, 0.f, 0.f, 0.f};
#pragma unroll
      for (int g2 = 0; g2 < 8; ++g2) o += *(const LAS f32x4*)(RED + (g2 * 8 + t) * 256 + 4 * v4);
#pragma unroll
      for (int s2 = 0; s2 < 8; ++s2) o += ATT[t * 8 + s2] * vv[s2];
      const float ss = wave_sum((o.x * o.x + o.y * o.y) + (o.z * o.z + o.w * o.w)); const float rs = 1.0f / sqrtf(ss * (1.f / DV) + EPS);
      v2u w; w.x = pk2(o.x * rs * go.x * bflo(zz.x), o.y * rs * go.y * bfhi(zz.x)); w.y = pk2(o.z * rs * go.z * bflo(zz.y), o.w * rs * go.w * bfhi(zz.y));
      *(GAS v2u*)(Y + (size_t)(r0 + t) * DM + EA + h * DV + 4 * v4) = w; }
}

constexpr int PRP = 264, PRT = 68;
__device__ __forceinline__ void prep_unit(Frame& F, int unit) {
    int tid = ((int)threadIdx.x); asm volatile("" : "+v"(tid));
    const int hp = unit & 1, cc = (unit >> 1) & 31, b = unit >> 6, r0 = b * SEQ + cc * GC, ch = tid & 255, th = tid >> 8, c0 = hp * 256;
    LAS bf16* QL = (LAS bf16*)F.lds;
    LAS bf16* KL = QL + 64 * PRP;
    LAS bf16* KTL = KL + 64 * PRP;
    LAS float* TOT = (LAS float*)(KTL + 256 * PRT);
    const float* LAg = (const float*)(F.ws + WS_LA); const bf16* Q = (const bf16*)(F.ws + WS_Q); const bf16* KBp = (const bf16*)(F.ws + WS_KB);
    bf16* QTg = (bf16*)(F.ws + WS_QT); bf16* KTT = (bf16*)(F.ws + WS_KTT); float* DEC = (float*)(F.ws + WS_DEC);
    __syncthreads();
    float bl[32]; float run = 0.f;
#pragma unroll
    for (int i2 = 0; i2 < 32; ++i2) { run += LAg[(size_t)(r0 + 32 * th + i2) * KBW + c0 + ch]; bl[i2] = run; }
    TOT[th * 256 + ch] = run;
    __syncthreads();
    const float t0 = TOT[ch], t1 = TOT[256 + ch], off = th ? t0 : 0.f;
    if (th == 0) DEC[((size_t)(b * HB + 2 * hp + (ch >> 7)) * NCH + cc) * DK + (ch & 127)] = __expf(t0 + t1);
#pragma unroll
    for (int i2 = 0; i2 < 32; ++i2) { const int t = 32 * th + i2; const float eb = __expf(bl[i2] + off), ek = __builtin_amdgcn_rcpf(eb);
        const float q = bf2f(Q[(size_t)(r0 + t) * KBW + c0 + ch]), k = bf2f(KBp[(size_t)(r0 + t) * KBW + c0 + ch]);
        const bf16 kb = (bf16)f2bf(k * ek); QL[t * PRP + ch] = (bf16)f2bf(q * eb); KL[t * PRP + ch] = kb; KTL[ch * PRT + t] = kb; }
    __syncthreads();
#pragma unroll
    for (int i2 = 0; i2 < 4; ++i2) { const int p = tid + NTHR * i2, t = p >> 5, c8 = (p & 31) * 8; const size_t o = ((size_t)(b * HB + 2 * hp + (c8 >> 7)) * SEQ + cc * GC + t) * DK + (c8 & 127);
        *(GAS v4u*)(QTg + o) = *(const LAS v4u*)(QL + t * PRP + c8); }
    { const int lane = tid & 63, fr = lane & 15, fq = lane >> 4, hl = F.wave >> 2, ti = F.wave & 3; bf16* ATg = (bf16*)(F.ws + WS_ATT) + ((size_t)(b * HB + 2 * hp + hl) * NCH + cc) * GC * GC;
      bf16x8 qf[4];
#pragma unroll
      for (int kk = 0; kk < 4; ++kk) qf[kk] = *(const LAS bf16x8*)(QL + (16 * ti + fr) * PRP + hl * 128 + 32 * kk + 8 * fq);
#pragma unroll
      for (int si = 0; si < 4; ++si) { pg8::f32x4 a = (pg8::f32x4){0.f, 0.f, 0.f, 0.f};
          if (si <= ti) {
#pragma unroll
              for (int kk = 0; kk < 4; ++kk) a = __builtin_amdgcn_mfma_f32_16x16x32_bf16(*(const LAS bf16x8*)(KL + (16 * si + fr) * PRP + hl * 128 + 32 * kk + 8 * fq), qf[kk], a, 0, 0, 0); }
          const int t = 16 * ti + fr, s0 = 16 * si + 4 * fq; v2u w;
          w.x = pk2(s0 <= t ? a.x : 0.f, s0 + 1 <= t ? a.y : 0.f); w.y = pk2(s0 + 2 <= t ? a.z : 0.f, s0 + 3 <= t ? a.w : 0.f);
          *(GAS v2u*)(ATg + t * GC + s0) = w; } }
#pragma unroll
    for (int i2 = 0; i2 < 4; ++i2) { const int p = tid + NTHR * i2, chh = p >> 3, t8 = (p & 7) * 8; const v2u a = *(const LAS v2u*)(KTL + chh * PRT + t8), c2 = *(const LAS v2u*)(KTL + chh * PRT + t8 + 4);
        *(GAS v4u*)(KTT + (((size_t)(b * HB + 2 * hp + (chh >> 7)) * NCH + cc) * DK + (chh & 127)) * GC + t8) = (v4u){a.x, a.y, c2.x, c2.y}; }
}

constexpr int PQ = 136, PS64 = 72;
__device__ __forceinline__ bf16x8 ldfrag(const LAS bf16* base, int row, int pitch, int k0) { return *(const LAS bf16x8*)(base + row * pitch + k0); }
struct GlaStage { v4u q[2], kt[2], at, v; float dec; };
template <int NVT>
__device__ __forceinline__ void gla_unit(Frame& F, int unit, bool fuse_norm) {
    constexpr int SW = 16 * NVT, NSL = DV / SW, VPR = SW / 8  ;
    int tid = ((int)threadIdx.x); asm volatile("" : "+v"(tid));
    const int bh = unit / NSL, j = unit % NSL, b = bh >> 2, h = bh & 3, lane = tid & 63, wave = F.wave, fr = lane & 15, fq = lane >> 4;
    constexpr int SET_E = 64 * PQ + 128 * PS64 + SW * PS64 + 64 * PS64 + 256;
    LAS bf16* L0 = (LAS bf16*)F.lds; LAS bf16* STL = L0 + 2 * SET_E;
    const bf16* QTg = (const bf16*)(F.ws + WS_QT) + (size_t)bh * SEQ * DK; const bf16* ATg = (const bf16*)(F.ws + WS_ATT) + (size_t)bh * NCH * GC * GC;
    const bf16* KTT = (const bf16*)(F.ws + WS_KTT) + (size_t)bh * NCH * DK * GC; const float* DEC = (const float*)(F.ws + WS_DEC) + (size_t)bh * NCH * DK;
    const bf16* VB = (const bf16*)(F.ws + WS_VB) + (size_t)(b * SEQ) * EB + h * DV + j * SW; bf16* O = (bf16*)(F.ws + WS_O) + (size_t)(b * SEQ) * EB + h * DV + j * SW;
    __syncthreads();
    for (int i = tid; i < 2 * SW * PQ / 2; i += NTHR) ((LAS unsigned*)STL)[i] = 0u;
#define GLA_LD16(dst, ptr) asm volatile("global_load_dwordx4 %0, %1, off" : "=v"(dst) : "v"(ptr) : "memory")
#define GLA_FETCH(R, c) do { const int c_ = (c) < NCH ? (c) : NCH - 1; \
        GLA_LD16(R.q[0], QTg + (size_t)c_ * GC * DK + tid * 8); GLA_LD16(R.q[1], QTg + (size_t)c_ * GC * DK + (tid + NTHR) * 8); \
        GLA_LD16(R.kt[0], KTT + (size_t)c_ * DK * GC + tid * 8); GLA_LD16(R.kt[1], KTT + (size_t)c_ * DK * GC + (tid + NTHR) * 8); \
        GLA_LD16(R.at, ATg + (size_t)c_ * GC * GC + tid * 8); \
        { const int tv_ = tid % (64 * VPR), s_ = tv_ / VPR, hf_ = tv_ % VPR; GLA_LD16(R.v, VB + (size_t)(c_ * GC + s_) * EB + hf_ * 8); } \
        asm volatile("global_load_dword %0, %1, off" : "=v"(R.dec) : "v"(DEC + c_ * DK + (tid & 127)) : "memory"); } while (0)
#define GLA_WAIT(R, n) asm volatile("s_waitcnt vmcnt(" #n ")" : "+v"(R.q[0]), "+v"(R.q[1]), "+v"(R.kt[0]), "+v"(R.kt[1]), "+v"(R.at), "+v"(R.v), "+v"(R.dec) :: "memory")
#define GLA_COMMIT(R, set) do { LAS bf16* QL_ = L0 + (set) * SET_E; LAS bf16* KTL_ = QL_ + 64 * PQ; LAS bf16* VTL_ = KTL_ + 128 * PS64; LAS bf16* ATL_ = VTL_ + SW * PS64; LAS float* DCL_ = (LAS float*)(ATL_ + 64 * PS64); \
        _Pragma("unroll") for (int i_ = 0; i_ < 2; ++i_) { const int p_ = tid + NTHR * i_; { const int r_ = p_ >> 4, cch_ = p_ & 15; *(LAS v4u*)(QL_ + r_ * PQ + cch_ * 8) = R.q[i_]; } \
            { const int r_ = p_ >> 3, cch_ = p_ & 7; *(LAS v4u*)(KTL_ + r_ * PS64 + cch_ * 8) = R.kt[i_]; } } \
        { const int r_ = tid >> 3, cch_ = tid & 7; *(LAS v4u*)(ATL_ + r_ * PS64 + cch_ * 8) = R.at; } \
        if (tid < 64 * VPR) { const int s_ = tid / VPR, hf_ = tid % VPR; const unsigned w_[4] = {R.v.x, R.v.y, R.v.z, R.v.w}; \
            _Pragma("unroll") for (int e_ = 0; e_ < 4; ++e_) { VTL_[(hf_ * 8 + 2 * e_) * PS64 + s_] = (bf16)(w_[e_] & 0xffffu); VTL_[(hf_ * 8 + 2 * e_ + 1) * PS64 + s_] = (bf16)(w_[e_] >> 16); } } \
        if (tid < 128) DCL_[tid] = R.dec; } while (0)
    pg8::f32x4 sacc[2][NVT];
#pragma unroll
    for (int e = 0; e < 2; ++e)
#pragma unroll
        for (int vt = 0; vt < NVT; ++vt) sacc[e][vt] = (pg8::f32x4){0.f, 0.f, 0.f, 0.f};
    GlaStage ra, rb, rc;
    GLA_FETCH(ra, 0); GLA_WAIT(ra, 0); GLA_COMMIT(ra, 0); GLA_FETCH(ra, 1); GLA_FETCH(rb, 2); GLA_FETCH(rc, 3);
    __syncthreads();
#define GLA_STEP(R, cc) { const int c = (cc); GLA_WAIT(R, 14); if (c + 1 < NCH) GLA_COMMIT(R, (c + 1) & 1); GLA_FETCH(R, c + 4);
    for (int c3 = 0; c3 < NCH; c3 += 3) {
        GLA_STEP(ra, c3)
        const LAS bf16* QL = L0 + (c & 1) * SET_E; const LAS bf16* KTL = QL + 64 * PQ; const LAS bf16* VTL = KTL + 128 * PS64; const LAS bf16* ATL = VTL + SW * PS64; const LAS float* DCL = (const LAS float*)(ATL + 64 * PS64);
        const LAS bf16* STc = STL + (c & 1) * SW * PQ; LAS bf16* STn = STL + ((c + 1) & 1) * SW * PQ;
        if (wave < 4) {
            const int ti = wave; pg8::f32x4 o[NVT];
#pragma unroll
            for (int vt = 0; vt < NVT; ++vt) o[vt] = (pg8::f32x4){0.f, 0.f, 0.f, 0.f};
#pragma unroll
            for (int kk = 0; kk < 2; ++kk) { const bf16x8 bf = ldfrag(ATL, 16 * ti + fr, PS64, 32 * kk + 8 * fq);
#pragma unroll
                for (int vt = 0; vt < NVT; ++vt) o[vt] = __builtin_amdgcn_mfma_f32_16x16x32_bf16(ldfrag(VTL, 16 * vt + fr, PS64, 32 * kk + 8 * fq), bf, o[vt], 0, 0, 0); }
#pragma unroll
            for (int kk = 0; kk < 4; ++kk) { const bf16x8 bf = ldfrag(QL, 16 * ti + fr, PQ, 32 * kk + 8 * fq);
#pragma unroll
                for (int vt = 0; vt < NVT; ++vt) o[vt] = __builtin_amdgcn_mfma_f32_16x16x32_bf16(ldfrag(STc, 16 * vt + fr, PQ, 32 * kk + 8 * fq), bf, o[vt], 0, 0, 0); }
#pragma unroll
            for (int vt = 0; vt < NVT; ++vt) *(GAS v2u*)(O + (size_t)(c * GC + 16 * ti + fr) * EB + 16 * vt + 4 * fq) = (v2u){pk2(o[vt].x, o[vt].y), pk2(o[vt].z, o[vt].w)};
        } else {
#pragma unroll
            for (int e = 0; e < 2; ++e) { const int dt = 2 * (wave - 4) + e; const pg8::f32x4 dc = *(const LAS pg8::f32x4*)(DCL + 16 * dt + 4 * fq);
                const bf16x8 a0 = ldfrag(KTL, 16 * dt + fr, PS64, 8 * fq), a1 = ldfrag(KTL, 16 * dt + fr, PS64, 32 + 8 * fq);
#pragma unroll
                for (int vt = 0; vt < NVT; ++vt) { pg8::f32x4 sv = sacc[e][vt];
                    sv = __builtin_amdgcn_mfma_f32_16x16x32_bf16(a0, ldfrag(VTL, 16 * vt + fr, PS64, 8 * fq), sv, 0, 0, 0);
                    sv = __builtin_amdgcn_mfma_f32_16x16x32_bf16(a1, ldfrag(VTL, 16 * vt + fr, PS64, 32 + 8 * fq), sv, 0, 0, 0);
                    sv = sv * dc; sacc[e][vt] = sv; v2u w; w.x = pk2(sv.x, sv.y); w.y = pk2(sv.z, sv.w);
                    *(LAS v2u*)(STn + (16 * vt + fr) * PQ + 16 * dt + 4 * fq) = w; } }
        }
        __syncthreads();
        }
        if (c3 + 1 < NCH) GLA_STEP(rb, c3 + 1)
        const LAS bf16* QL = L0 + (c & 1) * SET_E; const LAS bf16* KTL = QL + 64 * PQ; const LAS bf16* VTL = KTL + 128 * PS64; const LAS bf16* ATL = VTL + SW * PS64; const LAS float* DCL = (const LAS float*)(ATL + 64 * PS64);
        const LAS bf16* STc = STL + (c & 1) * SW * PQ; LAS bf16* STn = STL + ((c + 1) & 1) * SW * PQ;
        if (wave < 4) {
            const int ti = wave; pg8::f32x4 o[NVT];
#pragma unroll
            for (int vt = 0; vt < NVT; ++vt) o[vt] = (pg8::f32x4){0.f, 0.f, 0.f, 0.f};
#pragma unroll
            for (int kk = 0; kk < 2; ++kk) { const bf16x8 bf = ldfrag(ATL, 16 * ti + fr, PS64, 32 * kk + 8 * fq);
#pragma unroll
                for (int vt = 0; vt < NVT; ++vt) o[vt] = __builtin_amdgcn_mfma_f32_16x16x32_bf16(ldfrag(VTL, 16 * vt + fr, PS64, 32 * kk + 8 * fq), bf, o[vt], 0, 0, 0); }
#pragma unroll
            for (int kk = 0; kk < 4; ++kk) { const bf16x8 bf = ldfrag(QL, 16 * ti + fr, PQ, 32 * kk + 8 * fq);
#pragma unroll
                for (int vt = 0; vt < NVT; ++vt) o[vt] = __builtin_amdgcn_mfma_f32_16x16x32_bf16(ldfrag(STc, 16 * vt + fr, PQ, 32 * kk + 8 * fq), bf, o[vt], 0, 0, 0); }
#pragma unroll
            for (int vt = 0; vt < NVT; ++vt) *(GAS v2u*)(O + (size_t)(c * GC + 16 * ti + fr) * EB + 16 * vt + 4 * fq) = (v2u){pk2(o[vt].x, o[vt].y), pk2(o[vt].z, o[vt].w)};
        } else {
#pragma unroll
            for (int e = 0; e < 2; ++e) { const int dt = 2 * (wave - 4) + e; const pg8::f32x4 dc = *(const LAS pg8::f32x4*)(DCL + 16 * dt + 4 * fq);
                const bf16x8 a0 = ldfrag(KTL, 16 * dt + fr, PS64, 8 * fq), a1 = ldfrag(KTL, 16 * dt + fr, PS64, 32 + 8 * fq);
#pragma unroll
                for (int vt = 0; vt < NVT; ++vt) { pg8::f32x4 sv = sacc[e][vt];
                    sv = __builtin_amdgcn_mfma_f32_16x16x32_bf16(a0, ldfrag(VTL, 16 * vt + fr, PS64, 8 * fq), sv, 0, 0, 0);
                    sv = __builtin_amdgcn_mfma_f32_16x16x32_bf16(a1, ldfrag(VTL, 16 * vt + fr, PS64, 32 + 8 * fq), sv, 0, 0, 0);
                    sv = sv * dc; sacc[e][vt] = sv; v2u w; w.x = pk2(sv.x, sv.y); w.y = pk2(sv.z, sv.w);
                    *(LAS v2u*)(STn + (16 * vt + fr) * PQ + 16 * dt + 4 * fq) = w; } }
        }
        __syncthreads();
        }
        if (c3 + 2 < NCH) GLA_STEP(rc, c3 + 2)
        const LAS bf16* QL = L0 + (c & 1) * SET_E; const LAS bf16* KTL = QL + 64 * PQ; const LAS bf16* VTL = KTL + 128 * PS64; const LAS bf16* ATL = VTL + SW * PS64; const LAS float* DCL = (const LAS float*)(ATL + 64 * PS64);
        const LAS bf16* STc = STL + (c & 1) * SW * PQ; LAS bf16* STn = STL + ((c + 1) & 1) * SW * PQ;
        if (wave < 4) {
            const int ti = wave; pg8::f32x4 o[NVT];
#pragma unroll
            for (int vt = 0; vt < NVT; ++vt) o[vt] = (pg8::f32x4){0.f, 0.f, 0.f, 0.f};
#pragma unroll
            for (int kk = 0; kk < 2; ++kk) { const bf16x8 bf = ldfrag(ATL, 16 * ti + fr, PS64, 32 * kk + 8 * fq);
#pragma unroll
                for (int vt = 0; vt < NVT; ++vt) o[vt] = __builtin_amdgcn_mfma_f32_16x16x32_bf16(ldfrag(VTL, 16 * vt + fr, PS64, 32 * kk + 8 * fq), bf, o[vt], 0, 0, 0); }
#pragma unroll
            for (int kk = 0; kk < 4; ++kk) { const bf16x8 bf = ldfrag(QL, 16 * ti + fr, PQ, 32 * kk + 8 * fq);
#pragma unroll
                for (int vt = 0; vt < NVT; ++vt) o[vt] = __builtin_amdgcn_mfma_f32_16x16x32_bf16(ldfrag(STc, 16 * vt + fr, PQ, 32 * kk + 8 * fq), bf, o[vt], 0, 0, 0); }
#pragma unroll
            for (int vt = 0; vt < NVT; ++vt) *(GAS v2u*)(O + (size_t)(c * GC + 16 * ti + fr) * EB + 16 * vt + 4 * fq) = (v2u){pk2(o[vt].x, o[vt].y), pk2(o[vt].z, o[vt].w)};
        } else {
#pragma unroll
            for (int e = 0; e < 2; ++e) { const int dt = 2 * (wave - 4) + e; const pg8::f32x4 dc = *(const LAS pg8::f32x4*)(DCL + 16 * dt + 4 * fq);
                const bf16x8 a0 = ldfrag(KTL, 16 * dt + fr, PS64, 8 * fq), a1 = ldfrag(KTL, 16 * dt + fr, PS64, 32 + 8 * fq);
#pragma unroll
                for (int vt = 0; vt < NVT; ++vt) { pg8::f32x4 sv = sacc[e][vt];
                    sv = __builtin_amdgcn_mfma_f32_16x16x32_bf16(a0, ldfrag(VTL, 16 * vt + fr, PS64, 8 * fq), sv, 0, 0, 0);
                    sv = __builtin_amdgcn_mfma_f32_16x16x32_bf16(a1, ldfrag(VTL, 16 * vt + fr, PS64, 32 + 8 * fq), sv, 0, 0, 0);
                    sv = sv * dc; sacc[e][vt] = sv; v2u w; w.x = pk2(sv.x, sv.y); w.y = pk2(sv.z, sv.w);
                    *(LAS v2u*)(STn + (16 * vt + fr) * PQ + 16 * dt + 4 * fq) = w; } }
        }
        __syncthreads();
        }
    }
#undef GLA_STEP
    GLA_WAIT(ra, 0); GLA_WAIT(rb, 0); GLA_WAIT(rc, 0);
    if (wave >= 4) { float* SP = F.out + OUT_SP + (size_t)bh * DK * DV + j * SW;
#pragma unroll
        for (int e = 0; e < 2; ++e) { const int dt = 2 * (wave - 4) + e;
#pragma unroll
            for (int vt = 0; vt < NVT; ++vt)
#pragma unroll
                for (int i = 0; i < 4; ++i) SP[(size_t)(16 * dt + 4 * fq + i) * DV + 16 * vt + fr] = sacc[e][vt][i]; } }
#undef GLA_FETCH
#undef GLA_COMMIT
#undef GLA_WAIT
#undef GLA_LD16
    if (fuse_norm) {
        asm volatile("s_waitcnt vmcnt(0)" ::: "memory");
        __syncthreads();
        if (tid == 0) { unsigned* cnt = (unsigned*)(F.ws + WS_CTL) + CW_GRP + 64 * bh;
            __builtin_amdgcn_fence(__ATOMIC_RELEASE, "agent"); asm volatile("s_waitcnt vmcnt(0)" ::: "memory");
            (void)__hip_atomic_fetch_add(cnt, 1u, __ATOMIC_RELAXED, __HIP_MEMORY_SCOPE_AGENT); }
    }
}
__device__ __forceinline__ void head_norm(Frame& F, int bh, int rlo, unsigned need) {
    const int tid = (int)threadIdx.x, lane = tid & 63, wave = F.wave, b = bh >> 2, h = bh & 3;
    if (tid == 0) { unsigned* cnt = (unsigned*)(F.ws + WS_CTL) + CW_GRP + 64 * bh;
        unsigned sp = 0; while (__hip_atomic_load(cnt, __ATOMIC_RELAXED, __HIP_MEMORY_SCOPE_AGENT) < need) { __builtin_amdgcn_s_sleep(2); if (++sp > (1u << 20)) break; }
        __builtin_amdgcn_fence(__ATOMIC_ACQUIRE, "agent"); asm volatile("s_waitcnt vmcnt(0)" ::: "memory"); }
    __syncthreads();
    const bf16* Oh = (const bf16*)(F.ws + WS_O) + (size_t)(b * SEQ) * EB + h * DV; const bf16* SZB = (const bf16*)(F.ws + WS_SZB) + (size_t)(b * SEQ) * EB + h * DV; bf16* Y = (bf16*)(F.ws + WS_Y) + (size_t)(b * SEQ) * DM + EA + h * DV;
    const f32x4 go = *(const GAS f32x4*)(F.g_o + h * DV + 4 * lane);
    constexpr int NB = 16; v2u ob[NB], zz[NB];
#pragma unroll
    for (int q = 0; q < NB; ++q) { const int row = rlo + wave + NWAVES * q; ob[q] = *(const GAS v2u*)(Oh + (size_t)row * EB + 4 * lane); zz[q] = *(const GAS v2u*)(SZB + (size_t)row * EB + 4 * lane); }
#pragma unroll
    for (int q = 0; q < NB; ++q) { const int row = rlo + wave + NWAVES * q;
        const f32x4 o = (f32x4){bflo(ob[q].x), bfhi(ob[q].x), bflo(ob[q].y), bfhi(ob[q].y)};
        const float ss = wave_sum((o.x * o.x + o.y * o.y) + (o.z * o.z + o.w * o.w)); const float rs = 1.0f / sqrtf(ss * (1.f / DV) + EPS);
        v2u w; w.x = pk2(o.x * rs * go.x * bflo(zz[q].x), o.y * rs * go.y * bfhi(zz[q].x)); w.y = pk2(o.z * rs * go.z * bflo(zz[q].y), o.w * rs * go.w * bfhi(zz[q].y));
        *(GAS v2u*)(Y + (size_t)row * DM + 4 * lane) = w; }
}

struct Args { const float* in[19]; float* out; unsigned char* ws; int ph_lo, ph_hi, li, pad; };
constexpr int NPHASE = 11;
__global__ void __launch_bounds__(NTHR, 2) fwd_kernel(Args args) {
    extern __shared__ __attribute__((aligned(16))) unsigned char lds[];
    Frame F;
    F.lds = (LAS unsigned char*)lds; F.ws = args.ws; F.out = args.out;
    F.wave = __builtin_amdgcn_readfirstlane((int)threadIdx.x >> 6);
    F.G = gridDim.x; { const int bx = blockIdx.x; F.vcu = (F.G % 8 == 0) ? (bx % 8) * (F.G / 8) + bx / 8 : bx; }
    F.xp = args.in[0]; F.xs = args.in[1]; F.pp = args.in[2]; F.ps = args.in[3]; F.st0 = args.in[4]; F.g_pre = args.in[5]; F.w_in = args.in[6]; F.g_v = args.in[7]; F.w_s = args.in[8]; F.b_s = args.in[9];
    F.w_a2 = args.in[10]; F.b_a = args.in[11]; F.g_o = args.in[12]; F.w_pa = args.in[13]; F.w_pb = args.in[14]; F.w_o = args.in[15]; F.g_post = args.in[16]; F.w_pg = args.in[17]; F.w_pe = args.in[18];
    volatile LAS unsigned* MISC = (volatile LAS unsigned*)(F.lds + MISC_OFF);
    if (((int)threadIdx.x) < 64) MISC[((int)threadIdx.x)] = 0u;
    __syncthreads();
    XcdBarrier bar; bar.bar = (unsigned*)(F.ws + WS_CTL) + CW_BAR + args.li * XCD_BAR_WORDS; bar.x = 0; bar.st = nullptr;
    const int lo = args.ph_lo, hi = args.ph_hi;
    if (hi - lo > 1) bar = xcd_barrier_post(bar.bar, MISC + 8);
#define IN(k) (lo <= (k) && (k) < hi)
#define SEAM(k) do { if (IN(k) && IN((k) + 1)) xcd_barrier(bar); } while (0)
    unsigned char* ws = F.ws;

    if (IN(0)) { p0_prologue(F); } SEAM(0);

    if (IN(1)) {
        pg8::Gemm g{(const bf16*)(ws + WS_XN), (const bf16*)(ws + WS_W1T), DM, DM}; pg8::StaticOrder S; S.init(MT, N1, DM, F.G, (int)blockIdx.x);
        EpiG1 E{ws, F.b_a};
        pg8::gemm_phase<EpiG1, pg8::StaticOrder>(F.lds, g, S, E);
        { const int nfullc = S.nwg % F.G;
          pg8::Gemm g2{(const bf16*)(ws + WS_PBF), (const bf16*)(ws + WS_WPE), PLE, PLE}; pg8::ESampleOrder S2{nfullc ? F.G - nfullc : F.G, nfullc ? (int)blockIdx.x - nfullc : (int)blockIdx.x};
          EpiBf E2{(bf16*)(ws + WS_ES) - (size_t)MP * DM, DM};
          pg8::gemm_phase<EpiBf, pg8::ESampleOrder>(F.lds, g2, S2, E2); }
    } SEAM(1);

    const bool hetero = (F.G == 256);
    const bool fuse_norm = hetero || (F.G % 16) == 0;
    if (IN(2)) {
        if (hetero) { for (int u = F.vcu; u < 512; u += F.G) { if (u < 256) prep_unit(F, u); else gate_prompt_unit(F, u - 256); } }
        else { for (int u = F.vcu; u < 1024; u += F.G) { if (u < 256) gate_prompt_unit(F, u); else if (u < 768) sample_unit(F, u - 256); else prep_unit(F, u - 768); } }
    } SEAM(2);

    if (IN(3)) {
        if (hetero) { const int xcd = F.vcu >> 5, l = F.vcu & 31;
            if (l < 16) gla_unit<2>(F, (xcd * 2 + (l >> 3)) * 8 + (l & 7), true);
            else { for (int u = xcd * 16 + (l - 16); u < 512; u += 128) sample_unit(F, u); }
            __syncthreads(); head_norm(F, F.vcu >> 4, 128 * (F.vcu & 15), 8u); }
        else { for (int u = F.vcu; u < 256; u += F.G) gla_unit<1>(F, u, fuse_norm);
               if (fuse_norm) { for (int u = F.vcu; u < 256; u += F.G) head_norm(F, u >> 4, 128 * (u & 15), 16u); } }
    } SEAM(3);

    if (IN(4) && !fuse_norm) {
        const int gw = F.vcu * NWAVES + F.wave, NGW = F.G * NWAVES; const bf16* O = (const bf16*)(ws + WS_O); const bf16* SZB = (const bf16*)(ws + WS_SZB); bf16* Y = (bf16*)(ws + WS_Y);
        for (int m = gw; m < MP; m += NGW) {
#pragma unroll
            for (int h = 0; h < HB; ++h) { const v2u ob = *(const GAS v2u*)(O + (size_t)m * EB + h * DV + 4 * ((int)(threadIdx.x & 63u))); const f32x4 o = (f32x4){bflo(ob.x), bfhi(ob.x), bflo(ob.y), bfhi(ob.y)};
                const float ss = wave_sum((o.x * o.x + o.y * o.y) + (o.z * o.z + o.w * o.w)); const float rs = 1.0f / sqrtf(ss * (1.f / DV) + EPS);
                const f32x4 go = *(const GAS f32x4*)(F.g_o + h * DV + 4 * ((int)(threadIdx.x & 63u))); const v2u zz = *(const GAS v2u*)(SZB + (size_t)m * EB + h * DV + 4 * ((int)(threadIdx.x & 63u)));
                v2u w; w.x = pk2(o.x * rs * go.x * bflo(zz.x), o.y * rs * go.y * bfhi(zz.x)); w.y = pk2(o.z * rs * go.z * bflo(zz.y), o.w * rs * go.w * bfhi(zz.y));
                *(GAS v2u*)(Y + (size_t)m * DM + EA + h * DV + 4 * ((int)(threadIdx.x & 63u))) = w; } }
    } if (!fuse_norm) SEAM(4);

    bf16* const slabA_lo = (bf16*)(ws + WS_SLABA); bf16* const slabA_hi = slabA_lo + (size_t)4 * MS * DM;
    bf16* const slabB_lo = (bf16*)(ws + WS_GA); bf16* const slabB_hi = slabB_lo + (size_t)4 * MS * DM;
    if (IN(5)) {
        { pg8::Gemm g{(const bf16*)(ws + WS_Y), (const bf16*)(ws + WS_WPAB), DM, DM}; pg8::TailOrder S{F.G, (int)blockIdx.x, (int)((blockIdx.x >> 6) & 1)};
          EpiG2 E{ws + WS_GA, ws + WS_GB, (bf16*)(ws + WS_M), slabA_lo, slabA_hi};
          pg8::gemm_phase<EpiG2, pg8::TailOrder>(F.lds, g, S, E); }
        { pg8::Gemm g{(const bf16*)(ws + WS_PBF), (const bf16*)(ws + WS_WPE), PLE, PLE}; pg8::EPromptOrder S{F.G, (int)blockIdx.x};
          EpiBf E{(bf16*)(ws + WS_E), DM};
          pg8::gemm_phase<EpiBf, pg8::EPromptOrder>(F.lds, g, S, E); }
    } SEAM(5);

    if (IN(6)) {
        const int gt = F.vcu * NTHR + ((int)threadIdx.x), NGT = F.G * NTHR; const unsigned char* GA = ws + WS_GA; const unsigned char* GB = ws + WS_GB; bf16* Mo = (bf16*)(ws + WS_M);
        for (int p = gt; p < MS * DM / 8; p += NGT) { const size_t off = (size_t)p * 8, og = (size_t)MP * DM + off;
            f32x4 a0, a1, b0, b1; slab_sum8(slabA_lo, slabA_hi, off, 0, 4, a0, a1); slab_sum8(slabA_lo, slabA_hi, off, 4, 8, b0, b1);
            float fa[8], fb[8]; u8x8_to_f32(*(const GAS v2u*)(GA + og), fa); u8x8_to_f32(*(const GAS v2u*)(GB + og), fb); const float k = 1.f / 255.f; v4u w;
            w.x = pk2((fa[0] * a0.x + fb[0] * b0.x) * k, (fa[1] * a0.y + fb[1] * b0.y) * k); w.y = pk2((fa[2] * a0.z + fb[2] * b0.z) * k, (fa[3] * a0.w + fb[3] * b0.w) * k);
            w.z = pk2((fa[4] * a1.x + fb[4] * b1.x) * k, (fa[5] * a1.y + fb[5] * b1.y) * k); w.w = pk2((fa[6] * a1.z + fb[6] * b1.z) * k, (fa[7] * a1.w + fb[7] * b1.w) * k);
            *(GAS v4u*)(Mo + og) = w; }
    } SEAM(6);

    if (IN(7)) {
        pg8::Gemm g{(const bf16*)(ws + WS_M), (const bf16*)(ws + WS_WO), DM, DM}; pg8::TailOrder S{F.G, (int)blockIdx.x, (int)((blockIdx.x >> 6) & 1)};
        EpiG3 E{(bf16*)(ws + WS_T), (float*)(ws + WS_TSS), slabB_lo, slabB_hi, hetero ? 1 : 0, (bf16*)(ws + WS_H), (float*)(ws + WS_TSS), (unsigned*)(ws + WS_CTL) + CW_PAN, F.xp, F.g_post, F.lds + pg8::STAGE_BYTES};
        pg8::gemm_phase<EpiG3, pg8::TailOrder>(F.lds, g, S, E);
    } SEAM(7);

    if (IN(8)) {
        const bf16* T = (const bf16*)(ws + WS_T); const float* TSS = (const float*)(ws + WS_TSS); bf16* H = (bf16*)(ws + WS_H);
        for (int r = F.wave * F.G + F.vcu; r < MS; r += NWAVES * F.G) { const int m = MP + r;
            f32x4 t4[8]; float ss = 0.f;
#pragma unroll
            for (int j2 = 0; j2 < 8; ++j2) { t4[j2] = slab_sum4(slabB_lo, slabB_hi, (size_t)r * DM + 4 * ((int)(threadIdx.x & 63u)) + 256 * j2); ss += (t4[j2].x * t4[j2].x + t4[j2].y * t4[j2].y) + (t4[j2].z * t4[j2].z + t4[j2].w * t4[j2].w); }
            const float rs = 1.0f / sqrtf(wave_sum(ss) * (1.f / DM) + EPS);
            const GAS f32x4* xr = (const GAS f32x4*)xrow(F, m) + ((int)(threadIdx.x & 63u)); const GAS f32x4* gr = (const GAS f32x4*)F.g_post + ((int)(threadIdx.x & 63u)); GAS v2u* ho = (GAS v2u*)(H + (size_t)m * DM) + ((int)(threadIdx.x & 63u));
#pragma unroll
            for (int j2 = 0; j2 < 8; ++j2) { const f32x4 xv = xr[64 * j2], gg = gr[64 * j2], tv = t4[j2]; v2u o, tb; tb.x = pk2(tv.x, tv.y); tb.y = pk2(tv.z, tv.w);
                o.x = pk2(xv.x + bflo(tb.x) * rs * gg.x, xv.y + bfhi(tb.x) * rs * gg.y); o.y = pk2(xv.z + bflo(tb.y) * rs * gg.z, xv.w + bfhi(tb.y) * rs * gg.w); ho[64 * j2] = o; }
        }
        const int gw = F.vcu * NWAVES + F.wave, NGW = F.G * NWAVES;
        for (int m = hetero ? MP : gw; m < MP; m += NGW) {
            float ss = ((int)(threadIdx.x & 63u)) < 32 ? TSS[(size_t)m * 32 + ((int)(threadIdx.x & 63u))] : 0.f; ss = wave_sum(ss); const float rs = 1.0f / sqrtf(ss * (1.f / DM) + EPS);
            const GAS f32x4* xr = (const GAS f32x4*)xrow(F, m) + ((int)(threadIdx.x & 63u)); const GAS f32x4* gr = (const GAS f32x4*)F.g_post + ((int)(threadIdx.x & 63u)); const GAS v2u* tr = (const GAS v2u*)(T + (size_t)m * DM) + ((int)(threadIdx.x & 63u)); GAS v2u* ho = (GAS v2u*)(H + (size_t)m * DM) + ((int)(threadIdx.x & 63u));
#pragma unroll
            for (int j2 = 0; j2 < 8; ++j2) { const f32x4 xv = xr[64 * j2], gg = gr[64 * j2]; const v2u tv = tr[64 * j2]; v2u o;
                o.x = pk2(xv.x + bflo(tv.x) * rs * gg.x, xv.y + bfhi(tv.x) * rs * gg.y); o.y = pk2(xv.z + bflo(tv.y) * rs * gg.z, xv.w + bfhi(tv.y) * rs * gg.w); ho[64 * j2] = o; }
        }
    } SEAM(8);

    if (IN(9)) {
        pg8::Gemm g{(const bf16*)(ws + WS_H), (const bf16*)(ws + WS_WPG), DM, DM}; pg8::TailOrder S{F.G, (int)blockIdx.x, (int)((blockIdx.x >> 6) & 1)};
        EpiG4 E{(const bf16*)(ws + WS_H), (const bf16*)(ws + WS_E), F.out + OUT_Y, slabB_lo, slabB_hi};
        pg8::gemm_phase<EpiG4, pg8::TailOrder>(F.lds, g, S, E);
    } SEAM(9);

    if (IN(10)) {
        const int gt = F.vcu * NTHR + ((int)threadIdx.x), NGT = F.G * NTHR; const bf16* Hb = (const bf16*)(ws + WS_H); const bf16* Es = (const bf16*)(ws + WS_ES); float* out = F.out + OUT_Y;
        for (int p = gt; p < MS * DM / 4; p += NGT) { const size_t off = (size_t)p * 4, og = (size_t)MP * DM + off;
            const f32x4 a = slab_sum4(slabB_lo, slabB_hi, off); const v2u hv = *(const GAS v2u*)(Hb + og), ev = *(const GAS v2u*)(Es + off);
            f32x4 o; o.x = bflo(hv.x) + sigm(a.x) * bflo(ev.x); o.y = bfhi(hv.x) + sigm(a.y) * bfhi(ev.x); o.z = bflo(hv.y) + sigm(a.z) * bflo(ev.y); o.w = bfhi(hv.y) + sigm(a.w) * bfhi(ev.y);
            *(GAS f32x4*)(out + og) = o; }
    }
#undef IN
#undef SEAM
}

__global__ void dbg_dump(const unsigned short* src, float* dst, size_t n) { for (size_t i = blockIdx.x * (size_t)blockDim.x + threadIdx.x; i < n; i += (size_t)gridDim.x * blockDim.x) dst[i] = __uint_as_float((unsigned)src[i] << 16); }
extern "C" void kernel_launch(void* const* d_in, const int* in_sizes, int n_in, void* d_out, int out_size, void* d_ws, size_t ws_size, hipStream_t stream) {
    static int grid = 0;
    if (grid == 0) {
        if (n_in != 19 || ws_size < WS_END) { fprintf(stderr, "kernel_launch: built for 19 inputs and >= %zu bytes of workspace; got n_in %d, ws %zu\n", (size_t)WS_END, n_in, ws_size); grid = -1; return; }
        int dev = 0, cus = 0, per_cu = 0;
        if (hipGetDevice(&dev) != hipSuccess || hipDeviceGetAttribute(&cus, hipDeviceAttributeMultiprocessorCount, dev) != hipSuccess) { grid = -1; return; }
        if (hipFuncSetAttribute((const void*)fwd_kernel, hipFuncAttributeMaxDynamicSharedMemorySize, LDS_BYTES) != hipSuccess) { fprintf(stderr, "kernel_launch: hipFuncSetAttribute failed\n"); grid = -1; return; }
        if (hipOccupancyMaxActiveBlocksPerMultiprocessor(&per_cu, (const void*)fwd_kernel, NTHR, LDS_BYTES) != hipSuccess || per_cu < 1) { fprintf(stderr, "kernel_launch: occupancy query says %d blocks per CU\n", per_cu); per_cu = 1; }
        (void)hipGetLastError();
        grid = cus;
    }
    if (grid < 0) return;
    (void)hipMemsetAsync((char*)d_ws + WS_CTL, 0, CTL_ZERO_BYTES, stream);
    Args a{};
    for (int i = 0; i < 19; ++i) a.in[i] = (const float*)d_in[i];
    a.out = (float*)d_out; a.ws = (unsigned char*)d_ws;
#if MK_N_LAUNCHES == 1
    a.ph_lo = 0; a.ph_hi = NPHASE; a.li = 0;
    hipLaunchKernelGGL(fwd_kernel, dim3(grid), dim3(NTHR), LDS_BYTES, stream, a);
#else
#ifndef DBG_LAST
#define DBG_LAST (NPHASE - 1)
#endif
    if (DBG_LAST < NPHASE - 1) (void)hipMemsetAsync(d_out, 0, (size_t)out_size * 4, stream);
    for (int li = 0; li <= DBG_LAST; ++li) { const int rep = 1; for (int r = 0; r < rep; ++r) { a.ph_lo = li; a.ph_hi = li + 1; a.li = 0; hipLaunchKernelGGL(fwd_kernel, dim3(grid), dim3(NTHR), LDS_BYTES, stream, a); } }
#ifdef DBG_DUMP
    hipLaunchKernelGGL(dbg_dump, dim3(2048), dim3(256), 0, stream, (const unsigned short*)((char*)d_ws + DBG_DUMP), (float*)d_out, (size_t)MT * DM);
#endif
#endif
}
```

```cpp
#include <hip/hip_runtime.h>
#include <cstdio>
#include <cstdint>

#ifndef MK_N_LAUNCHES
#define MK_N_LAUNCHES 1
#endif

namespace pg8 {
#define PG8_LAS __attribute__((address_space(3)))
typedef unsigned short bf16_t;
typedef short bf16x8 __attribute__((ext_vector_type(8)));
typedef float f32x4 __attribute__((ext_vector_type(4)));
typedef unsigned u32x4 __attribute__((ext_vector_type(4)));
typedef unsigned u32x2 __attribute__((ext_vector_type(2)));
constexpr int BM = 256, BK = 64, HALF = 128, HTB = HALF * BK * 2, STAGE_BYTES = 8 * HTB, NXCD = 8, WGM = 8;

__host__ __device__ __forceinline__ int lds_byte(int r, int c) { const int st = (r >> 4) * 2 + (c >> 5), rr = r & 15, cc = c & 31, ob = rr * 64 + cc * 2; return st * 1024 + (ob ^ (((ob >> 9) & 1) << 5)); }
__host__ __device__ __forceinline__ void stage_rc(int b, int& R, int& C) { const int st = b / 1024, sb = b % 1024, swz = sb ^ (((sb >> 9) & 1) << 5); R = (st >> 1) * 16 + swz / 64; C = (st & 1) * 32 + (swz % 64) / 2; }
__host__ __device__ __forceinline__ int perm32(int rho) { const int n = rho >> 4, i = rho & 15; return 8 * (i >> 2) + 4 * n + (i & 3); }

struct Unit { int pm, pn, kt0, nkt, kind; };
struct Gemm { const bf16_t* A; const bf16_t* Bt; int lda, ldb; };

struct StaticOrder {
    int nM, nN, nwg, G, c, nkt;
    __host__ __device__ void init(int M, int N, int K, int G_, int c_) { nM = M / BM; nN = N / BM; nwg = nM * nN; G = G_; c = c_; nkt = K / BK; }
    __host__ __device__ bool next(int i, Unit& u) const {
        const long L = (long)i * G + c; if (L >= nwg) return false;
        int wgid = (int)L; { const int q = nwg / NXCD, r = nwg % NXCD, xcd = wgid % NXCD, off = wgid / NXCD; wgid = (xcd < r ? xcd * (q + 1) : r * (q + 1) + (xcd - r) * q) + off; }
        const int nig = WGM * nN, gid = wgid / nig, fm = gid * WGM, gsz = (nM - fm) < WGM ? (nM - fm) : WGM;
        u.pm = fm + ((wgid % nig) % gsz); u.pn = (wgid % nig) / gsz; u.kt0 = 0; u.nkt = nkt; u.kind = 0; return true;
    }
};
struct TailOrder {
    int G, c, swap;
    __host__ __device__ bool next(int i, Unit& u) const {
        long L = (long)i * G + c; if (swap && G == 256 && i < 2) L = (long)(1 - i) * G + c;
        if (L < 256) { const int x = (int)L & 7, kk = (int)L >> 3; u.pm = 4 * x + (kk >> 3); u.pn = kk & 7; u.kt0 = 0; u.nkt = 32; u.kind = 0; return true; }
        if (L < 512) { const int l2 = (int)L - 256, x = l2 & 7, kk = l2 >> 3; u.pm = 32 + (kk >> 3); u.pn = kk & 7; u.kt0 = 4 * x; u.nkt = 4; u.kind = 1; return true; }
        return false;
    }
};
struct EPromptOrder {
    int G, c;
    __host__ __device__ bool next(int i, Unit& u) const {
        const long L = (long)i * G + c; if (L >= 256) return false;
        const int x = (int)L & 7, kk = (int)L >> 3; u.pm = 4 * x + (kk >> 3); u.pn = kk & 7; u.kt0 = 0; u.nkt = 4; u.kind = 0; return true; }
};
struct ESampleOrder {
    int G2, c2;
    __host__ __device__ bool next(int i, Unit& u) const {
        if (c2 < 0 || G2 <= 0) return false; const long L = (long)i * G2 + c2; if (L >= 32) return false;
        u.pm = 32 + ((int)L >> 3); u.pn = (int)L & 7; u.kt0 = 0; u.nkt = 4; u.kind = 0; return true; }
};

typedef __bf16 bf2_t __attribute__((ext_vector_type(2)));
typedef float f2_t __attribute__((ext_vector_type(2)));
__device__ __forceinline__ unsigned cvt_pk_bf16(float lo, float hi) { return __builtin_bit_cast(unsigned, __builtin_convertvector((f2_t){lo, hi}, bf2_t)); }

template <class Epi, class Sched>
__device__ __forceinline__ void gemm_phase(PG8_LAS unsigned char* lds, const Gemm g, const Sched& S, const Epi& E) {
    const int tid = threadIdx.x, wid = __builtin_amdgcn_readfirstlane(tid >> 6), lane = tid & 63, wr = wid >> 2, wc = wid & 3, fr = lane & 15, fq = lane >> 4;
    unsigned voffA[2], voffB[2];
#pragma unroll
    for (int i = 0; i < 2; ++i) { int R, C; stage_rc(tid * 16 + i * 8192, R, C); const int Rb = Epi::PERM ? ((R & ~31) + perm32(R & 31)) : R;
        voffA[i] = (unsigned)(R * g.lda + C) * 2u; voffB[i] = (unsigned)(Rb * g.ldb + C) * 2u; }
    const size_t kstep = (size_t)(BK * 2);
    const size_t hstepA = (size_t)HALF * g.lda * 2, hstepB = (size_t)HALF * g.ldb * 2;
    const size_t tstepA = 2 * hstepA, tstepB = 2 * hstepB;
    const unsigned ldsw = (unsigned)wid * 1024u;
    const int aoff = lds_byte(wr * 64 + fr, fq * 8), boff = lds_byte(wc * 32 + fr, fq * 8);
#define PG8_SA(b, h) (((b) * 2 + (h)) * HTB)
#define PG8_SB(b, h) ((4 + (b) * 2 + (h)) * HTB)
#define PG8_STAGE(bufoff, gbase, voff) do { _Pragma("unroll") for (int _i = 0; _i < 2; ++_i) \
        __builtin_amdgcn_global_load_lds((const unsigned*)((const char*)(gbase) + (voff)[_i]), (PG8_LAS unsigned*)(lds + (bufoff) + ldsw + _i * 8192), 16, 0, 0); } while (0)
#define PG8_LDA(dst, b, h) do { _Pragma("unroll") for (int m = 0; m < 4; ++m) _Pragma("unroll") for (int k = 0; k < 2; ++k) dst[m][k] = *(const PG8_LAS bf16x8*)(lds + PG8_SA(b, h) + aoff + m * 2048 + k * 1024); } while (0)
#define PG8_LDB(dst, b, h) do { _Pragma("unroll") for (int n = 0; n < 2; ++n) _Pragma("unroll") for (int k = 0; k < 2; ++k) dst[n][k] = *(const PG8_LAS bf16x8*)(lds + PG8_SB(b, h) + boff + n * 2048 + k * 1024); } while (0)
#define PG8_MMA(ai, bj, At, Bt) do { __builtin_amdgcn_s_setprio(1); _Pragma("unroll") for (int m = 0; m < 4; ++m) _Pragma("unroll") for (int n = 0; n < 2; ++n) _Pragma("unroll") for (int k = 0; k < 2; ++k) \
        acc[ai][bj][m][n] = __builtin_amdgcn_mfma_f32_16x16x32_bf16(Bt[n][k], At[m][k], acc[ai][bj][m][n], 0, 0, 0); __builtin_amdgcn_s_setprio(0); } while (0)
#define PG8_WAIT_V(n) asm volatile("s_waitcnt vmcnt(" #n ")" ::: "memory")
#define PG8_WAIT_L(n) asm volatile("s_waitcnt lgkmcnt(" #n ")" ::: "memory")
#define PG8_BAR __builtin_amdgcn_s_barrier()
#define PG8_SCHED __builtin_amdgcn_sched_barrier(0)
    Unit cur, nxt; int ui = 0;
    if (!S.next(0, cur)) return;
    f32x4 acc[2][2][4][2];
#pragma unroll
    for (int a = 0; a < 2; ++a)
#pragma unroll
        for (int b = 0; b < 2; ++b)
#pragma unroll
            for (int m = 0; m < 4; ++m)
#pragma unroll
                for (int n = 0; n < 2; ++n) acc[a][b][m][n] = (f32x4){0.f, 0.f, 0.f, 0.f};
    bf16x8 At[4][2], B0[2][2], B1[2][2];
    const char* cA = (const char*)g.A + (size_t)cur.pm * tstepA + (size_t)cur.kt0 * kstep; const char* cB = (const char*)g.Bt + (size_t)cur.pn * tstepB + (size_t)cur.kt0 * kstep;
    int nt = cur.nkt; asm volatile("" : "+s"(nt));
    PG8_STAGE(PG8_SB(0, 0), cB, voffB); PG8_STAGE(PG8_SB(0, 1), cB + hstepB, voffB); PG8_STAGE(PG8_SA(0, 0), cA, voffA); PG8_STAGE(PG8_SA(0, 1), cA + hstepA, voffA);
    if (wr == 1) PG8_BAR;
    PG8_WAIT_V(2); PG8_BAR;
    PG8_STAGE(PG8_SB(1, 0), cB + kstep, voffB); PG8_STAGE(PG8_SA(1, 0), cA + kstep, voffA); PG8_STAGE(PG8_SB(1, 1), cB + hstepB + kstep, voffB);
    PG8_WAIT_V(6); PG8_BAR;
    for (;;) {
        const bool has_next = S.next(ui + 1, nxt);
        const char* nA = has_next ? (const char*)g.A + (size_t)nxt.pm * tstepA + (size_t)nxt.kt0 * kstep : cA; const char* nB = has_next ? (const char*)g.Bt + (size_t)nxt.pn * tstepB + (size_t)nxt.kt0 * kstep : cB;
        for (int t = 0; t < nt; t += 2) {
            const bool last = (t == nt - 2);
            const char* a1 = cA + (size_t)(t + 1) * kstep;
            const char* a2 = last ? nA : cA + (size_t)(t + 2) * kstep; const char* b2 = last ? nB : cB + (size_t)(t + 2) * kstep;
            const char* a3 = a2 + kstep; const char* b3 = b2 + kstep;
            if constexpr (Epi::HAS_MID) { if (cur.kind == 0 && t == (nt >> 1)) E.mid(acc, cur, wr, wc, fr, fq); }
            PG8_LDB(B0, 0, 0); PG8_LDB(B1, 0, 1); PG8_SCHED; PG8_LDA(At, 0, 0); PG8_STAGE(PG8_SA(1, 1), a1 + hstepA, voffA);
            PG8_WAIT_V(8); PG8_WAIT_L(0); PG8_BAR; PG8_MMA(0, 0, At, B0); PG8_MMA(0, 1, At, B1); PG8_BAR; PG8_SCHED;
            PG8_LDA(At, 0, 1); PG8_STAGE(PG8_SB(0, 0), b2, voffB); PG8_STAGE(PG8_SB(0, 1), b2 + hstepB, voffB); PG8_STAGE(PG8_SA(0, 0), a2, voffA);
            PG8_WAIT_V(8); PG8_WAIT_L(0); PG8_BAR; PG8_MMA(1, 0, At, B0); PG8_MMA(1, 1, At, B1); PG8_BAR; PG8_SCHED;
            PG8_LDB(B0, 1, 0); PG8_LDB(B1, 1, 1); PG8_SCHED; PG8_LDA(At, 1, 0); PG8_STAGE(PG8_SA(0, 1), a2 + hstepA, voffA);
            PG8_WAIT_V(8); PG8_WAIT_L(0); PG8_BAR; PG8_MMA(0, 0, At, B0); PG8_MMA(0, 1, At, B1); PG8_BAR; PG8_SCHED;
            PG8_LDA(At, 1, 1); PG8_STAGE(PG8_SB(1, 0), b3, voffB); PG8_STAGE(PG8_SB(1, 1), b3 + hstepB, voffB); PG8_STAGE(PG8_SA(1, 0), a3, voffA);
            PG8_WAIT_V(8); PG8_WAIT_L(0); PG8_BAR; PG8_MMA(1, 0, At, B0); PG8_MMA(1, 1, At, B1); PG8_BAR; PG8_SCHED;
        }
        if (wr == 0) PG8_BAR;
        E(acc, cur, wr, wc, fr, fq);
        if (!has_next) break;
#pragma unroll
        for (int a = 0; a < 2; ++a)
#pragma unroll
            for (int b = 0; b < 2; ++b)
#pragma unroll
                for (int m = 0; m < 4; ++m)
#pragma unroll
                    for (int n = 0; n < 2; ++n) acc[a][b][m][n] = (f32x4){0.f, 0.f, 0.f, 0.f};
        cur = nxt; cA = nA; cB = nB; ++ui; nt = cur.nkt; asm volatile("" : "+s"(nt));
        if (wr == 1) PG8_BAR;
    }
    PG8_WAIT_V(0);
    PG8_BAR;
#undef PG8_SA
#undef PG8_SB
#undef PG8_STAGE
#undef PG8_LDA
#undef PG8_LDB
#undef PG8_MMA
#undef PG8_WAIT_V
#undef PG8_WAIT_L
#undef PG8_BAR
#undef PG8_SCHED
}
}

constexpr int NWAVES = 8, NTHR = 512;
constexpr int DM = 2048, MP = 8192, MS = 1024, MT = 9216, SEQ = 2048, NBAT = 4, DBAT = 128, DSEQ = 8;
constexpr int EA = 1024, KBW = 512, EB = 1024, NIN = 10256, N1 = 10752, PLE = 256;
constexpr int HB = 4, DK = 128, DV = 256, GR = 16, CH = 128, GC = 64  , NCH = SEQ / GC;
constexpr float EPS = 1e-6f;
constexpr int C_ALR = 6144, C_MA = 6160;

constexpr size_t OUT_Y = 0, OUT_SP = (size_t)MT * DM, OUT_SS = OUT_SP + (size_t)NBAT * HB * DK * DV, OUT_CV = OUT_SS + (size_t)DBAT * HB * DK * DV;

constexpr size_t MiB = 1u << 20;
constexpr size_t WS_CTL = 0, CTL_ZERO_BYTES = 64 * 1024;
constexpr size_t WS_WPE = 1 * MiB, WS_WPAB = 2 * MiB, WS_WO = 10 * MiB, WS_WPG = 18 * MiB, WS_PBF = 26 * MiB;
constexpr size_t WS_VSS = 30 * MiB + 512 * 1024;
constexpr size_t WS_TSS = WS_VSS + (size_t)MT * 16 * 4;
constexpr size_t WS_RSTD = WS_TSS + (size_t)MT * 32 * 4;
constexpr size_t WS_DEC = 33 * MiB;
constexpr size_t WS_W1T = 34 * MiB;
constexpr size_t WS_QT = 34 * MiB, WS_ATT = 42 * MiB, WS_KTT = 50 * MiB;
constexpr size_t WS_E = 34 * MiB;
constexpr size_t WS_XN = 76 * MiB, WS_Y = 76 * MiB;
constexpr size_t WS_U = 112 * MiB  , WS_V = 130 * MiB, WS_Q = 166 * MiB, WS_KB = 175 * MiB, WS_VB = 184 * MiB, WS_SZB = 202 * MiB, WS_GA = 220 * MiB, WS_GB = 256 * MiB;
constexpr size_t WS_LA = 292 * MiB;
constexpr size_t WS_O = 58 * MiB;
constexpr size_t WS_SLABA = 112 * MiB;
constexpr size_t WS_M = 148 * MiB;
constexpr size_t WS_T = 184 * MiB;
constexpr size_t WS_H = 112 * MiB;
constexpr size_t WS_ES = 312 * MiB;
constexpr size_t WS_END = 316 * MiB;
static_assert(WS_RSTD + (size_t)MT * 4 <= WS_DEC && WS_DEC + 16 * 32 * 128 * 4 <= WS_W1T && WS_W1T + (size_t)N1 * 2048 * 2 <= WS_XN, "ws map");
constexpr int CW_GRP = 8192;
constexpr int CW_PAN = 9216;
constexpr int CW_BAR = 4096;

constexpr int LDS_BYTES = 155648;
constexpr int MISC_OFF = LDS_BYTES - 256;

#define GAS __attribute__((address_space(1)))
#define LAS __attribute__((address_space(3)))
typedef unsigned short bf16;
typedef unsigned v4u __attribute__((ext_vector_type(4)));
typedef unsigned v2u __attribute__((ext_vector_type(2)));
typedef float f32x4 __attribute__((ext_vector_type(4)));
typedef short bf16x8 __attribute__((ext_vector_type(8)));
typedef GAS unsigned gu32;
#define RLX_AGENT __ATOMIC_RELAXED, __HIP_MEMORY_SCOPE_AGENT
__device__ __forceinline__ unsigned pk2(float lo, float hi) { return pg8::cvt_pk_bf16(lo, hi); }
__device__ __forceinline__ unsigned f2bf(float f) { return pg8::cvt_pk_bf16(f, 0.f) & 0xffffu; }
__device__ __forceinline__ float bflo(unsigned w) { return __uint_as_float(w << 16); }
__device__ __forceinline__ float bfhi(unsigned w) { return __uint_as_float(w & 0xffff0000u); }
__device__ __forceinline__ float bf2f(bf16 h) { return __uint_as_float((unsigned)h << 16); }
__device__ __forceinline__ float sigm(float x) { return __builtin_amdgcn_rcpf(1.f + __expf(-x)); }
__device__ __forceinline__ float wave_sum(float v) {
#pragma unroll
    for (int o = 1; o < 64; o <<= 1) v += __shfl_xor(v, o);
    return v;
}

#define XB_TMO      128
#define XB_XCNT(j)  (256  + 64 * (j))
#define XB_XSUB(j)  (1280 + 64 * (j))
#define XB_XGEN(j)  (2304 + 64 * (j))
#define XB_TOP      3328
#define XB_TOPGEN   3392
#define XCD_BAR_WORDS 3456
#define XB_SPIN_CAP (1u << 18)
__device__ __forceinline__ unsigned xb_ld(unsigned* p)              { return __hip_atomic_load(p, __ATOMIC_RELAXED, __HIP_MEMORY_SCOPE_AGENT); }
__device__ __forceinline__ unsigned xb_add(unsigned* p, unsigned v) { return __hip_atomic_fetch_add(p, v, __ATOMIC_RELAXED, __HIP_MEMORY_SCOPE_AGENT); }
__device__ __forceinline__ unsigned xb_xcc_id() { return (unsigned)__builtin_amdgcn_s_getreg((3 << 11) | 20) & 0xFu; }
#define XB_SPIN(cond, bar) do { unsigned _sp = 0; while (cond) { __builtin_amdgcn_s_sleep(1); \
    if ((++_sp & 255u) == 0u) { if (xb_ld(&(bar)[XB_TMO])) break; if (_sp > XB_SPIN_CAP) { atomicAdd(&(bar)[XB_TMO], 1u); break; } } } } while (0)
struct XcdBarrier { unsigned* bar; unsigned x; volatile LAS unsigned* st; };
__device__ __forceinline__ XcdBarrier xcd_barrier_post(unsigned* bar, volatile LAS unsigned* st) {
    XcdBarrier b; b.bar = bar; b.x = xb_xcc_id(); b.st = st;
    if (threadIdx.x == 0) (void)xb_add(&bar[XB_XCNT(b.x)], 1u);
    return b;
}
__device__ __forceinline__ void xcd_barrier_complete(unsigned* bar, unsigned x, unsigned& nloc, unsigned& nx) {
    const unsigned G = gridDim.x * gridDim.y * gridDim.z;
    unsigned sum, cnt, mine, sp = 0u;
    for (;;) {
        sum = 0u; cnt = 0u; mine = 0u;
#pragma unroll
        for (unsigned j = 0; j < 16; ++j) { const unsigned c = xb_ld(&bar[XB_XCNT(j)]); sum += c; cnt += (c > 0u) ? 1u : 0u; mine = (j == x) ? c : mine; }
        if (sum == G) break;
        __builtin_amdgcn_s_sleep(1);
        if ((++sp & 255u) == 0u) { if (xb_ld(&bar[XB_TMO])) break; if (sp > XB_SPIN_CAP) { atomicAdd(&bar[XB_TMO], 1u); break; } }
    }
    nloc = mine > 0u ? mine : 1u; nx = cnt > 0u ? cnt : 1u;
}
__device__ __forceinline__ void xcd_barrier(const XcdBarrier& b) {
    asm volatile("s_waitcnt vmcnt(0)" ::: "memory");
    __syncthreads();
    if (threadIdx.x == 0) {
        unsigned* bar = b.bar;
        __builtin_amdgcn_s_waitcnt(0);
        unsigned nloc = b.st[0], nx = b.st[1];
        if (nloc == 0u) { xcd_barrier_complete(bar, b.x, nloc, nx); b.st[0] = nloc; b.st[1] = nx; }
        const unsigned old = xb_add(&bar[XB_XSUB(b.x)], 1u);
        const unsigned gen = old / nloc;
        if (old + 1u == (gen + 1u) * nloc) {
            __builtin_amdgcn_fence(__ATOMIC_RELEASE, "agent");
            asm volatile("s_waitcnt vmcnt(0)" ::: "memory");
            const unsigned og = xb_add(&bar[XB_TOP], 1u);
            const unsigned tg = og / nx;
            if (og + 1u == (tg + 1u) * nx) xb_add(&bar[XB_TOPGEN], 1u);
            else XB_SPIN(xb_ld(&bar[XB_TOPGEN]) == tg, bar);
            __builtin_amdgcn_fence(__ATOMIC_ACQUIRE, "agent");
            xb_add(&bar[XB_XGEN(b.x)], 1u);
            asm volatile("s_waitcnt vmcnt(0)" ::: "memory");
        } else {
            XB_SPIN(xb_ld(&bar[XB_XGEN(b.x)]) == gen, bar);
            __builtin_amdgcn_fence(__ATOMIC_ACQUIRE, "agent");
            asm volatile("s_waitcnt vmcnt(0)" ::: "memory");
        }
    }
    __syncthreads();
}

struct Frame {
    LAS unsigned char* lds;
    unsigned char* ws;
    int wave, vcu, G;
    const float *xp, *xs, *pp, *ps, *st0, *g_pre, *w_in, *g_v, *w_s, *b_s, *w_a2, *b_a, *g_o, *w_pa, *w_pb, *w_o, *g_post, *w_pg, *w_pe;
    float* out;
};
__device__ __forceinline__ const float* xrow(const Frame& F, int m) { return m < MP ? F.xp + (size_t)m * DM : F.xs + (size_t)(m - MP) * DM; }

struct ConvItem { const float* src; bf16* dst; int spitch, dpitch; };
constexpr int I_IN = 32 * 320, I_PA = 16 * 64, I_PB = 16 * 64, I_O = 32 * 64, I_PG = 32 * 64, I_PE = 4 * 64, NITEMS = I_IN + I_PA + I_PB + I_O + I_PG + I_PE;
__device__ __forceinline__ void conv_item(const Frame& F, int it, ConvItem& d) {
    int r = it;
    if (r < I_IN) { const int kb = r / 320, n0 = (r % 320) * 32;
        const int src = n0 < 2048 ? ((n0 & 128) ? 2048 + 128 * (n0 >> 8) + (n0 & 127) : 128 * (n0 >> 8) + (n0 & 127)) : n0 < 3072 ? n0 - 1024 : n0 + (n0 >= C_ALR ? GR : 0);
        d.src = F.w_in + (size_t)(kb * 64) * NIN + src; d.spitch = NIN; d.dst = (bf16*)(F.ws + WS_W1T) + (size_t)n0 * 2048 + kb * 64; d.dpitch = 2048; return; } r -= I_IN;
    const int k0 = (r / 64) * 64, n0 = (r % 64) * 32; d.spitch = DM; d.dpitch = 2048;
    if (r < I_PA) { d.src = F.w_pa + (size_t)k0 * DM + n0; d.dst = (bf16*)(F.ws + WS_WPAB) + (size_t)n0 * 2048 + k0; return; } r -= I_PA;
    { const int k1 = (r / 64) * 64, n1 = (r % 64) * 32;
      if (r < I_PB) { d.src = F.w_pb + (size_t)k1 * DM + n1; d.dst = (bf16*)(F.ws + WS_WPAB) + (size_t)n1 * 2048 + 1024 + k1; return; } } r -= I_PB;
    { const int k1 = (r / 64) * 64, n1 = (r % 64) * 32;
      if (r < I_O) { d.src = F.w_o + (size_t)k1 * DM + n1; d.dst = (bf16*)(F.ws + WS_WO) + (size_t)n1 * 2048 + k1; return; } } r -= I_O;
    { const int k1 = (r / 64) * 64, n1 = (r % 64) * 32;
      if (r < I_PG) { d.src = F.w_pg + (size_t)k1 * DM + n1; d.dst = (bf16*)(F.ws + WS_WPG) + (size_t)n1 * 2048 + k1; return; } } r -= I_PG;
    { const int k1 = (r / 64) * 64, n1 = (r % 64) * 32; d.src = F.w_pe + (size_t)k1 * DM + n1; d.dst = (bf16*)(F.ws + WS_WPE) + (size_t)n1 * 256 + k1; d.dpitch = 256; }
}
__device__ __forceinline__ void conv_load(const ConvItem& d, f32x4 (&v)[8], int lane) {
    const int r = lane >> 3, c4 = (lane & 7) * 4;
#pragma unroll
    for (int i = 0; i < 8; ++i) v[i] = __builtin_nontemporal_load((const GAS f32x4*)(d.src + (size_t)(8 * i + r) * d.spitch + c4));
}
__device__ __forceinline__ void conv_finish(const ConvItem& d, const f32x4 (&v)[8], LAS float* scr, int lane) {
    const int r = lane >> 3, c4 = (lane & 7) * 4;
#pragma unroll
    for (int i = 0; i < 8; ++i) { LAS float* p = scr + (8 * i + r) * 33 + c4; p[0] = v[i].x; p[1] = v[i].y; p[2] = v[i].z; p[3] = v[i].w; }
    asm volatile("s_waitcnt lgkmcnt(0)" ::: "memory");
    const int c = lane & 7;
#pragma unroll
    for (int j = 0; j < 4; ++j) { const int n = (lane >> 3) + 8 * j; const LAS float* s = scr + (8 * c) * 33 + n;
        v4u o; o.x = pk2(s[0 * 33], s[1 * 33]); o.y = pk2(s[2 * 33], s[3 * 33]); o.z = pk2(s[4 * 33], s[5 * 33]); o.w = pk2(s[6 * 33], s[7 * 33]);
        *(GAS v4u*)(d.dst + (size_t)n * d.dpitch + 8 * c) = o; }
    asm volatile("s_waitcnt lgkmcnt(0)" ::: "memory");
}
__device__ __forceinline__ void p0_prologue(Frame& F) {
    LAS float* scr = (LAS float*)(F.lds + F.wave * 16384);
    const int gw = F.vcu * NWAVES + F.wave, NGW = F.G * NWAVES, ln = (int)(threadIdx.x & 63u);
    bf16* W1T = (bf16*)(F.ws + WS_W1T);
    { f32x4 va[8], vb[8]; ConvItem da, db; int it = gw; bool ha = it < NITEMS;
      if (ha) { conv_item(F, it, da); conv_load(da, va, ln); }
      while (ha) {
          const int it2 = it + NGW; const bool hb = it2 < NITEMS;
          if (hb) { conv_item(F, it2, db); conv_load(db, vb, ln); }
          conv_finish(da, va, scr, ln);
          if (!hb) break;
          it = it2 + NGW; ha = it < NITEMS;
          if (ha) { conv_item(F, it, da); conv_load(da, va, ln); }
          conv_finish(db, vb, scr, ln);
      } }
    {
        const int gt = F.vcu * NTHR + ((int)threadIdx.x), NGT = F.G * NTHR;
        for (int p = gt; p < 512 * 256; p += NGT) { const int ch = p & 511, k0 = (p >> 9) * 8; float wa[16];
#pragma unroll
            for (int r = 0; r < 16; ++r) wa[r] = F.w_a2[r * KBW + ch];
            float t[8];
#pragma unroll
            for (int i = 0; i < 8; ++i) { const GAS f32x4* wr4 = (const GAS f32x4*)(F.w_in + (size_t)(k0 + i) * NIN + C_ALR); float a = 0.f;
#pragma unroll
                for (int r4 = 0; r4 < 4; ++r4) { const f32x4 w = wr4[r4]; a += w.x * wa[4 * r4] + w.y * wa[4 * r4 + 1] + w.z * wa[4 * r4 + 2] + w.w * wa[4 * r4 + 3]; }
                t[i] = a; }
            v4u o; o.x = pk2(t[0], t[1]); o.y = pk2(t[2], t[3]); o.z = pk2(t[4], t[5]); o.w = pk2(t[6], t[7]);
            *(GAS v4u*)(W1T + (size_t)(10240 + ch) * 2048 + k0) = o; }
        bf16* PBF = (bf16*)(F.ws + WS_PBF);
        for (int p = gt; p < MT * PLE / 8; p += NGT) { const size_t e = (size_t)p * 8; const float* src = e < (size_t)MP * PLE ? F.pp + e : F.ps + (e - (size_t)MP * PLE);
            const f32x4 a = __builtin_nontemporal_load((const GAS f32x4*)src), b = __builtin_nontemporal_load((const GAS f32x4*)(src + 4)); v4u o; o.x = pk2(a.x, a.y); o.y = pk2(a.z, a.w); o.z = pk2(b.x, b.y); o.w = pk2(b.z, b.w);
            *(GAS v4u*)(PBF + e) = o; }
    }
    bf16* XN = (bf16*)(F.ws + WS_XN);
    { const GAS f32x4* gr = (const GAS f32x4*)F.g_pre + ln; f32x4 va[8], vb[8]; int m = gw; bool ha = m < MT;
#define XN_LOAD(v, mm) do { const GAS f32x4* xr_ = (const GAS f32x4*)xrow(F, (mm)) + ln; _Pragma("unroll") for (int j_ = 0; j_ < 8; ++j_) v[j_] = __builtin_nontemporal_load(xr_ + 64 * j_); } while (0)
#define XN_FINISH(v, mm) do { float s_ = 0.f; _Pragma("unroll") for (int j_ = 0; j_ < 8; ++j_) s_ += (v[j_].x * v[j_].x + v[j_].y * v[j_].y) + (v[j_].z * v[j_].z + v[j_].w * v[j_].w); \
        const float rstd_ = 1.0f / sqrtf(wave_sum(s_) * (1.f / DM) + EPS); GAS v2u* o8_ = (GAS v2u*)(XN + (size_t)(mm) * DM) + ln; \
        _Pragma("unroll") for (int j_ = 0; j_ < 8; ++j_) { const f32x4 gg_ = gr[64 * j_]; v2u o_; o_.x = pk2(v[j_].x * rstd_ * gg_.x, v[j_].y * rstd_ * gg_.y); o_.y = pk2(v[j_].z * rstd_ * gg_.z, v[j_].w * rstd_ * gg_.w); o8_[64 * j_] = o_; } } while (0)
      if (ha) XN_LOAD(va, m);
      while (ha) {
          const int m2 = m + NGW; const bool hb = m2 < MT;
          if (hb) XN_LOAD(vb, m2);
          XN_FINISH(va, m);
          if (!hb) break;
          m = m2 + NGW; ha = m < MT;
          if (ha) XN_LOAD(va, m);
          XN_FINISH(vb, m2);
      }
#undef XN_LOAD
#undef XN_FINISH
    }
}

using pg8::Unit;
template <int ACT>
__device__ __forceinline__ void g1_store(const pg8::f32x4 (&acc)[2][2][4][2], bf16* base, int ldc, int row0, int col0, float* vss, int wc, int fq) {
#pragma unroll
    for (int ai = 0; ai < 2; ++ai)
#pragma unroll
        for (int m = 0; m < 4; ++m) { const int row = row0 + ai * 128 + m * 16; bf16* rowp = base + (size_t)row * ldc + col0; float ss = 0.f;
#pragma unroll
            for (int bj = 0; bj < 2; ++bj) { float v[8];
#pragma unroll
                for (int e = 0; e < 8; ++e) { float x = acc[ai][bj][m][e >> 2][e & 3];
                    if (ACT == 1) x = x * sigm(x); else if (ACT == 2) x = sigm(x); else if (ACT == 3) x = x * 0.08838834764831845f;
                    if (ACT == 4) ss += x * x; v[e] = x; }
                v4u w; w.x = pg8::cvt_pk_bf16(v[0], v[1]); w.y = pg8::cvt_pk_bf16(v[2], v[3]); w.z = pg8::cvt_pk_bf16(v[4], v[5]); w.w = pg8::cvt_pk_bf16(v[6], v[7]);
                *(GAS v4u*)(rowp + bj * 128) = w; }
            if (ACT == 4) { ss += __shfl_xor(ss, 16); ss += __shfl_xor(ss, 32); if (fq == 0) vss[(size_t)row * 16 + wc] = ss; } }
}
__device__ __forceinline__ float log_sigmoid(float z) { return -(fmaxf(-z, 0.f) + __logf(1.f + __expf(-fabsf(z)))); }
__device__ __forceinline__ unsigned q8(float x) { const unsigned q = (unsigned)__builtin_fmaf(sigm(x), 255.f, 0.5f); return q < 1u ? 1u : q; }
__device__ __forceinline__ void g1_store_u8(const pg8::f32x4 (&acc)[2][2][4][2], unsigned char* base, int row0, int col0) {
#pragma unroll
    for (int ai = 0; ai < 2; ++ai)
#pragma unroll
        for (int m = 0; m < 4; ++m) { unsigned char* rowp = base + (size_t)(row0 + ai * 128 + m * 16) * DM + col0;
#pragma unroll
            for (int bj = 0; bj < 2; ++bj) { const pg8::f32x4 a = acc[ai][bj][m][0], b = acc[ai][bj][m][1]; v2u w;
                w.x = q8(a.x) | (q8(a.y) << 8) | (q8(a.z) << 16) | (q8(a.w) << 24); w.y = q8(b.x) | (q8(b.y) << 8) | (q8(b.z) << 16) | (q8(b.w) << 24);
                *(GAS v2u*)(rowp + bj * 128) = w; } }
}
__device__ __forceinline__ void u8x8_to_f32(v2u w, float (&f)[8]) {
    f[0] = (float)(w.x & 0xffu); f[1] = (float)((w.x >> 8) & 0xffu); f[2] = (float)((w.x >> 16) & 0xffu); f[3] = (float)(w.x >> 24);
    f[4] = (float)(w.y & 0xffu); f[5] = (float)((w.y >> 8) & 0xffu); f[6] = (float)((w.y >> 16) & 0xffu); f[7] = (float)(w.y >> 24);
}
struct EpiG1 {
    static constexpr bool PERM = true, HAS_MID = false;
    unsigned char* ws; const float* b_a;
    __device__ __forceinline__ void operator()(const pg8::f32x4 (&acc)[2][2][4][2], const Unit& u, int wr, int wc, int fr, int fq) const {
        const int pn = u.pn, row0 = u.pm * 256 + wr * 64 + fr, cin = wc * 32 + 8 * fq;
        if (pn < 8) {
            bf16* UZ = (bf16*)(ws + WS_U);
#pragma unroll
            for (int ai = 0; ai < 2; ++ai)
#pragma unroll
                for (int m = 0; m < 4; ++m) { const pg8::f32x4 u0 = acc[ai][0][m][0], u1 = acc[ai][0][m][1], z0 = acc[ai][1][m][0], z1 = acc[ai][1][m][1]; v4u w;
                    w.x = pg8::cvt_pk_bf16(u0.x * z0.x * sigm(z0.x), u0.y * z0.y * sigm(z0.y)); w.y = pg8::cvt_pk_bf16(u0.z * z0.z * sigm(z0.z), u0.w * z0.w * sigm(z0.w));
                    w.z = pg8::cvt_pk_bf16(u1.x * z1.x * sigm(z1.x), u1.y * z1.y * sigm(z1.y)); w.w = pg8::cvt_pk_bf16(u1.z * z1.z * sigm(z1.z), u1.w * z1.w * sigm(z1.w));
                    *(GAS v4u*)(UZ + (size_t)(row0 + ai * 128 + m * 16) * EA + pn * 128 + cin) = w; } }
        else if (pn < 12) g1_store<4>(acc, (bf16*)(ws + WS_V), 1024, row0, (pn - 8) * 256 + cin, (float*)(ws + WS_VSS) + (pn - 8) * 4, wc, fq);
        else if (pn < 14) g1_store<3>(acc, (bf16*)(ws + WS_Q), 512, row0, (pn - 12) * 256 + cin, nullptr, wc, fq);
        else if (pn < 16) g1_store<0>(acc, (bf16*)(ws + WS_KB), 512, row0, (pn - 14) * 256 + cin, nullptr, wc, fq);
        else if (pn < 20) g1_store<0>(acc, (bf16*)(ws + WS_VB), 1024, row0, (pn - 16) * 256 + cin, nullptr, wc, fq);
        else if (pn < 24) g1_store<1>(acc, (bf16*)(ws + WS_SZB), 1024, row0, (pn - 20) * 256 + cin, nullptr, wc, fq);
        else if (pn < 32) g1_store_u8(acc, ws + WS_GA, row0, (pn - 24) * 256 + cin);
        else if (pn < 40) g1_store_u8(acc, ws + WS_GB, row0, (pn - 32) * 256 + cin);
        else {
            float* la = (float*)(ws + WS_LA); const int c0 = (pn - 40) * 256 + cin;
            pg8::f32x4 bb[2][2];
#pragma unroll
            for (int bj = 0; bj < 2; ++bj) { bb[bj][0] = *(const GAS pg8::f32x4*)(b_a + c0 + bj * 128); bb[bj][1] = *(const GAS pg8::f32x4*)(b_a + c0 + bj * 128 + 4); }
#pragma unroll
            for (int ai = 0; ai < 2; ++ai)
#pragma unroll
                for (int m = 0; m < 4; ++m) { float* rp = la + (size_t)(row0 + ai * 128 + m * 16) * KBW + c0;
#pragma unroll
                    for (int bj = 0; bj < 2; ++bj)
#pragma unroll
                        for (int n = 0; n < 2; ++n) { const pg8::f32x4 z = acc[ai][bj][m][n] + bb[bj][n]; pg8::f32x4 o;
                            o.x = log_sigmoid(z.x) * 0.0625f; o.y = log_sigmoid(z.y) * 0.0625f; o.z = log_sigmoid(z.z) * 0.0625f; o.w = log_sigmoid(z.w) * 0.0625f;
                            *(GAS pg8::f32x4*)(rp + bj * 128 + n * 4) = o; } }
        }
    }
};
struct EpiBf {
    static constexpr bool PERM = true, HAS_MID = false;
    bf16* O; int ldc;
    __device__ __forceinline__ void operator()(const pg8::f32x4 (&acc)[2][2][4][2], const Unit& u, int wr, int wc, int fr, int fq) const {
        g1_store<0>(acc, O, ldc, u.pm * 256 + wr * 64 + fr, u.pn * 256 + wc * 32 + 8 * fq, nullptr, wc, fq);
    }
};
template <bool PERM>
__device__ __forceinline__ void slab_store(const pg8::f32x4 (&acc)[2][2][4][2], bf16* lo, bf16* hi, const Unit& u, int wr, int wc, int fr, int fq) {
    const int ks = u.kt0 >> 2; bf16* sl = ks < 4 ? lo + (size_t)ks * MS * DM : hi + (size_t)(ks - 4) * MS * DM;
    const int row0 = (u.pm - 32) * 256 + wr * 64 + fr, col0 = u.pn * 256 + wc * 32 + (PERM ? 8 : 4) * fq;
#pragma unroll
    for (int ai = 0; ai < 2; ++ai)
#pragma unroll
        for (int m = 0; m < 4; ++m) { bf16* rp = sl + (size_t)(row0 + ai * 128 + m * 16) * DM + col0;
#pragma unroll
            for (int bj = 0; bj < 2; ++bj) {
                if (PERM) { const pg8::f32x4 a = acc[ai][bj][m][0], b = acc[ai][bj][m][1]; *(GAS v4u*)(rp + bj * 128) = (v4u){pk2(a.x, a.y), pk2(a.z, a.w), pk2(b.x, b.y), pk2(b.z, b.w)}; }
                else {
#pragma unroll
                    for (int n = 0; n < 2; ++n) { const pg8::f32x4 a = acc[ai][bj][m][n]; *(GAS v2u*)(rp + bj * 128 + n * 16) = (v2u){pk2(a.x, a.y), pk2(a.z, a.w)}; } } } }
}
__device__ __forceinline__ const bf16* slab_ptr(const bf16* lo, const bf16* hi, int ks) { return ks < 4 ? lo + (size_t)ks * MS * DM : hi + (size_t)(ks - 4) * MS * DM; }
__device__ __forceinline__ void slab_sum8(const bf16* lo, const bf16* hi, size_t off, int k0, int k1, pg8::f32x4& s0, pg8::f32x4& s1) {
    s0 = (pg8::f32x4){0.f, 0.f, 0.f, 0.f}; s1 = s0;
#pragma unroll
    for (int ks = 0; ks < 8; ++ks) if (ks >= k0 && ks < k1) { const v4u w = *(const GAS v4u*)(slab_ptr(lo, hi, ks) + off);
        s0.x += bflo(w.x); s0.y += bfhi(w.x); s0.z += bflo(w.y); s0.w += bfhi(w.y); s1.x += bflo(w.z); s1.y += bfhi(w.z); s1.z += bflo(w.w); s1.w += bfhi(w.w); }
}
__device__ __forceinline__ pg8::f32x4 slab_sum4(const bf16* lo, const bf16* hi, size_t off) {
    pg8::f32x4 a = (pg8::f32x4){0.f, 0.f, 0.f, 0.f};
#pragma unroll
    for (int ks = 0; ks < 8; ++ks) { const v2u w = *(const GAS v2u*)(slab_ptr(lo, hi, ks) + off); a.x += bflo(w.x); a.y += bfhi(w.x); a.z += bflo(w.y); a.w += bfhi(w.y); }
    return a;
}
struct EpiG2 {
    static constexpr bool PERM = true, HAS_MID = true;
    const unsigned char* GA; const unsigned char* GB; bf16* Mo; bf16* slo; bf16* shi;
    __device__ __forceinline__ void mid(pg8::f32x4 (&acc)[2][2][4][2], const Unit& u, int wr, int wc, int fr, int fq) const {
        asm volatile("" : "+v"(fr));
        const unsigned off0 = (unsigned)((u.pm * 256 + wr * 64 + fr) * DM + u.pn * 256 + wc * 32 + 8 * fq);
#pragma unroll
        for (int ai = 0; ai < 2; ++ai)
#pragma unroll
            for (int m = 0; m < 4; ++m) { const unsigned off = off0 + (unsigned)((ai * 128 + m * 16) * DM);
#pragma unroll
                for (int bj = 0; bj < 2; ++bj) { const v2u a = *(const GAS v2u*)(GA + off + bj * 128), b = *(const GAS v2u*)(GB + off + bj * 128); float fa[8], fb[8]; u8x8_to_f32(a, fa); u8x8_to_f32(b, fb);
#pragma unroll
                    for (int e = 0; e < 8; ++e) acc[ai][bj][m][e >> 2][e & 3] *= fa[e] * __builtin_amdgcn_rcpf(fb[e]); }
                if (m == 3) asm volatile("" ::: "memory"); }
    }
    __device__ __forceinline__ void operator()(const pg8::f32x4 (&acc)[2][2][4][2], const Unit& u, int wr, int wc, int fr, int fq) const {
        if (u.kind) { slab_store<true>(acc, slo, shi, u, wr, wc, fr, fq); return; }
        const int row0 = u.pm * 256 + wr * 64 + fr, col0 = u.pn * 256 + wc * 32 + 8 * fq;
#pragma unroll
        for (int ai = 0; ai < 2; ++ai)
#pragma unroll
            for (int m = 0; m < 4; ++m) { const size_t off = (size_t)(row0 + ai * 128 + m * 16) * DM + col0;
#pragma unroll
                for (int bj = 0; bj < 2; ++bj) { const v2u b = *(const GAS v2u*)(GB + off + bj * 128); float fb[8]; u8x8_to_f32(b, fb); unsigned w[4];
#pragma unroll
                    for (int p = 0; p < 4; ++p) w[p] = pg8::cvt_pk_bf16(acc[ai][bj][m][p >> 1][(p & 1) * 2] * (fb[2 * p] * (1.f / 255.f)), acc[ai][bj][m][p >> 1][(p & 1) * 2 + 1] * (fb[2 * p + 1] * (1.f / 255.f)));
                    *(GAS v4u*)(Mo + off + bj * 128) = (v4u){w[0], w[1], w[2], w[3]}; }
                if (m & 1) asm volatile("" ::: "memory"); }
    }
};
struct EpiG3 {
    static constexpr bool PERM = true, HAS_MID = false;
    bf16* T; float* tss; bf16* slo; bf16* shi;
    int fused; bf16* H; float* xs; unsigned* cnt; const float* xp; const float* gpost; LAS unsigned char* lx;
    __device__ __forceinline__ void operator()(const pg8::f32x4 (&acc)[2][2][4][2], const Unit& u, int wr, int wc, int fr, int fq) const {
        if (u.kind) { slab_store<true>(acc, slo, shi, u, wr, wc, fr, fq); return; }
        const int row0 = u.pm * 256 + wr * 64 + fr, col0 = u.pn * 256 + wc * 32 + 8 * fq;
        if (!fused) {
#pragma unroll
            for (int ai = 0; ai < 2; ++ai)
#pragma unroll
                for (int m = 0; m < 4; ++m) { const int row = row0 + ai * 128 + m * 16; bf16* rowp = T + (size_t)row * DM + col0; float ss = 0.f;
#pragma unroll
                    for (int bj = 0; bj < 2; ++bj) { const pg8::f32x4 a = acc[ai][bj][m][0], b = acc[ai][bj][m][1];
                        ss += (a.x * a.x + a.y * a.y) + (a.z * a.z + a.w * a.w) + (b.x * b.x + b.y * b.y) + (b.z * b.z + b.w * b.w);
                        v4u w; w.x = pg8::cvt_pk_bf16(a.x, a.y); w.y = pg8::cvt_pk_bf16(a.z, a.w); w.z = pg8::cvt_pk_bf16(b.x, b.y); w.w = pg8::cvt_pk_bf16(b.z, b.w);
                        *(GAS v4u*)(rowp + bj * 128) = w; }
                    ss += __shfl_xor(ss, 16); ss += __shfl_xor(ss, 32); if (fq == 0) tss[(size_t)row * 32 + u.pn * 4 + wc] = ss; }
            return;
        }
        LAS float* P = (LAS float*)lx; LAS float* S = P + 1024; volatile LAS unsigned* flag = (volatile LAS unsigned*)(S + 256);
        const int tid = threadIdx.x, lane = tid & 63, wid = __builtin_amdgcn_readfirstlane(tid >> 6);
#pragma unroll
        for (int ai = 0; ai < 2; ++ai)
#pragma unroll
            for (int m = 0; m < 4; ++m) { float ss = 0.f;
#pragma unroll
                for (int bj = 0; bj < 2; ++bj) { const pg8::f32x4 a = acc[ai][bj][m][0], b = acc[ai][bj][m][1]; ss += (a.x * a.x + a.y * a.y) + (a.z * a.z + a.w * a.w) + (b.x * b.x + b.y * b.y) + (b.z * b.z + b.w * b.w); }
                ss += __shfl_xor(ss, 16); ss += __shfl_xor(ss, 32); if (fq == 0) P[(ai * 128 + wr * 64 + m * 16 + fr) * 4 + wc] = ss; }
        asm volatile("s_waitcnt lgkmcnt(0)" ::: "memory"); __builtin_amdgcn_s_barrier(); asm volatile("" ::: "memory");
        if (tid < 256) { const pg8::f32x4 p = *(const LAS pg8::f32x4*)(P + tid * 4);
            __hip_atomic_store(xs + (size_t)(u.pm * 256 + tid) * 8 + u.pn, (p.x + p.y) + (p.z + p.w), __ATOMIC_RELAXED, __HIP_MEMORY_SCOPE_AGENT); }
        asm volatile("s_waitcnt vmcnt(0)" ::: "memory");
        if (tid < 256 && lane == 0) (void)__hip_atomic_fetch_add(cnt + 64 * u.pm, 1u, __ATOMIC_RELAXED, __HIP_MEMORY_SCOPE_AGENT);
        if (wid == 0) { unsigned sp = 0;
            while ((unsigned)__builtin_amdgcn_readfirstlane(__hip_atomic_load(cnt + 64 * u.pm, __ATOMIC_RELAXED, __HIP_MEMORY_SCOPE_AGENT)) < 32u) { __builtin_amdgcn_s_sleep(2); if (++sp > (1u << 20)) break; }
            __builtin_amdgcn_fence(__ATOMIC_ACQUIRE, "agent"); asm volatile("s_waitcnt vmcnt(0)" ::: "memory"); if (lane == 0) flag[0] = 1u; }
        asm volatile("s_waitcnt lgkmcnt(0)" ::: "memory"); __builtin_amdgcn_s_barrier(); asm volatile("" ::: "memory");
        if (tid < 256) { const float* sl = xs + (size_t)(u.pm * 256 + tid) * 8; float t = 0.f;
#pragma unroll
            for (int q = 0; q < 8; ++q) t += __hip_atomic_load(sl + q, __ATOMIC_RELAXED, __HIP_MEMORY_SCOPE_AGENT);
            S[tid] = 1.0f / sqrtf(t * (1.f / DM) + EPS); }
        asm volatile("s_waitcnt lgkmcnt(0)" ::: "memory"); __builtin_amdgcn_s_barrier(); asm volatile("" ::: "memory");
        pg8::f32x4 gp[2][2];
#pragma unroll
        for (int bj = 0; bj < 2; ++bj) { gp[bj][0] = *(const GAS pg8::f32x4*)(gpost + col0 + bj * 128); gp[bj][1] = *(const GAS pg8::f32x4*)(gpost + col0 + bj * 128 + 4); }
#pragma unroll
        for (int ai = 0; ai < 2; ++ai)
#pragma unroll
            for (int m = 0; m < 4; ++m) { const int rl = ai * 128 + wr * 64 + m * 16 + fr; const float rs = S[rl]; const size_t off = (size_t)(u.pm * 256 + rl) * DM + col0;
#pragma unroll
                for (int bj = 0; bj < 2; ++bj) { const pg8::f32x4 x0 = *(const GAS pg8::f32x4*)(xp + off + bj * 128), x1 = *(const GAS pg8::f32x4*)(xp + off + bj * 128 + 4); const pg8::f32x4 a = acc[ai][bj][m][0], b = acc[ai][bj][m][1], g0 = gp[bj][0], g1 = gp[bj][1];
                    v4u w; w.x = pg8::cvt_pk_bf16(x0.x + a.x * rs * g0.x, x0.y + a.y * rs * g0.y); w.y = pg8::cvt_pk_bf16(x0.z + a.z * rs * g0.z, x0.w + a.w * rs * g0.w);
                    w.z = pg8::cvt_pk_bf16(x1.x + b.x * rs * g1.x, x1.y + b.y * rs * g1.y); w.w = pg8::cvt_pk_bf16(x1.z + b.z * rs * g1.z, x1.w + b.w * rs * g1.w);
                    *(GAS v4u*)(H + off + bj * 128) = w; }
                if (m & 1) asm volatile("" ::: "memory"); }
    }
};
struct EpiG4 {
    static constexpr bool PERM = false, HAS_MID = false;
    const bf16 *H, *E; float* out; bf16* slo; bf16* shi;
    __device__ __forceinline__ void operator()(const pg8::f32x4 (&acc)[2][2][4][2], const Unit& u, int wr, int wc, int fr, int fq) const {
        if (u.kind) { slab_store<false>(acc, slo, shi, u, wr, wc, fr, fq); return; }
        const int row0 = u.pm * 256 + wr * 64 + fr, col0 = u.pn * 256 + wc * 32 + 4 * fq;
#pragma unroll
        for (int ai = 0; ai < 2; ++ai)
#pragma unroll
            for (int m = 0; m < 4; ++m) { const size_t off = (size_t)(row0 + ai * 128 + m * 16) * DM + col0;
#pragma unroll
                for (int bj = 0; bj < 2; ++bj)
#pragma unroll
                    for (int n = 0; n < 2; ++n) { const size_t o2 = off + bj * 128 + n * 16;
                        const v2u hv = __builtin_nontemporal_load((const GAS v2u*)(H + o2)), ev = __builtin_nontemporal_load((const GAS v2u*)(E + o2)); const pg8::f32x4 a = acc[ai][bj][m][n];
                        pg8::f32x4 o; o.x = bflo(hv.x) + sigm(a.x) * bflo(ev.x); o.y = bfhi(hv.x) + sigm(a.y) * bfhi(ev.x); o.z = bflo(hv.y) + sigm(a.z) * bflo(ev.y); o.w = bfhi(hv.y) + sigm(a.w) * bfhi(ev.y);
                        __builtin_nontemporal_store(o, (GAS pg8::f32x4*)(out + o2)); }
                asm volatile("" ::: "memory"); }
    }
};

constexpr int GWP = 136, GVP = 68;
__device__ __forceinline__ void gate_prompt_unit(Frame& F, int unit) {
    int tid = ((int)threadIdx.x); asm volatile("" : "+v"(tid));
    const int g = unit & 3, c = (unit >> 2) & 15, b = unit >> 6, r0 = b * SEQ + c * CH, lane = tid & 63, wave = F.wave, fr = lane & 15, fq = lane >> 4;
    LAS bf16* WL = (LAS bf16*)F.lds;
    LAS unsigned* VT = (LAS unsigned*)(F.lds + 128 * GWP * 2);
    LAS float* RS = (LAS float*)(F.lds + 128 * GWP * 2 + 256 * GVP * 4);
    const bf16* U = (const bf16*)(F.ws + WS_U); const bf16* V = (const bf16*)(F.ws + WS_V); const float* VSS = (const float*)(F.ws + WS_VSS);
    bf16* Y = (bf16*)(F.ws + WS_Y);
    __syncthreads();
    if (tid < 128) { const GAS f32x4* p = (const GAS f32x4*)(VSS + (size_t)(r0 + tid) * 16); const f32x4 a = p[0], b4 = p[1], c4 = p[2], d4 = p[3];
        const float ss = ((a.x + a.y) + (a.z + a.w)) + ((b4.x + b4.y) + (b4.z + b4.w)) + ((c4.x + c4.y) + (c4.z + c4.w)) + ((d4.x + d4.y) + (d4.z + d4.w));
        RS[tid] = 1.0f / sqrtf(ss * (1.f / EA) + EPS); }
    { const float* W = F.w_s + (size_t)g * CH * CH;
#pragma unroll
      for (int i = 0; i < 4; ++i) { const int p = tid + NTHR * i, t = p >> 4, s8 = (p & 15) * 8; const f32x4 w0 = *(const GAS f32x4*)(W + t * CH + s8), w1 = *(const GAS f32x4*)(W + t * CH + s8 + 4); v4u o;
          o.x = pk2(s8 <= t ? w0.x : 0.f, s8 + 1 <= t ? w0.y : 0.f); o.y = pk2(s8 + 2 <= t ? w0.z : 0.f, s8 + 3 <= t ? w0.w : 0.f);
          o.z = pk2(s8 + 4 <= t ? w1.x : 0.f, s8 + 5 <= t ? w1.y : 0.f); o.w = pk2(s8 + 6 <= t ? w1.z : 0.f, s8 + 7 <= t ? w1.w : 0.f);
          *(LAS v4u*)(WL + t * GWP + s8) = o; } }
    __syncthreads();
#pragma unroll
    for (int i = 0; i < 4; ++i) { const int idx = tid + NTHR * i, cg = ((idx >> 5) & 3) * 8 + (idx & 7), sp = (idx >> 7) * 4 + ((idx >> 3) & 3), s0 = 2 * sp;
        const v4u ra = *(const GAS v4u*)(V + (size_t)(r0 + s0) * EA + g * DV + 8 * cg), rb = *(const GAS v4u*)(V + (size_t)(r0 + s0 + 1) * EA + g * DV + 8 * cg);
        const GAS f32x4* gv = (const GAS f32x4*)(F.g_v + g * DV + 8 * cg); const f32x4 g0 = gv[0], g1 = gv[1]; const float ra_s = RS[s0], rb_s = RS[s0 + 1];
        const float gg[8] = {g0.x, g0.y, g0.z, g0.w, g1.x, g1.y, g1.z, g1.w}; const unsigned wa[4] = {ra.x, ra.y, ra.z, ra.w}, wb[4] = {rb.x, rb.y, rb.z, rb.w};
        LAS unsigned* dst = VT + (8 * cg) * GVP + (sp ^ (4 * (cg & 7)));
#pragma unroll
        for (int e = 0; e < 4; ++e) { dst[(2 * e) * GVP] = pk2(bflo(wa[e]) * ra_s * gg[2 * e], bflo(wb[e]) * rb_s * gg[2 * e]); dst[(2 * e + 1) * GVP] = pk2(bfhi(wa[e]) * ra_s * gg[2 * e + 1], bfhi(wb[e]) * rb_s * gg[2 * e + 1]); } }
    __syncthreads();
    pg8::f32x4 acc[16];
#pragma unroll
    for (int q = 0; q < 16; ++q) acc[q] = (pg8::f32x4){0.f, 0.f, 0.f, 0.f};
    const int nkk = (wave >> 1) + 1;
    for (int kk = 0; kk < nkk; ++kk) { const bf16x8 bw = *(const LAS bf16x8*)(WL + (16 * wave + fr) * GWP + 32 * kk + 8 * fq);
#pragma unroll
        for (int q = 0; q < 16; ++q) { const int d = 64 * (q >> 2) + 16 * (fr >> 2) + 4 * (q & 3) + (fr & 3);
            const bf16x8 af = *(const LAS bf16x8*)(VT + d * GVP + ((16 * kk + 4 * fq) ^ (4 * ((d >> 3) & 7))));
            acc[q] = __builtin_amdgcn_mfma_f32_16x16x32_bf16(af, bw, acc[q], 0, 0, 0); } }
    { const int t = 16 * wave + fr; const float bs = F.b_s[g * CH + t];
#pragma unroll
      for (int G4 = 0; G4 < 4; ++G4) { const size_t o1 = (size_t)(r0 + t) * EA + g * DV + 64 * G4 + 16 * fq; const v4u u0 = *(const GAS v4u*)(U + o1), u1 = *(const GAS v4u*)(U + o1 + 8);
          const unsigned uw[8] = {u0.x, u0.y, u0.z, u0.w, u1.x, u1.y, u1.z, u1.w}; unsigned yw[8];
#pragma unroll
          for (int n = 0; n < 4; ++n) { const pg8::f32x4 sv = acc[G4 * 4 + n];
              yw[2 * n] = pk2(bflo(uw[2 * n]) * (sv.x + bs), bfhi(uw[2 * n]) * (sv.y + bs));
              yw[2 * n + 1] = pk2(bflo(uw[2 * n + 1]) * (sv.z + bs), bfhi(uw[2 * n + 1]) * (sv.w + bs)); }
          bf16* yp = Y + (size_t)(r0 + t) * DM + g * DV + 64 * G4 + 16 * fq;
          *(GAS v4u*)yp = (v4u){yw[0], yw[1], yw[2], yw[3]}; *(GAS v4u*)(yp + 8) = (v4u){yw[4], yw[5], yw[6], yw[7]}; } }
}

__device__ __forceinline__ void sample_unit(Frame& F, int unit) {
    int tid = ((int)threadIdx.x); asm volatile("" : "+v"(tid));
    const int h = unit & 3, sb = unit >> 2, r0 = MP + sb * DSEQ, lane = tid & 63, wave = F.wave;
    LAS float* L = (LAS float*)F.lds;
    LAS float* QT = L; LAS float* KT = L + 1024; LAS float* KD = L + 2048; LAS float* DC = L + 3072; LAS float* ATT = L + 3200; LAS float* RS = L + 3264; LAS float* QS = L + 3400; LAS float* RED = L + 4608;
    const bf16* Vb = (const bf16*)(F.ws + WS_V); const bf16* U = (const bf16*)(F.ws + WS_U); const float* VSS = (const float*)(F.ws + WS_VSS);
    const bf16* Q = (const bf16*)(F.ws + WS_Q); const bf16* KBp = (const bf16*)(F.ws + WS_KB); const bf16* VB = (const bf16*)(F.ws + WS_VB); const bf16* SZB = (const bf16*)(F.ws + WS_SZB);
    const float* LAg = (const float*)(F.ws + WS_LA); bf16* Y = (bf16*)(F.ws + WS_Y);
    const int d = tid & 255, th = tid >> 8, col = h * DV + d, v4 = lane, dg = wave, chp = h * DK + (tid & 127);
    f32x4 ssv[4]; float bsv = 0.f; if (tid < 8) { const GAS f32x4* p = (const GAS f32x4*)(VSS + (size_t)(r0 + tid) * 16); ssv[0] = p[0]; ssv[1] = p[1]; ssv[2] = p[2]; ssv[3] = p[3]; bsv = F.b_s[h * CH + tid]; }
    float wsv = 0.f; if (tid < 64) wsv = F.w_s[(size_t)h * CH * CH + (tid >> 3) * CH + (tid & 7)];
    bf16 vraw[8], uraw[4];
#pragma unroll
    for (int s2 = 0; s2 < 8; ++s2) vraw[s2] = Vb[(size_t)(r0 + s2) * EA + col];
#pragma unroll
    for (int i = 0; i < 4; ++i) uraw[i] = U[(size_t)(r0 + th * 4 + i) * EA + col];
    const float gv = F.g_v[col];
    float laraw[8]; bf16 qraw[8], kraw[8];
    if (tid < 128) {
#pragma unroll
        for (int t = 0; t < 8; ++t) { laraw[t] = LAg[(size_t)(r0 + t) * KBW + chp]; qraw[t] = Q[(size_t)(r0 + t) * KBW + chp]; kraw[t] = KBp[(size_t)(r0 + t) * KBW + chp]; } }
    v2u vvraw[8];
#pragma unroll
    for (int s2 = 0; s2 < 8; ++s2) vvraw[s2] = *(const GAS v2u*)(VB + (size_t)(r0 + s2) * EB + h * DV + 4 * v4);
    const v2u zz = *(const GAS v2u*)(SZB + (size_t)(r0 + wave) * EB + h * DV + 4 * v4); const f32x4 go = *(const GAS f32x4*)(F.g_o + h * DV + 4 * v4);
    const float* S0 = F.st0 + ((size_t)(sb * HB + h) * DK) * DV; float* SN = F.out + OUT_SS + ((size_t)(sb * HB + h) * DK) * DV;
    f32x4 s0r[16];
#pragma unroll
    for (int dd = 0; dd < 16; ++dd) s0r[dd] = __builtin_nontemporal_load((const GAS f32x4*)(S0 + (size_t)(dg * 16 + dd) * DV + 4 * v4));
    __syncthreads();
    if (tid < 8) { const f32x4 a = ssv[0], b4 = ssv[1], c4 = ssv[2], d4 = ssv[3];
        const float ss = ((a.x + a.y) + (a.z + a.w)) + ((b4.x + b4.y) + (b4.z + b4.w)) + ((c4.x + c4.y) + (c4.z + c4.w)) + ((d4.x + d4.y) + (d4.z + d4.w));
        RS[tid] = 1.0f / sqrtf(ss * (1.f / EA) + EPS); RS[8 + tid] = bsv; }
    if (tid < 64) RS[16 + tid] = wsv;
    __syncthreads();
    {
        float vn[8];
#pragma unroll
        for (int s2 = 0; s2 < 8; ++s2) vn[s2] = bf2f(vraw[s2]) * RS[s2] * gv;
#pragma unroll
        for (int i = 0; i < 4; ++i) { const int t = th * 4 + i; float S = RS[8 + t];
#pragma unroll
            for (int s2 = 0; s2 < 8; ++s2) if (s2 <= t) S += RS[16 + t * 8 + s2] * vn[s2];
            Y[(size_t)(r0 + t) * DM + col] = (bf16)f2bf(bf2f(uraw[i]) * S);
            float vt = 0.f;
#pragma unroll
            for (int s2 = 0; s2 < 8; ++s2) vt = (s2 == t) ? vn[s2] : vt;
            F.out[OUT_CV + (size_t)(sb * DSEQ + t) * EA + col] = vt; }
    }
    if (tid < 128) { const int dq = tid; float bc[8]; float run = 0.f;
#pragma unroll
        for (int t = 0; t < 8; ++t) { run += laraw[t]; bc[t] = run; }
        const float dcv = __expf(run); DC[dq] = dcv;
#pragma unroll
        for (int t = 0; t < 8; ++t) { const float q = bf2f(qraw[t]), k = bf2f(kraw[t]);
            const float eb = __expf(bc[t]), ek = __builtin_amdgcn_rcpf(eb); const float qt = q * eb, kt = k * ek; QT[dq * 8 + t] = qt; QS[t * 128 + dq] = qt; KT[t * 128 + dq] = kt; KD[dq * 8 + t] = kt * dcv; }
    }
    __syncthreads();
    { const int p = tid >> 3, part = tid & 7, t = p >> 3, s2 = p & 7; float a = 0.f;
      if (s2 <= t) {
#pragma unroll
          for (int dd = 0; dd < 16; ++dd) a += QS[t * 128 + part * 16 + dd] * KT[s2 * 128 + part * 16 + dd]; }
      a += __shfl_xor(a, 1); a += __shfl_xor(a, 2); a += __shfl_xor(a, 4);
      if (part == 0) ATT[p] = a; }
    f32x4 vv[8];
#pragma unroll
    for (int s2 = 0; s2 < 8; ++s2) vv[s2] = (f32x4){bflo(vvraw[s2].x), bfhi(vvraw[s2].x), bflo(vvraw[s2].y), bfhi(vvraw[s2].y)};
    f32x4 oacc[8];
#pragma unroll
    for (int t = 0; t < 8; ++t) oacc[t] = (f32x4){0.f, 0.f, 0.f, 0.f};
#pragma unroll
    for (int dd = 0; dd < 16; ++dd) { const int dr = dg * 16 + dd; const f32x4 s0 = s0r[dd];
        const f32x4 q0 = *(const LAS f32x4*)(QT + dr * 8), q1 = *(const LAS f32x4*)(QT + dr * 8 + 4), k0 = *(const LAS f32x4*)(KD + dr * 8), k1 = *(const LAS f32x4*)(KD + dr * 8 + 4);
        oacc[0] += q0.x * s0; oacc[1] += q0.y * s0; oacc[2] += q0.z * s0; oacc[3] += q0.w * s0; oacc[4] += q1.x * s0; oacc[5] += q1.y * s0; oacc[6] += q1.z * s0; oacc[7] += q1.w * s0;
        f32x4 sn = DC[dr] * s0; sn += k0.x * vv[0]; sn += k0.y * vv[1]; sn += k0.z * vv[2]; sn += k0.w * vv[3]; sn += k1.x * vv[4]; sn += k1.y * vv[5]; sn += k1.z * vv[6]; sn += k1.w * vv[7];
        __builtin_nontemporal_store(sn, (GAS f32x4*)(SN + (size_t)dr * DV + 4 * v4)); }
#pragma unroll
    for (int t = 0; t < 8; ++t) *(LAS f32x4*)(RED + (dg * 8 + t) * 256 + 4 * v4) = oacc[t];
    __syncthreads();
    { const int t = wave; f32x4 o = (f32x4){0.f, 0.f, 0.f, 0.f};
#pragma unroll
      for (int g2 = 0; g2 < 8; ++g2) o += *(const LAS f32x4*)(RED + (g2 * 8 + t) * 256 + 4 * v4);
#pragma unroll
      for (int s2 = 0; s2 < 8; ++s2) o += ATT[t * 8 + s2] * vv[s2];
      const float ss = wave_sum((o.x * o.x + o.y * o.y) + (o.z * o.z + o.w * o.w)); const float rs = 1.0f / sqrtf(ss * (1.f / DV) + EPS);
      v2u w; w.x = pk2(o.x * rs * go.x * bflo(zz.x), o.y * rs * go.y * bfhi(zz.x)); w.y = pk2(o.z * rs * go.z * bflo(zz.y), o.w * rs * go.w * bfhi(zz.y));
      *(GAS v2u*)(Y + (size_t)(r0 + t) * DM + EA + h * DV + 4 * v4) = w; }
}

constexpr int PRP = 264, PRT = 68;
__device__ __forceinline__ void prep_unit(Frame& F, int unit) {
    int tid = ((int)threadIdx.x); asm volatile("" : "+v"(tid));
    const int hp = unit & 1, cc = (unit >> 1) & 31, b = unit >> 6, r0 = b * SEQ + cc * GC, ch = tid & 255, th = tid >> 8, c0 = hp * 256;
    LAS bf16* QL = (LAS bf16*)F.lds;
    LAS bf16* KL = QL + 64 * PRP;
    LAS bf16* KTL = KL + 64 * PRP;
    LAS float* TOT = (LAS float*)(KTL + 256 * PRT);
    const float* LAg = (const float*)(F.ws + WS_LA); const bf16* Q = (const bf16*)(F.ws + WS_Q); const bf16* KBp = (const bf16*)(F.ws + WS_KB);
    bf16* QTg = (bf16*)(F.ws + WS_QT); bf16* KTT = (bf16*)(F.ws + WS_KTT); float* DEC = (float*)(F.ws + WS_DEC);
    __syncthreads();
    float bl[32]; float run = 0.f;
#pragma unroll
    for (int i2 = 0; i2 < 32; ++i2) { run += LAg[(size_t)(r0 + 32 * th + i2) * KBW + c0 + ch]; bl[i2] = run; }
    TOT[th * 256 + ch] = run;
    __syncthreads();
    const float t0 = TOT[ch], t1 = TOT[256 + ch], off = th ? t0 : 0.f;
    if (th == 0) DEC[((size_t)(b * HB + 2 * hp + (ch >> 7)) * NCH + cc) * DK + (ch & 127)] = __expf(t0 + t1);
#pragma unroll
    for (int i2 = 0; i2 < 32; ++i2) { const int t = 32 * th + i2; const float eb = __expf(bl[i2] + off), ek = __builtin_amdgcn_rcpf(eb);
        const float q = bf2f(Q[(size_t)(r0 + t) * KBW + c0 + ch]), k = bf2f(KBp[(size_t)(r0 + t) * KBW + c0 + ch]);
        const bf16 kb = (bf16)f2bf(k * ek); QL[t * PRP + ch] = (bf16)f2bf(q * eb); KL[t * PRP + ch] = kb; KTL[ch * PRT + t] = kb; }
    __syncthreads();
#pragma unroll
    for (int i2 = 0; i2 < 4; ++i2) { const int p = tid + NTHR * i2, t = p >> 5, c8 = (p & 31) * 8; const size_t o = ((size_t)(b * HB + 2 * hp + (c8 >> 7)) * SEQ + cc * GC + t) * DK + (c8 & 127);
        *(GAS v4u*)(QTg + o) = *(const LAS v4u*)(QL + t * PRP + c8); }
    { const int lane = tid & 63, fr = lane & 15, fq = lane >> 4, hl = F.wave >> 2, ti = F.wave & 3; bf16* ATg = (bf16*)(F.ws + WS_ATT) + ((size_t)(b * HB + 2 * hp + hl) * NCH + cc) * GC * GC;
      bf16x8 qf[4];
#pragma unroll
      for (int kk = 0; kk < 4; ++kk) qf[kk] = *(const LAS bf16x8*)(QL + (16 * ti + fr) * PRP + hl * 128 + 32 * kk + 8 * fq);
#pragma unroll
      for (int si = 0; si < 4; ++si) { pg8::f32x4 a = (pg8::f32x4){0.f, 0.f, 0.f, 0.f};
          if (si <= ti) {
#pragma unroll
              for (int kk = 0; kk < 4; ++kk) a = __builtin_amdgcn_mfma_f32_16x16x32_bf16(*(const LAS bf16x8*)(KL + (16 * si + fr) * PRP + hl * 128 + 32 * kk + 8 * fq), qf[kk], a, 0, 0, 0); }
          const int t = 16 * ti + fr, s0 = 16 * si + 4 * fq; v2u w;
          w.x = pk2(s0 <= t ? a.x : 0.f, s0 + 1 <= t ? a.y : 0.f); w.y = pk2(s0 + 2 <= t ? a.z : 0.f, s0 + 3 <= t ? a.w : 0.f);
          *(GAS v2u*)(ATg + t * GC + s0) = w; } }
#pragma unroll
    for (int i2 = 0; i2 < 4; ++i2) { const int p = tid + NTHR * i2, chh = p >> 3, t8 = (p & 7) * 8; const v2u a = *(const LAS v2u*)(KTL + chh * PRT + t8), c2 = *(const LAS v2u*)(KTL + chh * PRT + t8 + 4);
        *(GAS v4u*)(KTT + (((size_t)(b * HB + 2 * hp + (chh >> 7)) * NCH + cc) * DK + (chh & 127)) * GC + t8) = (v4u){a.x, a.y, c2.x, c2.y}; }
}

constexpr int PQ = 136, PS64 = 72;
__device__ __forceinline__ bf16x8 ldfrag(const LAS bf16* base, int row, int pitch, int k0) { return *(const LAS bf16x8*)(base + row * pitch + k0); }
struct GlaStage { v4u q[2], kt[2], at, v; float dec; };
template <int NVT>
__device__ __forceinline__ void gla_unit(Frame& F, int unit, bool fuse_norm) {
    constexpr int SW = 16 * NVT, NSL = DV / SW, VPR = SW / 8  ;
    int tid = ((int)threadIdx.x); asm volatile("" : "+v"(tid));
    const int bh = unit / NSL, j = unit % NSL, b = bh >> 2, h = bh & 3, lane = tid & 63, wave = F.wave, fr = lane & 15, fq = lane >> 4;
    constexpr int SET_E = 64 * PQ + 128 * PS64 + SW * PS64 + 64 * PS64 + 256;
    LAS bf16* L0 = (LAS bf16*)F.lds; LAS bf16* STL = L0 + 2 * SET_E;
    const bf16* QTg = (const bf16*)(F.ws + WS_QT) + (size_t)bh * SEQ * DK; const bf16* ATg = (const bf16*)(F.ws + WS_ATT) + (size_t)bh * NCH * GC * GC;
    const bf16* KTT = (const bf16*)(F.ws + WS_KTT) + (size_t)bh * NCH * DK * GC; const float* DEC = (const float*)(F.ws + WS_DEC) + (size_t)bh * NCH * DK;
    const bf16* VB = (const bf16*)(F.ws + WS_VB) + (size_t)(b * SEQ) * EB + h * DV + j * SW; bf16* O = (bf16*)(F.ws + WS_O) + (size_t)(b * SEQ) * EB + h * DV + j * SW;
    __syncthreads();
    for (int i = tid; i < 2 * SW * PQ / 2; i += NTHR) ((LAS unsigned*)STL)[i] = 0u;
#define GLA_LD16(dst, ptr) asm volatile("global_load_dwordx4 %0, %1, off" : "=v"(dst) : "v"(ptr) : "memory")
#define GLA_FETCH(R, c) do { const int c_ = (c) < NCH ? (c) : NCH - 1; \
        GLA_LD16(R.q[0], QTg + (size_t)c_ * GC * DK + tid * 8); GLA_LD16(R.q[1], QTg + (size_t)c_ * GC * DK + (tid + NTHR) * 8); \
        GLA_LD16(R.kt[0], KTT + (size_t)c_ * DK * GC + tid * 8); GLA_LD16(R.kt[1], KTT + (size_t)c_ * DK * GC + (tid + NTHR) * 8); \
        GLA_LD16(R.at, ATg + (size_t)c_ * GC * GC + tid * 8); \
        { const int tv_ = tid % (64 * VPR), s_ = tv_ / VPR, hf_ = tv_ % VPR; GLA_LD16(R.v, VB + (size_t)(c_ * GC + s_) * EB + hf_ * 8); } \
        asm volatile("global_load_dword %0, %1, off" : "=v"(R.dec) : "v"(DEC + c_ * DK + (tid & 127)) : "memory"); } while (0)
#define GLA_WAIT(R, n) asm volatile("s_waitcnt vmcnt(" #n ")" : "+v"(R.q[0]), "+v"(R.q[1]), "+v"(R.kt[0]), "+v"(R.kt[1]), "+v"(R.at), "+v"(R.v), "+v"(R.dec) :: "memory")
#define GLA_COMMIT(R, set) do { LAS bf16* QL_ = L0 + (set) * SET_E; LAS bf16* KTL_ = QL_ + 64 * PQ; LAS bf16* VTL_ = KTL_ + 128 * PS64; LAS bf16* ATL_ = VTL_ + SW * PS64; LAS float* DCL_ = (LAS float*)(ATL_ + 64 * PS64); \
        _Pragma("unroll") for (int i_ = 0; i_ < 2; ++i_) { const int p_ = tid + NTHR * i_; { const int r_ = p_ >> 4, cch_ = p_ & 15; *(LAS v4u*)(QL_ + r_ * PQ + cch_ * 8) = R.q[i_]; } \
            { const int r_ = p_ >> 3, cch_ = p_ & 7; *(LAS v4u*)(KTL_ + r_ * PS64 + cch_ * 8) = R.kt[i_]; } } \
        { const int r_ = tid >> 3, cch_ = tid & 7; *(LAS v4u*)(ATL_ + r_ * PS64 + cch_ * 8) = R.at; } \
        if (tid < 64 * VPR) { const int s_ = tid / VPR, hf_ = tid % VPR; const unsigned w_[4] = {R.v.x, R.v.y, R.v.z, R.v.w}; \
            _Pragma("unroll") for (int e_ = 0; e_ < 4; ++e_) { VTL_[(hf_ * 8 + 2 * e_) * PS64 + s_] = (bf16)(w_[e_] & 0xffffu); VTL_[(hf_ * 8 + 2 * e_ + 1) * PS64 + s_] = (bf16)(w_[e_] >> 16); } } \
        if (tid < 128) DCL_[tid] = R.dec; } while (0)
    pg8::f32x4 sacc[2][NVT];
#pragma unroll
    for (int e = 0; e < 2; ++e)
#pragma unroll
        for (int vt = 0; vt < NVT; ++vt) sacc[e][vt] = (pg8::f32x4){0.f, 0.f, 0.f, 0.f};
    GlaStage ra, rb, rc;
    GLA_FETCH(ra, 0); GLA_WAIT(ra, 0); GLA_COMMIT(ra, 0); GLA_FETCH(ra, 1); GLA_FETCH(rb, 2); GLA_FETCH(rc, 3);
    __syncthreads();
#define GLA_STEP(R, cc) { const int c = (cc); GLA_WAIT(R, 14); if (c + 1 < NCH) GLA_COMMIT(R, (c + 1) & 1); GLA_FETCH(R, c + 4);
    for (int c3 = 0; c3 < NCH; c3 += 3) {
        GLA_STEP(ra, c3)
        const LAS bf16* QL = L0 + (c & 1) * SET_E; const LAS bf16* KTL = QL + 64 * PQ; const LAS bf16* VTL = KTL + 128 * PS64; const LAS bf16* ATL = VTL + SW * PS64; const LAS float* DCL = (const LAS float*)(ATL + 64 * PS64);
        const LAS bf16* STc = STL + (c & 1) * SW * PQ; LAS bf16* STn = STL + ((c + 1) & 1) * SW * PQ;
        if (wave < 4) {
            const int ti = wave; pg8::f32x4 o[NVT];
#pragma unroll
            for (int vt = 0; vt < NVT; ++vt) o[vt] = (pg8::f32x4){0.f, 0.f, 0.f, 0.f};
#pragma unroll
            for (int kk = 0; kk < 2; ++kk) { const bf16x8 bf = ldfrag(ATL, 16 * ti + fr, PS64, 32 * kk + 8 * fq);
#pragma unroll
                for (int vt = 0; vt < NVT; ++vt) o[vt] = __builtin_amdgcn_mfma_f32_16x16x32_bf16(ldfrag(VTL, 16 * vt + fr, PS64, 32 * kk + 8 * fq), bf, o[vt], 0, 0, 0); }
#pragma unroll
            for (int kk = 0; kk < 4; ++kk) { const bf16x8 bf = ldfrag(QL, 16 * ti + fr, PQ, 32 * kk + 8 * fq);
#pragma unroll
                for (int vt = 0; vt < NVT; ++vt) o[vt] = __builtin_amdgcn_mfma_f32_16x16x32_bf16(ldfrag(STc, 16 * vt + fr, PQ, 32 * kk + 8 * fq), bf, o[vt], 0, 0, 0); }
#pragma unroll
            for (int vt = 0; vt < NVT; ++vt) *(GAS v2u*)(O + (size_t)(c * GC + 16 * ti + fr) * EB + 16 * vt + 4 * fq) = (v2u){pk2(o[vt].x, o[vt].y), pk2(o[vt].z, o[vt].w)};
        } else {
#pragma unroll
            for (int e = 0; e < 2; ++e) { const int dt = 2 * (wave - 4) + e; const pg8::f32x4 dc = *(const LAS pg8::f32x4*)(DCL + 16 * dt + 4 * fq);
                const bf16x8 a0 = ldfrag(KTL, 16 * dt + fr, PS64, 8 * fq), a1 = ldfrag(KTL, 16 * dt + fr, PS64, 32 + 8 * fq);
#pragma unroll
                for (int vt = 0; vt < NVT; ++vt) { pg8::f32x4 sv = sacc[e][vt];
                    sv = __builtin_amdgcn_mfma_f32_16x16x32_bf16(a0, ldfrag(VTL, 16 * vt + fr, PS64, 8 * fq), sv, 0, 0, 0);
                    sv = __builtin_amdgcn_mfma_f32_16x16x32_bf16(a1, ldfrag(VTL, 16 * vt + fr, PS64, 32 + 8 * fq), sv, 0, 0, 0);
                    sv = sv * dc; sacc[e][vt] = sv; v2u w; w.x = pk2(sv.x, sv.y); w.y = pk2(sv.z, sv.w);
                    *(LAS v2u*)(STn + (16 * vt + fr) * PQ + 16 * dt + 4 * fq) = w; } }
        }
        __syncthreads();
        }
        if (c3 + 1 < NCH) GLA_STEP(rb, c3 + 1)
        const LAS bf16* QL = L0 + (c & 1) * SET_E; const LAS bf16* KTL = QL + 64 * PQ; const LAS bf16* VTL = KTL + 128 * PS64; const LAS bf16* ATL = VTL + SW * PS64; const LAS float* DCL = (const LAS float*)(ATL + 64 * PS64);
        const LAS bf16* STc = STL + (c & 1) * SW * PQ; LAS bf16* STn = STL + ((c + 1) & 1) * SW * PQ;
        if (wave < 4) {
            const int ti = wave; pg8::f32x4 o[NVT];
#pragma unroll
            for (int vt = 0; vt < NVT; ++vt) o[vt] = (pg8::f32x4){0.f, 0.f, 0.f, 0.f};
#pragma unroll
            for (int kk = 0; kk < 2; ++kk) { const bf16x8 bf = ldfrag(ATL, 16 * ti + fr, PS64, 32 * kk + 8 * fq);
#pragma unroll
                for (int vt = 0; vt < NVT; ++vt) o[vt] = __builtin_amdgcn_mfma_f32_16x16x32_bf16(ldfrag(VTL, 16 * vt + fr, PS64, 32 * kk + 8 * fq), bf, o[vt], 0, 0, 0); }
#pragma unroll
            for (int kk = 0; kk < 4; ++kk) { const bf16x8 bf = ldfrag(QL, 16 * ti + fr, PQ, 32 * kk + 8 * fq);
#pragma unroll
                for (int vt = 0; vt < NVT; ++vt) o[vt] = __builtin_amdgcn_mfma_f32_16x16x32_bf16(ldfrag(STc, 16 * vt + fr, PQ, 32 * kk + 8 * fq), bf, o[vt], 0, 0, 0); }
#pragma unroll
            for (int vt = 0; vt < NVT; ++vt) *(GAS v2u*)(O + (size_t)(c * GC + 16 * ti + fr) * EB + 16 * vt + 4 * fq) = (v2u){pk2(o[vt].x, o[vt].y), pk2(o[vt].z, o[vt].w)};
        } else {
#pragma unroll
            for (int e = 0; e < 2; ++e) { const int dt = 2 * (wave - 4) + e; const pg8::f32x4 dc = *(const LAS pg8::f32x4*)(DCL + 16 * dt + 4 * fq);
                const bf16x8 a0 = ldfrag(KTL, 16 * dt + fr, PS64, 8 * fq), a1 = ldfrag(KTL, 16 * dt + fr, PS64, 32 + 8 * fq);
#pragma unroll
                for (int vt = 0; vt < NVT; ++vt) { pg8::f32x4 sv = sacc[e][vt];
                    sv = __builtin_amdgcn_mfma_f32_16x16x32_bf16(a0, ldfrag(VTL, 16 * vt + fr, PS64, 8 * fq), sv, 0, 0, 0);
                    sv = __builtin_amdgcn_mfma_f32_16x16x32_bf16(a1, ldfrag(VTL, 16 * vt + fr, PS64, 32 + 8 * fq), sv, 0, 0, 0);
                    sv = sv * dc; sacc[e][vt] = sv; v2u w; w.x = pk2(sv.x, sv.y); w.y = pk2(sv.z, sv.w);
                    *(LAS v2u*)(STn + (16 * vt + fr) * PQ + 16 * dt + 4 * fq) = w; } }
        }
        __syncthreads();
        }
        if (c3 + 2 < NCH) GLA_STEP(rc, c3 + 2)
        const LAS bf16* QL = L0 + (c & 1) * SET_E; const LAS bf16* KTL = QL + 64 * PQ; const LAS bf16* VTL = KTL + 128 * PS64; const LAS bf16* ATL = VTL + SW * PS64; const LAS float* DCL = (const LAS float*)(ATL + 64 * PS64);
        const LAS bf16* STc = STL + (c & 1) * SW * PQ; LAS bf16* STn = STL + ((c + 1) & 1) * SW * PQ;
        if (wave < 4) {
            const int ti = wave; pg8::f32x4 o[NVT];
#pragma unroll
            for (int vt = 0; vt < NVT; ++vt) o[vt] = (pg8::f32x4){0.f, 0.f, 0.f, 0.f};
#pragma unroll
            for (int kk = 0; kk < 2; ++kk) { const bf16x8 bf = ldfrag(ATL, 16 * ti + fr, PS64, 32 * kk + 8 * fq);
#pragma unroll
                for (int vt = 0; vt < NVT; ++vt) o[vt] = __builtin_amdgcn_mfma_f32_16x16x32_bf16(ldfrag(VTL, 16 * vt + fr, PS64, 32 * kk + 8 * fq), bf, o[vt], 0, 0, 0); }
#pragma unroll
            for (int kk = 0; kk < 4; ++kk) { const bf16x8 bf = ldfrag(QL, 16 * ti + fr, PQ, 32 * kk + 8 * fq);
#pragma unroll
                for (int vt = 0; vt < NVT; ++vt) o[vt] = __builtin_amdgcn_mfma_f32_16x16x32_bf16(ldfrag(STc, 16 * vt + fr, PQ, 32 * kk + 8 * fq), bf, o[vt], 0, 0, 0); }
#pragma unroll
            for (int vt = 0; vt < NVT; ++vt) *(GAS v2u*)(O + (size_t)(c * GC + 16 * ti + fr) * EB + 16 * vt + 4 * fq) = (v2u){pk2(o[vt].x, o[vt].y), pk2(o[vt].z, o[vt].w)};
        } else {
#pragma unroll
            for (int e = 0; e < 2; ++e) { const int dt = 2 * (wave - 4) + e; const pg8::f32x4 dc = *(const LAS pg8::f32x4*)(DCL + 16 * dt + 4 * fq);
                const bf16x8 a0 = ldfrag(KTL, 16 * dt + fr, PS64, 8 * fq), a1 = ldfrag(KTL, 16 * dt + fr, PS64, 32 + 8 * fq);
#pragma unroll
                for (int vt = 0; vt < NVT; ++vt) { pg8::f32x4 sv = sacc[e][vt];
                    sv = __builtin_amdgcn_mfma_f32_16x16x32_bf16(a0, ldfrag(VTL, 16 * vt + fr, PS64, 8 * fq), sv, 0, 0, 0);
                    sv = __builtin_amdgcn_mfma_f32_16x16x32_bf16(a1, ldfrag(VTL, 16 * vt + fr, PS64, 32 + 8 * fq), sv, 0, 0, 0);
                    sv = sv * dc; sacc[e][vt] = sv; v2u w; w.x = pk2(sv.x, sv.y); w.y = pk2(sv.z, sv.w);
                    *(LAS v2u*)(STn + (16 * vt + fr) * PQ + 16 * dt + 4 * fq) = w; } }
        }
        __syncthreads();
        }
    }
#undef GLA_STEP
    GLA_WAIT(ra, 0); GLA_WAIT(rb, 0); GLA_WAIT(rc, 0);
    if (wave >= 4) { float* SP = F.out + OUT_SP + (size_t)bh * DK * DV + j * SW;
#pragma unroll
        for (int e = 0; e < 2; ++e) { const int dt = 2 * (wave - 4) + e;
#pragma unroll
            for (int vt = 0; vt < NVT; ++vt)
#pragma unroll
                for (int i = 0; i < 4; ++i) SP[(size_t)(16 * dt + 4 * fq + i) * DV + 16 * vt + fr] = sacc[e][vt][i]; } }
#undef GLA_FETCH
#undef GLA_COMMIT
#undef GLA_WAIT
#undef GLA_LD16
    if (fuse_norm) {
        asm volatile("s_waitcnt vmcnt(0)" ::: "memory");
        __syncthreads();
        if (tid == 0) { unsigned* cnt = (unsigned*)(F.ws + WS_CTL) + CW_GRP + 64 * bh;
            __builtin_amdgcn_fence(__ATOMIC_RELEASE, "agent"); asm volatile("s_waitcnt vmcnt(0)" ::: "memory");
            (void)__hip_atomic_fetch_add(cnt, 1u, __ATOMIC_RELAXED, __HIP_MEMORY_SCOPE_AGENT); }
    }
}
__device__ __forceinline__ void head_norm(Frame& F, int bh, int rlo, unsigned need) {
    const int tid = (int)threadIdx.x, lane = tid & 63, wave = F.wave, b = bh >> 2, h = bh & 3;
    if (tid == 0) { unsigned* cnt = (unsigned*)(F.ws + WS_CTL) + CW_GRP + 64 * bh;
        unsigned sp = 0; while (__hip_atomic_load(cnt, __ATOMIC_RELAXED, __HIP_MEMORY_SCOPE_AGENT) < need) { __builtin_amdgcn_s_sleep(2); if (++sp > (1u << 20)) break; }
        __builtin_amdgcn_fence(__ATOMIC_ACQUIRE, "agent"); asm volatile("s_waitcnt vmcnt(0)" ::: "memory"); }
    __syncthreads();
    const bf16* Oh = (const bf16*)(F.ws + WS_O) + (size_t)(b * SEQ) * EB + h * DV; const bf16* SZB = (const bf16*)(F.ws + WS_SZB) + (size_t)(b * SEQ) * EB + h * DV; bf16* Y = (bf16*)(F.ws + WS_Y) + (size_t)(b * SEQ) * DM + EA + h * DV;
    const f32x4 go = *(const GAS f32x4*)(F.g_o + h * DV + 4 * lane);
    constexpr int NB = 16; v2u ob[NB], zz[NB];
#pragma unroll
    for (int q = 0; q < NB; ++q) { const int row = rlo + wave + NWAVES * q; ob[q] = *(const GAS v2u*)(Oh + (size_t)row * EB + 4 * lane); zz[q] = *(const GAS v2u*)(SZB + (size_t)row * EB + 4 * lane); }
#pragma unroll
    for (int q = 0; q < NB; ++q) { const int row = rlo + wave + NWAVES * q;
        const f32x4 o = (f32x4){bflo(ob[q].x), bfhi(ob[q].x), bflo(ob[q].y), bfhi(ob[q].y)};
        const float ss = wave_sum((o.x * o.x + o.y * o.y) + (o.z * o.z + o.w * o.w)); const float rs = 1.0f / sqrtf(ss * (1.f / DV) + EPS);
        v2u w; w.x = pk2(o.x * rs * go.x * bflo(zz[q].x), o.y * rs * go.y * bfhi(zz[q].x)); w.y = pk2(o.z * rs * go.z * bflo(zz[q].y), o.w * rs * go.w * bfhi(zz[q].y));
        *(GAS v2u*)(Y + (size_t)row * DM + 4 * lane) = w; }
}

struct Args { const float* in[19]; float* out; unsigned char* ws; int ph_lo, ph_hi, li, pad; };
constexpr int NPHASE = 11;
__global__ void __launch_bounds__(NTHR, 2) fwd_kernel(Args args) {
    extern __shared__ __attribute__((aligned(16))) unsigned char lds[];
    Frame F;
    F.lds = (LAS unsigned char*)lds; F.ws = args.ws; F.out = args.out;
    F.wave = __builtin_amdgcn_readfirstlane((int)threadIdx.x >> 6);
    F.G = gridDim.x; { const int bx = blockIdx.x; F.vcu = (F.G % 8 == 0) ? (bx % 8) * (F.G / 8) + bx / 8 : bx; }
    F.xp = args.in[0]; F.xs = args.in[1]; F.pp = args.in[2]; F.ps = args.in[3]; F.st0 = args.in[4]; F.g_pre = args.in[5]; F.w_in = args.in[6]; F.g_v = args.in[7]; F.w_s = args.in[8]; F.b_s = args.in[9];
    F.w_a2 = args.in[10]; F.b_a = args.in[11]; F.g_o = args.in[12]; F.w_pa = args.in[13]; F.w_pb = args.in[14]; F.w_o = args.in[15]; F.g_post = args.in[16]; F.w_pg = args.in[17]; F.w_pe = args.in[18];
    volatile LAS unsigned* MISC = (volatile LAS unsigned*)(F.lds + MISC_OFF);
    if (((int)threadIdx.x) < 64) MISC[((int)threadIdx.x)] = 0u;
    __syncthreads();
    XcdBarrier bar; bar.bar = (unsigned*)(F.ws + WS_CTL) + CW_BAR + args.li * XCD_BAR_WORDS; bar.x = 0; bar.st = nullptr;
    const int lo = args.ph_lo, hi = args.ph_hi;
    if (hi - lo > 1) bar = xcd_barrier_post(bar.bar, MISC + 8);
#define IN(k) (lo <= (k) && (k) < hi)
#define SEAM(k) do { if (IN(k) && IN((k) + 1)) xcd_barrier(bar); } while (0)
    unsigned char* ws = F.ws;

    if (IN(0)) { p0_prologue(F); } SEAM(0);

    if (IN(1)) {
        pg8::Gemm g{(const bf16*)(ws + WS_XN), (const bf16*)(ws + WS_W1T), DM, DM}; pg8::StaticOrder S; S.init(MT, N1, DM, F.G, (int)blockIdx.x);
        EpiG1 E{ws, F.b_a};
        pg8::gemm_phase<EpiG1, pg8::StaticOrder>(F.lds, g, S, E);
        { const int nfullc = S.nwg % F.G;
          pg8::Gemm g2{(const bf16*)(ws + WS_PBF), (const bf16*)(ws + WS_WPE), PLE, PLE}; pg8::ESampleOrder S2{nfullc ? F.G - nfullc : F.G, nfullc ? (int)blockIdx.x - nfullc : (int)blockIdx.x};
          EpiBf E2{(bf16*)(ws + WS_ES) - (size_t)MP * DM, DM};
          pg8::gemm_phase<EpiBf, pg8::ESampleOrder>(F.lds, g2, S2, E2); }
    } SEAM(1);

    const bool hetero = (F.G == 256);
    const bool fuse_norm = hetero || (F.G % 16) == 0;
    if (IN(2)) {
        if (hetero) { for (int u = F.vcu; u < 512; u += F.G) { if (u < 256) prep_unit(F, u); else gate_prompt_unit(F, u - 256); } }
        else { for (int u = F.vcu; u < 1024; u += F.G) { if (u < 256) gate_prompt_unit(F, u); else if (u < 768) sample_unit(F, u - 256); else prep_unit(F, u - 768); } }
    } SEAM(2);

    if (IN(3)) {
        if (hetero) { const int xcd = F.vcu >> 5, l = F.vcu & 31;
            if (l < 16) gla_unit<2>(F, (xcd * 2 + (l >> 3)) * 8 + (l & 7), true);
            else { for (int u = xcd * 16 + (l - 16); u < 512; u += 128) sample_unit(F, u); }
            __syncthreads(); head_norm(F, F.vcu >> 4, 128 * (F.vcu & 15), 8u); }
        else { for (int u = F.vcu; u < 256; u += F.G) gla_unit<1>(F, u, fuse_norm);
               if (fuse_norm) { for (int u = F.vcu; u < 256; u += F.G) head_norm(F, u >> 4, 128 * (u & 15), 16u); } }
    } SEAM(3);

    if (IN(4) && !fuse_norm) {
        const int gw = F.vcu * NWAVES + F.wave, NGW = F.G * NWAVES; const bf16* O = (const bf16*)(ws + WS_O); const bf16* SZB = (const bf16*)(ws + WS_SZB); bf16* Y = (bf16*)(ws + WS_Y);
        for (int m = gw; m < MP; m += NGW) {
#pragma unroll
            for (int h = 0; h < HB; ++h) { const v2u ob = *(const GAS v2u*)(O + (size_t)m * EB + h * DV + 4 * ((int)(threadIdx.x & 63u))); const f32x4 o = (f32x4){bflo(ob.x), bfhi(ob.x), bflo(ob.y), bfhi(ob.y)};
                const float ss = wave_sum((o.x * o.x + o.y * o.y) + (o.z * o.z + o.w * o.w)); const float rs = 1.0f / sqrtf(ss * (1.f / DV) + EPS);
                const f32x4 go = *(const GAS f32x4*)(F.g_o + h * DV + 4 * ((int)(threadIdx.x & 63u))); const v2u zz = *(const GAS v2u*)(SZB + (size_t)m * EB + h * DV + 4 * ((int)(threadIdx.x & 63u)));
                v2u w; w.x = pk2(o.x * rs * go.x * bflo(zz.x), o.y * rs * go.y * bfhi(zz.x)); w.y = pk2(o.z * rs * go.z * bflo(zz.y), o.w * rs * go.w * bfhi(zz.y));
                *(GAS v2u*)(Y + (size_t)m * DM + EA + h * DV + 4 * ((int)(threadIdx.x & 63u))) = w; } }
    } if (!fuse_norm) SEAM(4);

    bf16* const slabA_lo = (bf16*)(ws + WS_SLABA); bf16* const slabA_hi = slabA_lo + (size_t)4 * MS * DM;
    bf16* const slabB_lo = (bf16*)(ws + WS_GA); bf16* const slabB_hi = slabB_lo + (size_t)4 * MS * DM;
    if (IN(5)) {
        { pg8::Gemm g{(const bf16*)(ws + WS_Y), (const bf16*)(ws + WS_WPAB), DM, DM}; pg8::TailOrder S{F.G, (int)blockIdx.x, (int)((blockIdx.x >> 6) & 1)};
          EpiG2 E{ws + WS_GA, ws + WS_GB, (bf16*)(ws + WS_M), slabA_lo, slabA_hi};
          pg8::gemm_phase<EpiG2, pg8::TailOrder>(F.lds, g, S, E); }
        { pg8::Gemm g{(const bf16*)(ws + WS_PBF), (const bf16*)(ws + WS_WPE), PLE, PLE}; pg8::EPromptOrder S{F.G, (int)blockIdx.x};
          EpiBf E{(bf16*)(ws + WS_E), DM};
          pg8::gemm_phase<EpiBf, pg8::EPromptOrder>(F.lds, g, S, E); }
    } SEAM(5);

    if (IN(6)) {
        const int gt = F.vcu * NTHR + ((int)threadIdx.x), NGT = F.G * NTHR; const unsigned char* GA = ws + WS_GA; const unsigned char* GB = ws + WS_GB; bf16* Mo = (bf16*)(ws + WS_M);
        for (int p = gt; p < MS * DM / 8; p += NGT) { const size_t off = (size_t)p * 8, og = (size_t)MP * DM + off;
            f32x4 a0, a1, b0, b1; slab_sum8(slabA_lo, slabA_hi, off, 0, 4, a0, a1); slab_sum8(slabA_lo, slabA_hi, off, 4, 8, b0, b1);
            float fa[8], fb[8]; u8x8_to_f32(*(const GAS v2u*)(GA + og), fa); u8x8_to_f32(*(const GAS v2u*)(GB + og), fb); const float k = 1.f / 255.f; v4u w;
            w.x = pk2((fa[0] * a0.x + fb[0] * b0.x) * k, (fa[1] * a0.y + fb[1] * b0.y) * k); w.y = pk2((fa[2] * a0.z + fb[2] * b0.z) * k, (fa[3] * a0.w + fb[3] * b0.w) * k);
            w.z = pk2((fa[4] * a1.x + fb[4] * b1.x) * k, (fa[5] * a1.y + fb[5] * b1.y) * k); w.w = pk2((fa[6] * a1.z + fb[6] * b1.z) * k, (fa[7] * a1.w + fb[7] * b1.w) * k);
            *(GAS v4u*)(Mo + og) = w; }
    } SEAM(6);

    if (IN(7)) {
        pg8::Gemm g{(const bf16*)(ws + WS_M), (const bf16*)(ws + WS_WO), DM, DM}; pg8::TailOrder S{F.G, (int)blockIdx.x, (int)((blockIdx.x >> 6) & 1)};
        EpiG3 E{(bf16*)(ws + WS_T), (float*)(ws + WS_TSS), slabB_lo, slabB_hi, hetero ? 1 : 0, (bf16*)(ws + WS_H), (float*)(ws + WS_TSS), (unsigned*)(ws + WS_CTL) + CW_PAN, F.xp, F.g_post, F.lds + pg8::STAGE_BYTES};
        pg8::gemm_phase<EpiG3, pg8::TailOrder>(F.lds, g, S, E);
    } SEAM(7);

    if (IN(8)) {
        const bf16* T = (const bf16*)(ws + WS_T); const float* TSS = (const float*)(ws + WS_TSS); bf16* H = (bf16*)(ws + WS_H);
        for (int r = F.wave * F.G + F.vcu; r < MS; r += NWAVES * F.G) { const int m = MP + r;
            f32x4 t4[8]; float ss = 0.f;
#pragma unroll
            for (int j2 = 0; j2 < 8; ++j2) { t4[j2] = slab_sum4(slabB_lo, slabB_hi, (size_t)r * DM + 4 * ((int)(threadIdx.x & 63u)) + 256 * j2); ss += (t4[j2].x * t4[j2].x + t4[j2].y * t4[j2].y) + (t4[j2].z * t4[j2].z + t4[j2].w * t4[j2].w); }
            const float rs = 1.0f / sqrtf(wave_sum(ss) * (1.f / DM) + EPS);
            const GAS f32x4* xr = (const GAS f32x4*)xrow(F, m) + ((int)(threadIdx.x & 63u)); const GAS f32x4* gr = (const GAS f32x4*)F.g_post + ((int)(threadIdx.x & 63u)); GAS v2u* ho = (GAS v2u*)(H + (size_t)m * DM) + ((int)(threadIdx.x & 63u));
#pragma unroll
            for (int j2 = 0; j2 < 8; ++j2) { const f32x4 xv = xr[64 * j2], gg = gr[64 * j2], tv = t4[j2]; v2u o, tb; tb.x = pk2(tv.x, tv.y); tb.y = pk2(tv.z, tv.w);
                o.x = pk2(xv.x + bflo(tb.x) * rs * gg.x, xv.y + bfhi(tb.x) * rs * gg.y); o.y = pk2(xv.z + bflo(tb.y) * rs * gg.z, xv.w + bfhi(tb.y) * rs * gg.w); ho[64 * j2] = o; }
        }
        const int gw = F.vcu * NWAVES + F.wave, NGW = F.G * NWAVES;
        for (int m = hetero ? MP : gw; m < MP; m += NGW) {
            float ss = ((int)(threadIdx.x & 63u)) < 32 ? TSS[(size_t)m * 32 + ((int)(threadIdx.x & 63u))] : 0.f; ss = wave_sum(ss); const float rs = 1.0f / sqrtf(ss * (1.f / DM) + EPS);
            const GAS f32x4* xr = (const GAS f32x4*)xrow(F, m) + ((int)(threadIdx.x & 63u)); const GAS f32x4* gr = (const GAS f32x4*)F.g_post + ((int)(threadIdx.x & 63u)); const GAS v2u* tr = (const GAS v2u*)(T + (size_t)m * DM) + ((int)(threadIdx.x & 63u)); GAS v2u* ho = (GAS v2u*)(H + (size_t)m * DM) + ((int)(threadIdx.x & 63u));
#pragma unroll
            for (int j2 = 0; j2 < 8; ++j2) { const f32x4 xv = xr[64 * j2], gg = gr[64 * j2]; const v2u tv = tr[64 * j2]; v2u o;
                o.x = pk2(xv.x + bflo(tv.x) * rs * gg.x, xv.y + bfhi(tv.x) * rs * gg.y); o.y = pk2(xv.z + bflo(tv.y) * rs * gg.z, xv.w + bfhi(tv.y) * rs * gg.w); ho[64 * j2] = o; }
        }
    } SEAM(8);

    if (IN(9)) {
        pg8::Gemm g{(const bf16*)(ws + WS_H), (const bf16*)(ws + WS_WPG), DM, DM}; pg8::TailOrder S{F.G, (int)blockIdx.x, (int)((blockIdx.x >> 6) & 1)};
        EpiG4 E{(const bf16*)(ws + WS_H), (const bf16*)(ws + WS_E), F.out + OUT_Y, slabB_lo, slabB_hi};
        pg8::gemm_phase<EpiG4, pg8::TailOrder>(F.lds, g, S, E);
    } SEAM(9);

    if (IN(10)) {
        const int gt = F.vcu * NTHR + ((int)threadIdx.x), NGT = F.G * NTHR; const bf16* Hb = (const bf16*)(ws + WS_H); const bf16* Es = (const bf16*)(ws + WS_ES); float* out = F.out + OUT_Y;
        for (int p = gt; p < MS * DM / 4; p += NGT) { const size_t off = (size_t)p * 4, og = (size_t)MP * DM + off;
            const f32x4 a = slab_sum4(slabB_lo, slabB_hi, off); const v2u hv = *(const GAS v2u*)(Hb + og), ev = *(const GAS v2u*)(Es + off);
            f32x4 o; o.x = bflo(hv.x) + sigm(a.x) * bflo(ev.x); o.y = bfhi(hv.x) + sigm(a.y) * bfhi(ev.x); o.z = bflo(hv.y) + sigm(a.z) * bflo(ev.y); o.w = bfhi(hv.y) + sigm(a.w) * bfhi(ev.y);
            *(GAS f32x4*)(out + og) = o; }
    }
#undef IN
#undef SEAM
}

__global__ void dbg_dump(const unsigned short* src, float* dst, size_t n) { for (size_t i = blockIdx.x * (size_t)blockDim.x + threadIdx.x; i < n; i += (size_t)gridDim.x * blockDim.x) dst[i] = __uint_as_float((unsigned)src[i] << 16); }
extern "C" void kernel_launch(void* const* d_in, const int* in_sizes, int n_in, void* d_out, int out_size, void* d_ws, size_t ws_size, hipStream_t stream) {
    static int grid = 0;
    if (grid == 0) {
        if (n_in != 19 || ws_size < WS_END) { fprintf(stderr, "kernel_launch: built for 19 inputs and >= %zu bytes of workspace; got n_in %d, ws %zu\n", (size_t)WS_END, n_in, ws_size); grid = -1; return; }
        int dev = 0, cus = 0, per_cu = 0;
        if (hipGetDevice(&dev) != hipSuccess || hipDeviceGetAttribute(&cus, hipDeviceAttributeMultiprocessorCount, dev) != hipSuccess) { grid = -1; return; }
        if (hipFuncSetAttribute((const void*)fwd_kernel, hipFuncAttributeMaxDynamicSharedMemorySize, LDS_BYTES) != hipSuccess) { fprintf(stderr, "kernel_launch: hipFuncSetAttribute failed\n"); grid = -1; return; }
        if (hipOccupancyMaxActiveBlocksPerMultiprocessor(&per_cu, (const void*)fwd_kernel, NTHR, LDS_BYTES) != hipSuccess || per_cu < 1) { fprintf(stderr, "kernel_launch: occupancy query says %d blocks per CU\n", per_cu); per_cu = 1; }
        (void)hipGetLastError();
        grid = cus;
    }
    if (grid < 0) return;
    (void)hipMemsetAsync((char*)d_ws + WS_CTL, 0, CTL_ZERO_BYTES, stream);
    Args a{};
    for (int i = 0; i < 19; ++i) a.in[i] = (const float*)d_in[i];
    a.out = (float*)d_out; a.ws = (unsigned char*)d_ws;
#if MK_N_LAUNCHES == 1
    a.ph_lo = 0; a.ph_hi = NPHASE; a.li = 0;
    hipLaunchKernelGGL(fwd_kernel, dim3(grid), dim3(NTHR), LDS_BYTES, stream, a);
#else
#ifndef DBG_LAST
#define DBG_LAST (NPHASE - 1)
#endif
    if (DBG_LAST < NPHASE - 1) (void)hipMemsetAsync(d_out, 0, (size_t)out_size * 4, stream);
    for (int li = 0; li <= DBG_LAST; ++li) { const int rep = 1; for (int r = 0; r < rep; ++r) { a.ph_lo = li; a.ph_hi = li + 1; a.li = 0; hipLaunchKernelGGL(fwd_kernel, dim3(grid), dim3(NTHR), LDS_BYTES, stream, a); } }
#ifdef DBG_DUMP
    hipLaunchKernelGGL(dbg_dump, dim3(2048), dim3(256), 0, stream, (const unsigned short*)((char*)d_ws + DBG_DUMP), (float*)d_out, (size_t)MT * DM);
#endif
#endif
}
```

```cpp
#include <hip/hip_runtime.h>
#include <cstdio>
#include <cstdint>

#ifndef MK_N_LAUNCHES
#define MK_N_LAUNCHES 1
#endif

namespace pg8 {
#define PG8_LAS __attribute__((address_space(3)))
typedef unsigned short bf16_t;
typedef short bf16x8 __attribute__((ext_vector_type(8)));
typedef float f32x4 __attribute__((ext_vector_type(4)));
typedef unsigned u32x4 __attribute__((ext_vector_type(4)));
typedef unsigned u32x2 __attribute__((ext_vector_type(2)));
constexpr int BM = 256, BK = 64, HALF = 128, HTB = HALF * BK * 2, STAGE_BYTES = 8 * HTB, NXCD = 8, WGM = 8;

__host__ __device__ __forceinline__ int lds_byte(int r, int c) { const int st = (r >> 4) * 2 + (c >> 5), rr = r & 15, cc = c & 31, ob = rr * 64 + cc * 2; return st * 1024 + (ob ^ (((ob >> 9) & 1) << 5)); }
__host__ __device__ __forceinline__ void stage_rc(int b, int& R, int& C) { const int st = b / 1024, sb = b % 1024, swz = sb ^ (((sb >> 9) & 1) << 5); R = (st >> 1) * 16 + swz / 64; C = (st & 1) * 32 + (swz % 64) / 2; }
__host__ __device__ __forceinline__ int perm32(int rho) { const int n = rho >> 4, i = rho & 15; return 8 * (i >> 2) + 4 * n + (i & 3); }

struct Unit { int pm, pn, kt0, nkt, kind; };
struct Gemm { const bf16_t* A; const bf16_t* Bt; int lda, ldb; };

struct StaticOrder {
    int nM, nN, nwg, G, c, nkt;
    __host__ __device__ void init(int M, int N, int K, int G_, int c_) { nM = M / BM; nN = N / BM; nwg = nM * nN; G = G_; c = c_; nkt = K / BK; }
    __host__ __device__ bool next(int i, Unit& u) const {
        const long L = (long)i * G + c; if (L >= nwg) return false;
        int wgid = (int)L; { const int q = nwg / NXCD, r = nwg % NXCD, xcd = wgid % NXCD, off = wgid / NXCD; wgid = (xcd < r ? xcd * (q + 1) : r * (q + 1) + (xcd - r) * q) + off; }
        const int nig = WGM * nN, gid = wgid / nig, fm = gid * WGM, gsz = (nM - fm) < WGM ? (nM - fm) : WGM;
        u.pm = fm + ((wgid % nig) % gsz); u.pn = (wgid % nig) / gsz; u.kt0 = 0; u.nkt = nkt; u.kind = 0; return true;
    }
};
struct TailOrder {
    int G, c, swap;
    __host__ __device__ bool next(int i, Unit& u) const {
        long L = (long)i * G + c; if (swap && G == 256 && i < 2) L = (long)(1 - i) * G + c;
        if (L < 256) { const int x = (int)L & 7, kk = (int)L >> 3; u.pm = 4 * x + (kk >> 3); u.pn = kk & 7; u.kt0 = 0; u.nkt = 32; u.kind = 0; return true; }
        if (L < 512) { const int l2 = (int)L - 256, x = l2 & 7, kk = l2 >> 3; u.pm = 32 + (kk >> 3); u.pn = kk & 7; u.kt0 = 4 * x; u.nkt = 4; u.kind = 1; return true; }
        return false;
    }
};
struct EPromptOrder {
    int G, c;
    __host__ __device__ bool next(int i, Unit& u) const {
        const long L = (long)i * G + c; if (L >= 256) return false;
        const int x = (int)L & 7, kk = (int)L >> 3; u.pm = 4 * x + (kk >> 3); u.pn = kk & 7; u.kt0 = 0; u.nkt = 4; u.kind = 0; return true; }
};
struct ESampleOrder {
    int G2, c2;
    __host__ __device__ bool next(int i, Unit& u) const {
        if (c2 < 0 || G2 <= 0) return false; const long L = (long)i * G2 + c2; if (L >= 32) return false;
        u.pm = 32 + ((int)L >> 3); u.pn = (int)L & 7; u.kt0 = 0; u.nkt = 4; u.kind = 0; return true; }
};

typedef __bf16 bf2_t __attribute__((ext_vector_type(2)));
typedef float f2_t __attribute__((ext_vector_type(2)));
__device__ __forceinline__ unsigned cvt_pk_bf16(float lo, float hi) { return __builtin_bit_cast(unsigned, __builtin_convertvector((f2_t){lo, hi}, bf2_t)); }

template <class Epi, class Sched>
__device__ __forceinline__ void gemm_phase(PG8_LAS unsigned char* lds, const Gemm g, const Sched& S, const Epi& E) {
    const int tid = threadIdx.x, wid = __builtin_amdgcn_readfirstlane(tid >> 6), lane = tid & 63, wr = wid >> 2, wc = wid & 3, fr = lane & 15, fq = lane >> 4;
    unsigned voffA[2], voffB[2];
#pragma unroll
    for (int i = 0; i < 2; ++i) { int R, C; stage_rc(tid * 16 + i * 8192, R, C); const int Rb = Epi::PERM ? ((R & ~31) + perm32(R & 31)) : R;
        voffA[i] = (unsigned)(R * g.lda + C) * 2u; voffB[i] = (unsigned)(Rb * g.ldb + C) * 2u; }
    const size_t kstep = (size_t)(BK * 2);
    const size_t hstepA = (size_t)HALF * g.lda * 2, hstepB = (size_t)HALF * g.ldb * 2;
    const size_t tstepA = 2 * hstepA, tstepB = 2 * hstepB;
    const unsigned ldsw = (unsigned)wid * 1024u;
    const int aoff = lds_byte(wr * 64 + fr, fq * 8), boff = lds_byte(wc * 32 + fr, fq * 8);
#define PG8_SA(b, h) (((b) * 2 + (h)) * HTB)
#define PG8_SB(b, h) ((4 + (b) * 2 + (h)) * HTB)
#define PG8_STAGE(bufoff, gbase, voff) do { _Pragma("unroll") for (int _i = 0; _i < 2; ++_i) \
        __builtin_amdgcn_global_load_lds((const unsigned*)((const char*)(gbase) + (voff)[_i]), (PG8_LAS unsigned*)(lds + (bufoff) + ldsw + _i * 8192), 16, 0, 0); } while (0)
#define PG8_LDA(dst, b, h) do { _Pragma("unroll") for (int m = 0; m < 4; ++m) _Pragma("unroll") for (int k = 0; k < 2; ++k) dst[m][k] = *(const PG8_LAS bf16x8*)(lds + PG8_SA(b, h) + aoff + m * 2048 + k * 1024); } while (0)
#define PG8_LDB(dst, b, h) do { _Pragma("unroll") for (int n = 0; n < 2; ++n) _Pragma("unroll") for (int k = 0; k < 2; ++k) dst[n][k] = *(const PG8_LAS bf16x8*)(lds + PG8_SB(b, h) + boff + n * 2048 + k * 1024); } while (0)
#define PG8_MMA(ai, bj, At, Bt) do { __builtin_amdgcn_s_setprio(1); _Pragma("unroll") for (int m = 0; m < 4; ++m) _Pragma("unroll") for (int n = 0; n < 2; ++n) _Pragma("unroll") for (int k = 0; k < 2; ++k) \
        acc[ai][bj][m][n] = __builtin_amdgcn_mfma_f32_16x16x32_bf16(Bt[n][k], At[m][k], acc[ai][bj][m][n], 0, 0, 0); __builtin_amdgcn_s_setprio(0); } while (0)
#define PG8_WAIT_V(n) asm volatile("s_waitcnt vmcnt(" #n ")" ::: "memory")
#define PG8_WAIT_L(n) asm volatile("s_waitcnt lgkmcnt(" #n ")" ::: "memory")
#define PG8_BAR __builtin_amdgcn_s_barrier()
#define PG8_SCHED __builtin_amdgcn_sched_barrier(0)
    Unit cur, nxt; int ui = 0;
    if (!S.next(0, cur)) return;
    f32x4 acc[2][2][4][2];
#pragma unroll
    for (int a = 0; a < 2; ++a)
#pragma unroll
        for (int b = 0; b < 2; ++b)
#pragma unroll
            for (int m = 0; m < 4; ++m)
#pragma unroll
                for (int n = 0; n < 2; ++n) acc[a][b][m][n] = (f32x4){0.f, 0.f, 0.f, 0.f};
    bf16x8 At[4][2], B0[2][2], B1[2][2];
    const char* cA = (const char*)g.A + (size_t)cur.pm * tstepA + (size_t)cur.kt0 * kstep; const char* cB = (const char*)g.Bt + (size_t)cur.pn * tstepB + (size_t)cur.kt0 * kstep;
    int nt = cur.nkt; asm volatile("" : "+s"(nt));
    PG8_STAGE(PG8_SB(0, 0), cB, voffB); PG8_STAGE(PG8_SB(0, 1), cB + hstepB, voffB); PG8_STAGE(PG8_SA(0, 0), cA, voffA); PG8_STAGE(PG8_SA(0, 1), cA + hstepA, voffA);
    if (wr == 1) PG8_BAR;
    PG8_WAIT_V(2); PG8_BAR;
    PG8_STAGE(PG8_SB(1, 0), cB + kstep, voffB); PG8_STAGE(PG8_SA(1, 0), cA + kstep, voffA); PG8_STAGE(PG8_SB(1, 1), cB + hstepB + kstep, voffB);
    PG8_WAIT_V(6); PG8_BAR;
    for (;;) {
        const bool has_next = S.next(ui + 1, nxt);
        const char* nA = has_next ? (const char*)g.A + (size_t)nxt.pm * tstepA + (size_t)nxt.kt0 * kstep : cA; const char* nB = has_next ? (const char*)g.Bt + (size_t)nxt.pn * tstepB + (size_t)nxt.kt0 * kstep : cB;
        for (int t = 0; t < nt; t += 2) {
            const bool last = (t == nt - 2);
            const char* a1 = cA + (size_t)(t + 1) * kstep;
            const char* a2 = last ? nA : cA + (size_t)(t + 2) * kstep; const char* b2 = last ? nB : cB + (size_t)(t + 2) * kstep;
            const char* a3 = a2 + kstep; const char* b3 = b2 + kstep;
            if constexpr (Epi::HAS_MID) { if (cur.kind == 0 && t == (nt >> 1)) E.mid(acc, cur, wr, wc, fr, fq); }
            PG8_LDB(B0, 0, 0); PG8_LDB(B1, 0, 1); PG8_SCHED; PG8_LDA(At, 0, 0); PG8_STAGE(PG8_SA(1, 1), a1 + hstepA, voffA);
            PG8_WAIT_V(8); PG8_WAIT_L(0); PG8_BAR; PG8_MMA(0, 0, At, B0); PG8_MMA(0, 1, At, B1); PG8_BAR; PG8_SCHED;
            PG8_LDA(At, 0, 1); PG8_STAGE(PG8_SB(0, 0), b2, voffB); PG8_STAGE(PG8_SB(0, 1), b2 + hstepB, voffB); PG8_STAGE(PG8_SA(0, 0), a2, voffA);
            PG8_WAIT_V(8); PG8_WAIT_L(0); PG8_BAR; PG8_MMA(1, 0, At, B0); PG8_MMA(1, 1, At, B1); PG8_BAR; PG8_SCHED;
            PG8_LDB(B0, 1, 0); PG8_LDB(B1, 1, 1); PG8_SCHED; PG8_LDA(At, 1, 0); PG8_STAGE(PG8_SA(0, 1), a2 + hstepA, voffA);
            PG8_WAIT_V(8); PG8_WAIT_L(0); PG8_BAR; PG8_MMA(0, 0, At, B0); PG8_MMA(0, 1, At, B1); PG8_BAR; PG8_SCHED;
            PG8_LDA(At, 1, 1); PG8_STAGE(PG8_SB(1, 0), b3, voffB); PG8_STAGE(PG8_SB(1, 1), b3 + hstepB, voffB); PG8_STAGE(PG8_SA(1, 0), a3, voffA);
            PG8_WAIT_V(8); PG8_WAIT_L(0); PG8_BAR; PG8_MMA(1, 0, At, B0); PG8_MMA(1, 1, At, B1); PG8_BAR; PG8_SCHED;
        }
        if (wr == 0) PG8_BAR;
        E(acc, cur, wr, wc, fr, fq);
        if (!has_next) break;
#pragma unroll
        for (int a = 0; a < 2; ++a)
#pragma unroll
            for (int b = 0; b < 2; ++b)
#pragma unroll
                for (int m = 0; m < 4; ++m)
#pragma unroll
                    for (int n = 0; n < 2; ++n) acc[a][b][m][n] = (f32x4){0.f, 0.f, 0.f, 0.f};
        cur = nxt; cA = nA; cB = nB; ++ui; nt = cur.nkt; asm volatile("" : "+s"(nt));
        if (wr == 1) PG8_BAR;
    }
    PG8_WAIT_V(0);
    PG8_BAR;
#undef PG8_SA
#undef PG8_SB
#undef PG8_STAGE
#undef PG8_LDA
#undef PG8_LDB
#undef PG8_MMA
#undef PG8_WAIT_V
#undef PG8_WAIT_L
#undef PG8_BAR
#undef PG8_SCHED
}
}

constexpr int NWAVES = 8, NTHR = 512;
constexpr int DM = 2048, MP = 8192, MS = 1024, MT = 9216, SEQ = 2048, NBAT = 4, DBAT = 128, DSEQ = 8;
constexpr int EA = 1024, KBW = 512, EB = 1024, NIN = 10256, N1 = 10752, PLE = 256;
constexpr int HB = 4, DK = 128, DV = 256, GR = 16, CH = 128, GC = 64  , NCH = SEQ / GC;
constexpr float EPS = 1e-6f;
constexpr int C_ALR = 6144, C_MA = 6160;

constexpr size_t OUT_Y = 0, OUT_SP = (size_t)MT * DM, OUT_SS = OUT_SP + (size_t)NBAT * HB * DK * DV, OUT_CV = OUT_SS + (size_t)DBAT * HB * DK * DV;

constexpr size_t MiB = 1u << 20;
constexpr size_t WS_CTL = 0, CTL_ZERO_BYTES = 64 * 1024;
constexpr size_t WS_WPE = 1 * MiB, WS_WPAB = 2 * MiB, WS_WO = 10 * MiB, WS_WPG = 18 * MiB, WS_PBF = 26 * MiB;
constexpr size_t WS_VSS = 30 * MiB + 512 * 1024;
constexpr size_t WS_TSS = WS_VSS + (size_t)MT * 16 * 4;
constexpr size_t WS_RSTD = WS_TSS + (size_t)MT * 32 * 4;
constexpr size_t WS_DEC = 33 * MiB;
constexpr size_t WS_W1T = 34 * MiB;
constexpr size_t WS_QT = 34 * MiB, WS_ATT = 42 * MiB, WS_KTT = 50 * MiB;
constexpr size_t WS_E = 34 * MiB;
constexpr size_t WS_XN = 76 * MiB, WS_Y = 76 * MiB;
constexpr size_t WS_U = 112 * MiB  , WS_V = 130 * MiB, WS_Q = 166 * MiB, WS_KB = 175 * MiB, WS_VB = 184 * MiB, WS_SZB = 202 * MiB, WS_GA = 220 * MiB, WS_GB = 256 * MiB;
constexpr size_t WS_LA = 292 * MiB;
constexpr size_t WS_O = 58 * MiB;
constexpr size_t WS_SLABA = 112 * MiB;
constexpr size_t WS_M = 148 * MiB;
constexpr size_t WS_T = 184 * MiB;
constexpr size_t WS_H = 112 * MiB;
constexpr size_t WS_ES = 312 * MiB;
constexpr size_t WS_END = 316 * MiB;
static_assert(WS_RSTD + (size_t)MT * 4 <= WS_DEC && WS_DEC + 16 * 32 * 128 * 4 <= WS_W1T && WS_W1T + (size_t)N1 * 2048 * 2 <= WS_XN, "ws map");
constexpr int CW_GRP = 8192;
constexpr int CW_PAN = 9216;
constexpr int CW_BAR = 4096;

constexpr int LDS_BYTES = 155648;
constexpr int MISC_OFF = LDS_BYTES - 256;

#define GAS __attribute__((address_space(1)))
#define LAS __attribute__((address_space(3)))
typedef unsigned short bf16;
typedef unsigned v4u __attribute__((ext_vector_type(4)));
typedef unsigned v2u __attribute__((ext_vector_type(2)));
typedef float f32x4 __attribute__((ext_vector_type(4)));
typedef short bf16x8 __attribute__((ext_vector_type(8)));
typedef GAS unsigned gu32;
#define RLX_AGENT __ATOMIC_RELAXED, __HIP_MEMORY_SCOPE_AGENT
__device__ __forceinline__ unsigned pk2(float lo, float hi) { return pg8::cvt_pk_bf16(lo, hi); }
__device__ __forceinline__ unsigned f2bf(float f) { return pg8::cvt_pk_bf16(f, 0.f) & 0xffffu; }
__device__ __forceinline__ float bflo(unsigned w) { return __uint_as_float(w << 16); }
__device__ __forceinline__ float bfhi(unsigned w) { return __uint_as_float(w & 0xffff0000u); }
__device__ __forceinline__ float bf2f(bf16 h) { return __uint_as_float((unsigned)h << 16); }
__device__ __forceinline__ float sigm(float x) { return __builtin_amdgcn_rcpf(1.f + __expf(-x)); }
__device__ __forceinline__ float wave_sum(float v) {
#pragma unroll
    for (int o = 1; o < 64; o <<= 1) v += __shfl_xor(v, o);
    return v;
}

#define XB_TMO      128
#define XB_XCNT(j)  (256  + 64 * (j))
#define XB_XSUB(j)  (1280 + 64 * (j))
#define XB_XGEN(j)  (2304 + 64 * (j))
#define XB_TOP      3328
#define XB_TOPGEN   3392
#define XCD_BAR_WORDS 3456
#define XB_SPIN_CAP (1u << 18)
__device__ __forceinline__ unsigned xb_ld(unsigned* p)              { return __hip_atomic_load(p, __ATOMIC_RELAXED, __HIP_MEMORY_SCOPE_AGENT); }
__device__ __forceinline__ unsigned xb_add(unsigned* p, unsigned v) { return __hip_atomic_fetch_add(p, v, __ATOMIC_RELAXED, __HIP_MEMORY_SCOPE_AGENT); }
__device__ __forceinline__ unsigned xb_xcc_id() { return (unsigned)__builtin_amdgcn_s_getreg((3 << 11) | 20) & 0xFu; }
#define XB_SPIN(cond, bar) do { unsigned _sp = 0; while (cond) { __builtin_amdgcn_s_sleep(1); \
    if ((++_sp & 255u) == 0u) { if (xb_ld(&(bar)[XB_TMO])) break; if (_sp > XB_SPIN_CAP) { atomicAdd(&(bar)[XB_TMO], 1u); break; } } } } while (0)
struct XcdBarrier { unsigned* bar; unsigned x; volatile LAS unsigned* st; };
__device__ __forceinline__ XcdBarrier xcd_barrier_post(unsigned* bar, volatile LAS unsigned* st) {
    XcdBarrier b; b.bar = bar; b.x = xb_xcc_id(); b.st = st;
    if (threadIdx.x == 0) (void)xb_add(&bar[XB_XCNT(b.x)], 1u);
    return b;
}
__device__ __forceinline__ void xcd_barrier_complete(unsigned* bar, unsigned x, unsigned& nloc, unsigned& nx) {
    const unsigned G = gridDim.x * gridDim.y * gridDim.z;
    unsigned sum, cnt, mine, sp = 0u;
    for (;;) {
        sum = 0u; cnt = 0u; mine = 0u;
#pragma unroll
        for (unsigned j = 0; j < 16; ++j) { const unsigned c = xb_ld(&bar[XB_XCNT(j)]); sum += c; cnt += (c > 0u) ? 1u : 0u; mine = (j == x) ? c : mine; }
        if (sum == G) break;
        __builtin_amdgcn_s_sleep(1);
        if ((++sp & 255u) == 0u) { if (xb_ld(&bar[XB_TMO])) break; if (sp > XB_SPIN_CAP) { atomicAdd(&bar[XB_TMO], 1u); break; } }
    }
    nloc = mine > 0u ? mine : 1u; nx = cnt > 0u ? cnt : 1u;
}
__device__ __forceinline__ void xcd_barrier(const XcdBarrier& b) {
    asm volatile("s_waitcnt vmcnt(0)" ::: "memory");
    __syncthreads();
    if (threadIdx.x == 0) {
        unsigned* bar = b.bar;
        __builtin_amdgcn_s_waitcnt(0);
        unsigned nloc = b.st[0], nx = b.st[1];
        if (nloc == 0u) { xcd_barrier_complete(bar, b.x, nloc, nx); b.st[0] = nloc; b.st[1] = nx; }
        const unsigned old = xb_add(&bar[XB_XSUB(b.x)], 1u);
        const unsigned gen = old / nloc;
        if (old + 1u == (gen + 1u) * nloc) {
            __builtin_amdgcn_fence(__ATOMIC_RELEASE, "agent");
            asm volatile("s_waitcnt vmcnt(0)" ::: "memory");
            const unsigned og = xb_add(&bar[XB_TOP], 1u);
            const unsigned tg = og / nx;
            if (og + 1u == (tg + 1u) * nx) xb_add(&bar[XB_TOPGEN], 1u);
            else XB_SPIN(xb_ld(&bar[XB_TOPGEN]) == tg, bar);
            __builtin_amdgcn_fence(__ATOMIC_ACQUIRE, "agent");
            xb_add(&bar[XB_XGEN(b.x)], 1u);
            asm volatile("s_waitcnt vmcnt(0)" ::: "memory");
        } else {
            XB_SPIN(xb_ld(&bar[XB_XGEN(b.x)]) == gen, bar);
            __builtin_amdgcn_fence(__ATOMIC_ACQUIRE, "agent");
            asm volatile("s_waitcnt vmcnt(0)" ::: "memory");
        }
    }
    __syncthreads();
}

struct Frame {
    LAS unsigned char* lds;
    unsigned char* ws;
    int wave, vcu, G;
    const float *xp, *xs, *pp, *ps, *st0, *g_pre, *w_in, *g_v, *w_s, *b_s, *w_a2, *b_a, *g_o, *w_pa, *w_pb, *w_o, *g_post, *w_pg, *w_pe;
    float* out;
};
__device__ __forceinline__ const float* xrow(const Frame& F, int m) { return m < MP ? F.xp + (size_t)m * DM : F.xs + (size_t)(m - MP) * DM; }

struct ConvItem { const float* src; bf16* dst; int spitch, dpitch; };
constexpr int I_IN = 32 * 320, I_PA = 16 * 64, I_PB = 16 * 64, I_O = 32 * 64, I_PG = 32 * 64, I_PE = 4 * 64, NITEMS = I_IN + I_PA + I_PB + I_O + I_PG + I_PE;
__device__ __forceinline__ void conv_item(const Frame& F, int it, ConvItem& d) {
    int r = it;
    if (r < I_IN) { const int kb = r / 320, n0 = (r % 320) * 32;
        const int src = n0 < 2048 ? ((n0 & 128) ? 2048 + 128 * (n0 >> 8) + (n0 & 127) : 128 * (n0 >> 8) + (n0 & 127)) : n0 < 3072 ? n0 - 1024 : n0 + (n0 >= C_ALR ? GR : 0);
        d.src = F.w_in + (size_t)(kb * 64) * NIN + src; d.spitch = NIN; d.dst = (bf16*)(F.ws + WS_W1T) + (size_t)n0 * 2048 + kb * 64; d.dpitch = 2048; return; } r -= I_IN;
    const int k0 = (r / 64) * 64, n0 = (r % 64) * 32; d.spitch = DM; d.dpitch = 2048;
    if (r < I_PA) { d.src = F.w_pa + (size_t)k0 * DM + n0; d.dst = (bf16*)(F.ws + WS_WPAB) + (size_t)n0 * 2048 + k0; return; } r -= I_PA;
    { const int k1 = (r / 64) * 64, n1 = (r % 64) * 32;
      if (r < I_PB) { d.src = F.w_pb + (size_t)k1 * DM + n1; d.dst = (bf16*)(F.ws + WS_WPAB) + (size_t)n1 * 2048 + 1024 + k1; return; } } r -= I_PB;
    { const int k1 = (r / 64) * 64, n1 = (r % 64) * 32;
      if (r < I_O) { d.src = F.w_o + (size_t)k1 * DM + n1; d.dst = (bf16*)(F.ws + WS_WO) + (size_t)n1 * 2048 + k1; return; } } r -= I_O;
    { const int k1 = (r / 64) * 64, n1 = (r % 64) * 32;
      if (r < I_PG) { d.src = F.w_pg + (size_t)k1 * DM + n1; d.dst = (bf16*)(F.ws + WS_WPG) + (size_t)n1 * 2048 + k1; return; } } r -= I_PG;
    { const int k1 = (r / 64) * 64, n1 = (r % 64) * 32; d.src = F.w_pe + (size_t)k1 * DM + n1; d.dst = (bf16*)(F.ws + WS_WPE) + (size_t)n1 * 256 + k1; d.dpitch = 256; }
}
__device__ __forceinline__ void conv_load(const ConvItem& d, f32x4 (&v)[8], int lane) {
    const int r = lane >> 3, c4 = (lane & 7) * 4;
#pragma unroll
    for (int i = 0; i < 8; ++i) v[i] = __builtin_nontemporal_load((const GAS f32x4*)(d.src + (size_t)(8 * i + r) * d.spitch + c4));
}
__device__ __forceinline__ void conv_finish(const ConvItem& d, const f32x4 (&v)[8], LAS float* scr, int lane) {
    const int r = lane >> 3, c4 = (lane & 7) * 4;
#pragma unroll
    for (int i = 0; i < 8; ++i) { LAS float* p = scr + (8 * i + r) * 33 + c4; p[0] = v[i].x; p[1] = v[i].y; p[2] = v[i].z; p[3] = v[i].w; }
    asm volatile("s_waitcnt lgkmcnt(0)" ::: "memory");
    const int c = lane & 7;
#pragma unroll
    for (int j = 0; j < 4; ++j) { const int n = (lane >> 3) + 8 * j; const LAS float* s = scr + (8 * c) * 33 + n;
        v4u o; o.x = pk2(s[0 * 33], s[1 * 33]); o.y = pk2(s[2 * 33], s[3 * 33]); o.z = pk2(s[4 * 33], s[5 * 33]); o.w = pk2(s[6 * 33], s[7 * 33]);
        *(GAS v4u*)(d.dst + (size_t)n * d.dpitch + 8 * c) = o; }
    asm volatile("s_waitcnt lgkmcnt(0)" ::: "memory");
}
__device__ __forceinline__ void p0_prologue(Frame& F) {
    LAS float* scr = (LAS float*)(F.lds + F.wave * 16384);
    const int gw = F.vcu * NWAVES + F.wave, NGW = F.G * NWAVES, ln = (int)(threadIdx.x & 63u);
    bf16* W1T = (bf16*)(F.ws + WS_W1T);
    { f32x4 va[8], vb[8]; ConvItem da, db; int it = gw; bool ha = it < NITEMS;
      if (ha) { conv_item(F, it, da); conv_load(da, va, ln); }
      while (ha) {
          const int it2 = it + NGW; const bool hb = it2 < NITEMS;
          if (hb) { conv_item(F, it2, db); conv_load(db, vb, ln); }
          conv_finish(da, va, scr, ln);
          if (!hb) break;
          it = it2 + NGW; ha = it < NITEMS;
          if (ha) { conv_item(F, it, da); conv_load(da, va, ln); }
          conv_finish(db, vb, scr, ln);
      } }
    {
        const int gt = F.vcu * NTHR + ((int)threadIdx.x), NGT = F.G * NTHR;
        for (int p = gt; p < 512 * 256; p += NGT) { const int ch = p & 511, k0 = (p >> 9) * 8; float wa[16];
#pragma unroll
            for (int r = 0; r < 16; ++r) wa[r] = F.w_a2[r * KBW + ch];
            float t[8];
#pragma unroll
            for (int i = 0; i < 8; ++i) { const GAS f32x4* wr4 = (const GAS f32x4*)(F.w_in + (size_t)(k0 + i) * NIN + C_ALR); float a = 0.f;
#pragma unroll
                for (int r4 = 0; r4 < 4; ++r4) { const f32x4 w = wr4[r4]; a += w.x * wa[4 * r4] + w.y * wa[4 * r4 + 1] + w.z * wa[4 * r4 + 2] + w.w * wa[4 * r4 + 3]; }
                t[i] = a; }
            v4u o; o.x = pk2(t[0], t[1]); o.y = pk2(t[2], t[3]); o.z = pk2(t[4], t[5]); o.w = pk2(t[6], t[7]);
            *(GAS v4u*)(W1T + (size_t)(10240 + ch) * 2048 + k0) = o; }
        bf16* PBF = (bf16*)(F.ws + WS_PBF);
        for (int p = gt; p < MT * PLE / 8; p += NGT) { const size_t e = (size_t)p * 8; const float* src = e < (size_t)MP * PLE ? F.pp + e : F.ps + (e - (size_t)MP * PLE);
            const f32x4 a = __builtin_nontemporal_load((const GAS f32x4*)src), b = __builtin_nontemporal_load((const GAS f32x4*)(src + 4)); v4u o; o.x = pk2(a.x, a.y); o.y = pk2(a.z, a.w); o.z = pk2(b.x, b.y); o.w = pk2(b.z, b.w);
            *(GAS v4u*)(PBF + e) = o; }
    }
    bf16* XN = (bf16*)(F.ws + WS_XN);
    { const GAS f32x4* gr = (const GAS f32x4*)F.g_pre + ln; f32x4 va[8], vb[8]; int m = gw; bool ha = m < MT;
#define XN_LOAD(v, mm) do { const GAS f32x4* xr_ = (const GAS f32x4*)xrow(F, (mm)) + ln; _Pragma("unroll") for (int j_ = 0; j_ < 8; ++j_) v[j_] = __builtin_nontemporal_load(xr_ + 64 * j_); } while (0)
#define XN_FINISH(v, mm) do { float s_ = 0.f; _Pragma("unroll") for (int j_ = 0; j_ < 8; ++j_) s_ += (v[j_].x * v[j_].x + v[j_].y * v[j_].y) + (v[j_].z * v[j_].z + v[j_].w * v[j_].w); \
        const float rstd_ = 1.0f / sqrtf(wave_sum(s_) * (1.f / DM) + EPS); GAS v2u* o8_ = (GAS v2u*)(XN + (size_t)(mm) * DM) + ln; \
        _Pragma("unroll") for (int j_ = 0; j_ < 8; ++j_) { const f32x4 gg_ = gr[64 * j_]; v2u o_; o_.x = pk2(v[j_].x * rstd_ * gg_.x, v[j_].y * rstd_ * gg_.y); o_.y = pk2(v[j_].z * rstd_ * gg_.z, v[j_].w * rstd_ * gg_.w); o8_[64 * j_] = o_; } } while (0)
      if (ha) XN_LOAD(va, m);
      while (ha) {
          const int m2 = m + NGW; const bool hb = m2 < MT;
          if (hb) XN_LOAD(vb, m2);
          XN_FINISH(va, m);
          if (!hb) break;
          m = m2 + NGW; ha = m < MT;
          if (ha) XN_LOAD(va, m);
          XN_FINISH(vb, m2);
      }
#undef XN_LOAD
#undef XN_FINISH
    }
}

using pg8::Unit;
template <int ACT>
__device__ __forceinline__ void g1_store(const pg8::f32x4 (&acc)[2][2][4][2], bf16* base, int ldc, int row0, int col0, float* vss, int wc, int fq) {
#pragma unroll
    for (int ai = 0; ai < 2; ++ai)
#pragma unroll
        for (int m = 0; m < 4; ++m) { const int row = row0 + ai * 128 + m * 16; bf16* rowp = base + (size_t)row * ldc + col0; float ss = 0.f;
#pragma unroll
            for (int bj = 0; bj < 2; ++bj) { float v[8];
#pragma unroll
                for (int e = 0; e < 8; ++e) { float x = acc[ai][bj][m][e >> 2][e & 3];
                    if (ACT == 1) x = x * sigm(x); else if (ACT == 2) x = sigm(x); else if (ACT == 3) x = x * 0.08838834764831845f;
                    if (ACT == 4) ss += x * x; v[e] = x; }
                v4u w; w.x = pg8::cvt_pk_bf16(v[0], v[1]); w.y = pg8::cvt_pk_bf16(v[2], v[3]); w.z = pg8::cvt_pk_bf16(v[4], v[5]); w.w = pg8::cvt_pk_bf16(v[6], v[7]);
                *(GAS v4u*)(rowp + bj * 128) = w; }
            if (ACT == 4) { ss += __shfl_xor(ss, 16); ss += __shfl_xor(ss, 32); if (fq == 0) vss[(size_t)row * 16 + wc] = ss; } }
}
__device__ __forceinline__ float log_sigmoid(float z) { return -(fmaxf(-z, 0.f) + __logf(1.f + __expf(-fabsf(z)))); }
__device__ __forceinline__ unsigned q8(float x) { const unsigned q = (unsigned)__builtin_fmaf(sigm(x), 255.f, 0.5f); return q < 1u ? 1u : q; }
__device__ __forceinline__ void g1_store_u8(const pg8::f32x4 (&acc)[2][2][4][2], unsigned char* base, int row0, int col0) {
#pragma unroll
    for (int ai = 0; ai < 2; ++ai)
#pragma unroll
        for (int m = 0; m < 4; ++m) { unsigned char* rowp = base + (size_t)(row0 + ai * 128 + m * 16) * DM + col0;
#pragma unroll
            for (int bj = 0; bj < 2; ++bj) { const pg8::f32x4 a = acc[ai][bj][m][0], b = acc[ai][bj][m][1]; v2u w;
                w.x = q8(a.x) | (q8(a.y) << 8) | (q8(a.z) << 16) | (q8(a.w) << 24); w.y = q8(b.x) | (q8(b.y) << 8) | (q8(b.z) << 16) | (q8(b.w) << 24);
                *(GAS v2u*)(rowp + bj * 128) = w; } }
}
__device__ __forceinline__ void u8x8_to_f32(v2u w, float (&f)[8]) {
    f[0] = (float)(w.x & 0xffu); f[1] = (float)((w.x >> 8) & 0xffu); f[2] = (float)((w.x >> 16) & 0xffu); f[3] = (float)(w.x >> 24);
    f[4] = (float)(w.y & 0xffu); f[5] = (float)((w.y >> 8) & 0xffu); f[6] = (float)((w.y >> 16) & 0xffu); f[7] = (float)(w.y >> 24);
}
struct EpiG1 {
    static constexpr bool PERM = true, HAS_MID = false;
    unsigned char* ws; const float* b_a;
    __device__ __forceinline__ void operator()(const pg8::f32x4 (&acc)[2][2][4][2], const Unit& u, int wr, int wc, int fr, int fq) const {
        const int pn = u.pn, row0 = u.pm * 256 + wr * 64 + fr, cin = wc * 32 + 8 * fq;
        if (pn < 8) {
            bf16* UZ = (bf16*)(ws + WS_U);
#pragma unroll
            for (int ai = 0; ai < 2; ++ai)
#pragma unroll
                for (int m = 0; m < 4; ++m) { const pg8::f32x4 u0 = acc[ai][0][m][0], u1 = acc[ai][0][m][1], z0 = acc[ai][1][m][0], z1 = acc[ai][1][m][1]; v4u w;
                    w.x = pg8::cvt_pk_bf16(u0.x * z0.x * sigm(z0.x), u0.y * z0.y * sigm(z0.y)); w.y = pg8::cvt_pk_bf16(u0.z * z0.z * sigm(z0.z), u0.w * z0.w * sigm(z0.w));
                    w.z = pg8::cvt_pk_bf16(u1.x * z1.x * sigm(z1.x), u1.y * z1.y * sigm(z1.y)); w.w = pg8::cvt_pk_bf16(u1.z * z1.z * sigm(z1.z), u1.w * z1.w * sigm(z1.w));
                    *(GAS v4u*)(UZ + (size_t)(row0 + ai * 128 + m * 16) * EA + pn * 128 + cin) = w; } }
        else if (pn < 12) g1_store<4>(acc, (bf16*)(ws + WS_V), 1024, row0, (pn - 8) * 256 + cin, (float*)(ws + WS_VSS) + (pn - 8) * 4, wc, fq);
        else if (pn < 14) g1_store<3>(acc, (bf16*)(ws + WS_Q), 512, row0, (pn - 12) * 256 + cin, nullptr, wc, fq);
        else if (pn < 16) g1_store<0>(acc, (bf16*)(ws + WS_KB), 512, row0, (pn - 14) * 256 + cin, nullptr, wc, fq);
        else if (pn < 20) g1_store<0>(acc, (bf16*)(ws + WS_VB), 1024, row0, (pn - 16) * 256 + cin, nullptr, wc, fq);
        else if (pn < 24) g1_store<1>(acc, (bf16*)(ws + WS_SZB), 1024, row0, (pn - 20) * 256 + cin, nullptr, wc, fq);
        else if (pn < 32) g1_store_u8(acc, ws + WS_GA, row0, (pn - 24) * 256 + cin);
        else if (pn < 40) g1_store_u8(acc, ws + WS_GB, row0, (pn - 32) * 256 + cin);
        else {
            float* la = (float*)(ws + WS_LA); const int c0 = (pn - 40) * 256 + cin;
            pg8::f32x4 bb[2][2];
#pragma unroll
            for (int bj = 0; bj < 2; ++bj) { bb[bj][0] = *(const GAS pg8::f32x4*)(b_a + c0 + bj * 128); bb[bj][1] = *(const GAS pg8::f32x4*)(b_a + c0 + bj * 128 + 4); }
#pragma unroll
            for (int ai = 0; ai < 2; ++ai)
#pragma unroll
                for (int m = 0; m < 4; ++m) { float* rp = la + (size_t)(row0 + ai * 128 + m * 16) * KBW + c0;
#pragma unroll
                    for (int bj = 0; bj < 2; ++bj)
#pragma unroll
                        for (int n = 0; n < 2; ++n) { const pg8::f32x4 z = acc[ai][bj][m][n] + bb[bj][n]; pg8::f32x4 o;
                            o.x = log_sigmoid(z.x) * 0.0625f; o.y = log_sigmoid(z.y) * 0.0625f; o.z = log_sigmoid(z.z) * 0.0625f; o.w = log_sigmoid(z.w) * 0.0625f;
                            *(GAS pg8::f32x4*)(rp + bj * 128 + n * 4) = o; } }
        }
    }
};
struct EpiBf {
    static constexpr bool PERM = true, HAS_MID = false;
    bf16* O; int ldc;
    __device__ __forceinline__ void operator()(const pg8::f32x4 (&acc)[2][2][4][2], const Unit& u, int wr, int wc, int fr, int fq) const {
        g1_store<0>(acc, O, ldc, u.pm * 256 + wr * 64 + fr, u.pn * 256 + wc * 32 + 8 * fq, nullptr, wc, fq);
    }
};
template <bool PERM>
__device__ __forceinline__ void slab_store(const pg8::f32x4 (&acc)[2][2][4][2], bf16* lo, bf16* hi, const Unit& u, int wr, int wc, int fr, int fq) {
    const int ks = u.kt0 >> 2; bf16* sl = ks < 4 ? lo + (size_t)ks * MS * DM : hi + (size_t)(ks - 4) * MS * DM;
    const int row0 = (u.pm - 32) * 256 + wr * 64 + fr, col0 = u.pn * 256 + wc * 32 + (PERM ? 8 : 4) * fq;
#pragma unroll
    for (int ai = 0; ai < 2; ++ai)
#pragma unroll
        for (int m = 0; m < 4; ++m) { bf16* rp = sl + (size_t)(row0 + ai * 128 + m * 16) * DM + col0;
#pragma unroll
            for (int bj = 0; bj < 2; ++bj) {
                if (PERM) { const pg8::f32x4 a = acc[ai][bj][m][0], b = acc[ai][bj][m][1]; *(GAS v4u*)(rp + bj * 128) = (v4u){pk2(a.x, a.y), pk2(a.z, a.w), pk2(b.x, b.y), pk2(b.z, b.w)}; }
                else {
#pragma unroll
                    for (int n = 0; n < 2; ++n) { const pg8::f32x4 a = acc[ai][bj][m][n]; *(GAS v2u*)(rp + bj * 128 + n * 16) = (v2u){pk2(a.x, a.y), pk2(a.z, a.w)}; } } } }
}
__device__ __forceinline__ const bf16* slab_ptr(const bf16* lo, const bf16* hi, int ks) { return ks < 4 ? lo + (size_t)ks * MS * DM : hi + (size_t)(ks - 4) * MS * DM; }
__device__ __forceinline__ void slab_sum8(const bf16* lo, const bf16* hi, size_t off, int k0, int k1, pg8::f32x4& s0, pg8::f32x4& s1) {
    s0 = (pg8::f32x4){0.f, 0.f, 0.f, 0.f}; s1 = s0;
#pragma unroll
    for (int ks = 0; ks < 8; ++ks) if (ks >= k0 && ks < k1) { const v4u w = *(const GAS v4u*)(slab_ptr(lo, hi, ks) + off);
        s0.x += bflo(w.x); s0.y += bfhi(w.x); s0.z += bflo(w.y); s0.w += bfhi(w.y); s1.x += bflo(w.z); s1.y += bfhi(w.z); s1.z += bflo(w.w); s1.w += bfhi(w.w); }
}
__device__ __forceinline__ pg8::f32x4 slab_sum4(const bf16* lo, const bf16* hi, size_t off) {
    pg8::f32x4 a = (pg8::f32x4){0.f, 0.f, 0.f, 0.f};
#pragma unroll
    for (int ks = 0; ks < 8; ++ks) { const v2u w = *(const GAS v2u*)(slab_ptr(lo, hi, ks) + off); a.x += bflo(w.x); a.y += bfhi(w.x); a.z += bflo(w.y); a.w += bfhi(w.y); }
    return a;
}
struct EpiG2 {
    static constexpr bool PERM = true, HAS_MID = true;
    const unsigned char* GA; const unsigned char* GB; bf16* Mo; bf16* slo; bf16* shi;
    __device__ __forceinline__ void mid(pg8::f32x4 (&acc)[2][2][4][2], const Unit& u, int wr, int wc, int fr, int fq) const {
        asm volatile("" : "+v"(fr));
        const unsigned off0 = (unsigned)((u.pm * 256 + wr * 64 + fr) * DM + u.pn * 256 + wc * 32 + 8 * fq);
#pragma unroll
        for (int ai = 0; ai < 2; ++ai)
#pragma unroll
            for (int m = 0; m < 4; ++m) { const unsigned off = off0 + (unsigned)((ai * 128 + m * 16) * DM);
#pragma unroll
                for (int bj = 0; bj < 2; ++bj) { const v2u a = *(const GAS v2u*)(GA + off + bj * 128), b = *(const GAS v2u*)(GB + off + bj * 128); float fa[8], fb[8]; u8x8_to_f32(a, fa); u8x8_to_f32(b, fb);
#pragma unroll
                    for (int e = 0; e < 8; ++e) acc[ai][bj][m][e >> 2][e & 3] *= fa[e] * __builtin_amdgcn_rcpf(fb[e]); }
                if (m == 3) asm volatile("" ::: "memory"); }
    }
    __device__ __forceinline__ void operator()(const pg8::f32x4 (&acc)[2][2][4][2], const Unit& u, int wr, int wc, int fr, int fq) const {
        if (u.kind) { slab_store<true>(acc, slo, shi, u, wr, wc, fr, fq); return; }
        const int row0 = u.pm * 256 + wr * 64 + fr, col0 = u.pn * 256 + wc * 32 + 8 * fq;
#pragma unroll
        for (int ai = 0; ai < 2; ++ai)
#pragma unroll
            for (int m = 0; m < 4; ++m) { const size_t off = (size_t)(row0 + ai * 128 + m * 16) * DM + col0;
#pragma unroll
                for (int bj = 0; bj < 2; ++bj) { const v2u b = *(const GAS v2u*)(GB + off + bj * 128); float fb[8]; u8x8_to_f32(b, fb); unsigned w[4];
#pragma unroll
                    for (int p = 0; p < 4; ++p) w[p] = pg8::cvt_pk_bf16(acc[ai][bj][m][p >> 1][(p & 1) * 2] * (fb[2 * p] * (1.f / 255.f)), acc[ai][bj][m][p >> 1][(p & 1) * 2 + 1] * (fb[2 * p + 1] * (1.f / 255.f)));
                    *(GAS v4u*)(Mo + off + bj * 128) = (v4u){w[0], w[1], w[2], w[3]}; }
                if (m & 1) asm volatile("" ::: "memory"); }
    }
};
struct EpiG3 {
    static constexpr bool PERM = true, HAS_MID = false;
    bf16* T; float* tss; bf16* slo; bf16* shi;
    int fused; bf16* H; float* xs; unsigned* cnt; const float* xp; const float* gpost; LAS unsigned char* lx;
    __device__ __forceinline__ void operator()(const pg8::f32x4 (&acc)[2][2][4][2], const Unit& u, int wr, int wc, int fr, int fq) const {
        if (u.kind) { slab_store<true>(acc, slo, shi, u, wr, wc, fr, fq); return; }
        const int row0 = u.pm * 256 + wr * 64 + fr, col0 = u.pn * 256 + wc * 32 + 8 * fq;
        if (!fused) {
#pragma unroll
            for (int ai = 0; ai < 2; ++ai)
#pragma unroll
                for (int m = 0; m < 4; ++m) { const int row = row0 + ai * 128 + m * 16; bf16* rowp = T + (size_t)row * DM + col0; float ss = 0.f;
#pragma unroll
                    for (int bj = 0; bj < 2; ++bj) { const pg8::f32x4 a = acc[ai][bj][m][0], b = acc[ai][bj][m][1];
                        ss += (a.x * a.x + a.y * a.y) + (a.z * a.z + a.w * a.w) + (b.x * b.x + b.y * b.y) + (b.z * b.z + b.w * b.w);
                        v4u w; w.x = pg8::cvt_pk_bf16(a.x, a.y); w.y = pg8::cvt_pk_bf16(a.z, a.w); w.z = pg8::cvt_pk_bf16(b.x, b.y); w.w = pg8::cvt_pk_bf16(b.z, b.w);
                        *(GAS v4u*)(rowp + bj * 128) = w; }
                    ss += __shfl_xor(ss, 16); ss += __shfl_xor(ss, 32); if (fq == 0) tss[(size_t)row * 32 + u.pn * 4 + wc] = ss; }
            return;
        }
        LAS float* P = (LAS float*)lx; LAS float* S = P + 1024; volatile LAS unsigned* flag = (volatile LAS unsigned*)(S + 256);
        const int tid = threadIdx.x, lane = tid & 63, wid = __builtin_amdgcn_readfirstlane(tid >> 6);
#pragma unroll
        for (int ai = 0; ai < 2; ++ai)
#pragma unroll
            for (int m = 0; m < 4; ++m) { float ss = 0.f;
#pragma unroll
                for (int bj = 0; bj < 2; ++bj) { const pg8::f32x4 a = acc[ai][bj][m][0], b = acc[ai][bj][m][1]; ss += (a.x * a.x + a.y * a.y) + (a.z * a.z + a.w * a.w) + (b.x * b.x + b.y * b.y) + (b.z * b.z + b.w * b.w); }
                ss += __shfl_xor(ss, 16); ss += __shfl_xor(ss, 32); if (fq == 0) P[(ai * 128 + wr * 64 + m * 16 + fr) * 4 + wc] = ss; }
        asm volatile("s_waitcnt lgkmcnt(0)" ::: "memory"); __builtin_amdgcn_s_barrier(); asm volatile("" ::: "memory");
        if (tid < 256) { const pg8::f32x4 p = *(const LAS pg8::f32x4*)(P + tid * 4);
            __hip_atomic_store(xs + (size_t)(u.pm * 256 + tid) * 8 + u.pn, (p.x + p.y) + (p.z + p.w), __ATOMIC_RELAXED, __HIP_MEMORY_SCOPE_AGENT); }
        asm volatile("s_waitcnt vmcnt(0)" ::: "memory");
        if (tid < 256 && lane == 0) (void)__hip_atomic_fetch_add(cnt + 64 * u.pm, 1u, __ATOMIC_RELAXED, __HIP_MEMORY_SCOPE_AGENT);
        if (wid == 0) { unsigned sp = 0;
            while ((unsigned)__builtin_amdgcn_readfirstlane(__hip_atomic_load(cnt + 64 * u.pm, __ATOMIC_RELAXED, __HIP_MEMORY_SCOPE_AGENT)) < 32u) { __builtin_amdgcn_s_sleep(2); if (++sp > (1u << 20)) break; }
            __builtin_amdgcn_fence(__ATOMIC_ACQUIRE, "agent"); asm volatile("s_waitcnt vmcnt(0)" ::: "memory"); if (lane == 0) flag[0] = 1u; }
        asm volatile("s_waitcnt lgkmcnt(0)" ::: "memory"); __builtin_amdgcn_s_barrier(); asm volatile("" ::: "memory");
        if (tid < 256) { const float* sl = xs + (size_t)(u.pm * 256 + tid) * 8; float t = 0.f;
#pragma unroll
            for (int q = 0; q < 8; ++q) t += __hip_atomic_load(sl + q, __ATOMIC_RELAXED, __HIP_MEMORY_SCOPE_AGENT);
            S[tid] = 1.0f / sqrtf(t * (1.f / DM) + EPS); }
        asm volatile("s_waitcnt lgkmcnt(0)" ::: "memory"); __builtin_amdgcn_s_barrier(); asm volatile("" ::: "memory");
        pg8::f32x4 gp[2][2];
#pragma unroll
        for (int bj = 0; bj < 2; ++bj) { gp[bj][0] = *(const GAS pg8::f32x4*)(gpost + col0 + bj * 128); gp[bj][1] = *(const GAS pg8::f32x4*)(gpost + col0 + bj * 128 + 4); }
#pragma unroll
        for (int ai = 0; ai < 2; ++ai)
#pragma unroll
            for (int m = 0; m < 4; ++m) { const int rl = ai * 128 + wr * 64 + m * 16 + fr; const float rs = S[rl]; const size_t off = (size_t)(u.pm * 256 + rl) * DM + col0;
#pragma unroll
                for (int bj = 0; bj < 2; ++bj) { const pg8::f32x4 x0 = *(const GAS pg8::f32x4*)(xp + off + bj * 128), x1 = *(const GAS pg8::f32x4*)(xp + off + bj * 128 + 4); const pg8::f32x4 a = acc[ai][bj][m][0], b = acc[ai][bj][m][1], g0 = gp[bj][0], g1 = gp[bj][1];
                    v4u w; w.x = pg8::cvt_pk_bf16(x0.x + a.x * rs * g0.x, x0.y + a.y * rs * g0.y); w.y = pg8::cvt_pk_bf16(x0.z + a.z * rs * g0.z, x0.w + a.w * rs * g0.w);
                    w.z = pg8::cvt_pk_bf16(x1.x + b.x * rs * g1.x, x1.y + b.y * rs * g1.y); w.w = pg8::cvt_pk_bf16(x1.z + b.z * rs * g1.z, x1.w + b.w * rs * g1.w);
                    *(GAS v4u*)(H + off + bj * 128) = w; }
                if (m & 1) asm volatile("" ::: "memory"); }
    }
};
struct EpiG4 {
    static constexpr bool PERM = false, HAS_MID = false;
    const bf16 *H, *E; float* out; bf16* slo; bf16* shi;
    __device__ __forceinline__ void operator()(const pg8::f32x4 (&acc)[2][2][4][2], const Unit& u, int wr, int wc, int fr, int fq) const {
        if (u.kind) { slab_store<false>(acc, slo, shi, u, wr, wc, fr, fq); return; }
        const int row0 = u.pm * 256 + wr * 64 + fr, col0 = u.pn * 256 + wc * 32 + 4 * fq;
#pragma unroll
        for (int ai = 0; ai < 2; ++ai)
#pragma unroll
            for (int m = 0; m < 4; ++m) { const size_t off = (size_t)(row0 + ai * 128 + m * 16) * DM + col0;
#pragma unroll
                for (int bj = 0; bj < 2; ++bj)
#pragma unroll
                    for (int n = 0; n < 2; ++n) { const size_t o2 = off + bj * 128 + n * 16;
                        const v2u hv = __builtin_nontemporal_load((const GAS v2u*)(H + o2)), ev = __builtin_nontemporal_load((const GAS v2u*)(E + o2)); const pg8::f32x4 a = acc[ai][bj][m][n];
                        pg8::f32x4 o; o.x = bflo(hv.x) + sigm(a.x) * bflo(ev.x); o.y = bfhi(hv.x) + sigm(a.y) * bfhi(ev.x); o.z = bflo(hv.y) + sigm(a.z) * bflo(ev.y); o.w = bfhi(hv.y) + sigm(a.w) * bfhi(ev.y);
                        *(GAS pg8::f32x4*)(out + o2) = o; }
                asm volatile("" ::: "memory"); }
    }
};

constexpr int GWP = 136, GVP = 68;
__device__ __forceinline__ void gate_prompt_unit(Frame& F, int unit) {
    int tid = ((int)threadIdx.x); asm volatile("" : "+v"(tid));
    const int g = unit & 3, c = (unit >> 2) & 15, b = unit >> 6, r0 = b * SEQ + c * CH, lane = tid & 63, wave = F.wave, fr = lane & 15, fq = lane >> 4;
    LAS bf16* WL = (LAS bf16*)F.lds;
    LAS unsigned* VT = (LAS unsigned*)(F.lds + 128 * GWP * 2);
    LAS float* RS = (LAS float*)(F.lds + 128 * GWP * 2 + 256 * GVP * 4);
    const bf16* U = (const bf16*)(F.ws + WS_U); const bf16* V = (const bf16*)(F.ws + WS_V); const float* VSS = (const float*)(F.ws + WS_VSS);
    bf16* Y = (bf16*)(F.ws + WS_Y);
    __syncthreads();
    if (tid < 128) { const GAS f32x4* p = (const GAS f32x4*)(VSS + (size_t)(r0 + tid) * 16); const f32x4 a = p[0], b4 = p[1], c4 = p[2], d4 = p[3];
        const float ss = ((a.x + a.y) + (a.z + a.w)) + ((b4.x + b4.y) + (b4.z + b4.w)) + ((c4.x + c4.y) + (c4.z + c4.w)) + ((d4.x + d4.y) + (d4.z + d4.w));
        RS[tid] = 1.0f / sqrtf(ss * (1.f / EA) + EPS); }
    { const float* W = F.w_s + (size_t)g * CH * CH;
#pragma unroll
      for (int i = 0; i < 4; ++i) { const int p = tid + NTHR * i, t = p >> 4, s8 = (p & 15) * 8; const f32x4 w0 = *(const GAS f32x4*)(W + t * CH + s8), w1 = *(const GAS f32x4*)(W + t * CH + s8 + 4); v4u o;
          o.x = pk2(s8 <= t ? w0.x : 0.f, s8 + 1 <= t ? w0.y : 0.f); o.y = pk2(s8 + 2 <= t ? w0.z : 0.f, s8 + 3 <= t ? w0.w : 0.f);
          o.z = pk2(s8 + 4 <= t ? w1.x : 0.f, s8 + 5 <= t ? w1.y : 0.f); o.w = pk2(s8 + 6 <= t ? w1.z : 0.f, s8 + 7 <= t ? w1.w : 0.f);
          *(LAS v4u*)(WL + t * GWP + s8) = o; } }
    __syncthreads();
#pragma unroll
    for (int i = 0; i < 4; ++i) { const int idx = tid + NTHR * i, cg = ((idx >> 5) & 3) * 8 + (idx & 7), sp = (idx >> 7) * 4 + ((idx >> 3) & 3), s0 = 2 * sp;
        const v4u ra = *(const GAS v4u*)(V + (size_t)(r0 + s0) * EA + g * DV + 8 * cg), rb = *(const GAS v4u*)(V + (size_t)(r0 + s0 + 1) * EA + g * DV + 8 * cg);
        const GAS f32x4* gv = (const GAS f32x4*)(F.g_v + g * DV + 8 * cg); const f32x4 g0 = gv[0], g1 = gv[1]; const float ra_s = RS[s0], rb_s = RS[s0 + 1];
        const float gg[8] = {g0.x, g0.y, g0.z, g0.w, g1.x, g1.y, g1.z, g1.w}; const unsigned wa[4] = {ra.x, ra.y, ra.z, ra.w}, wb[4] = {rb.x, rb.y, rb.z, rb.w};
        LAS unsigned* dst = VT + (8 * cg) * GVP + (sp ^ (4 * (cg & 7)));
#pragma unroll
        for (int e = 0; e < 4; ++e) { dst[(2 * e) * GVP] = pk2(bflo(wa[e]) * ra_s * gg[2 * e], bflo(wb[e]) * rb_s * gg[2 * e]); dst[(2 * e + 1) * GVP] = pk2(bfhi(wa[e]) * ra_s * gg[2 * e + 1], bfhi(wb[e]) * rb_s * gg[2 * e + 1]); } }
    __syncthreads();
    pg8::f32x4 acc[16];
#pragma unroll
    for (int q = 0; q < 16; ++q) acc[q] = (pg8::f32x4){0.f, 0.f, 0.f, 0.f};
    const int nkk = (wave >> 1) + 1;
    for (int kk = 0; kk < nkk; ++kk) { const bf16x8 bw = *(const LAS bf16x8*)(WL + (16 * wave + fr) * GWP + 32 * kk + 8 * fq);
#pragma unroll
        for (int q = 0; q < 16; ++q) { const int d = 64 * (q >> 2) + 16 * (fr >> 2) + 4 * (q & 3) + (fr & 3);
            const bf16x8 af = *(const LAS bf16x8*)(VT + d * GVP + ((16 * kk + 4 * fq) ^ (4 * ((d >> 3) & 7))));
            acc[q] = __builtin_amdgcn_mfma_f32_16x16x32_bf16(af, bw, acc[q], 0, 0, 0); } }
    { const int t = 16 * wave + fr; const float bs = F.b_s[g * CH + t];
#pragma unroll
      for (int G4 = 0; G4 < 4; ++G4) { const size_t o1 = (size_t)(r0 + t) * EA + g * DV + 64 * G4 + 16 * fq; const v4u u0 = *(const GAS v4u*)(U + o1), u1 = *(const GAS v4u*)(U + o1 + 8);
          const unsigned uw[8] = {u0.x, u0.y, u0.z, u0.w, u1.x, u1.y, u1.z, u1.w}; unsigned yw[8];
#pragma unroll
          for (int n = 0; n < 4; ++n) { const pg8::f32x4 sv = acc[G4 * 4 + n];
              yw[2 * n] = pk2(bflo(uw[2 * n]) * (sv.x + bs), bfhi(uw[2 * n]) * (sv.y + bs));
              yw[2 * n + 1] = pk2(bflo(uw[2 * n + 1]) * (sv.z + bs), bfhi(uw[2 * n + 1]) * (sv.w + bs)); }
          bf16* yp = Y + (size_t)(r0 + t) * DM + g * DV + 64 * G4 + 16 * fq;
          *(GAS v4u*)yp = (v4u){yw[0], yw[1], yw[2], yw[3]}; *(GAS v4u*)(yp + 8) = (v4u){yw[4], yw[5], yw[6], yw[7]}; } }
}

__device__ __forceinline__ void sample_unit(Frame& F, int unit) {
    int tid = ((int)threadIdx.x); asm volatile("" : "+v"(tid));
    const int h = unit & 3, sb = unit >> 2, r0 = MP + sb * DSEQ, lane = tid & 63, wave = F.wave;
    LAS float* L = (LAS float*)F.lds;
    LAS float* QT = L; LAS float* KT = L + 1024; LAS float* KD = L + 2048; LAS float* DC = L + 3072; LAS float* ATT = L + 3200; LAS float* RS = L + 3264; LAS float* QS = L + 3400; LAS float* RED = L + 4608;
    const bf16* Vb = (const bf16*)(F.ws + WS_V); const bf16* U = (const bf16*)(F.ws + WS_U); const float* VSS = (const float*)(F.ws + WS_VSS);
    const bf16* Q = (const bf16*)(F.ws + WS_Q); const bf16* KBp = (const bf16*)(F.ws + WS_KB); const bf16* VB = (const bf16*)(F.ws + WS_VB); const bf16* SZB = (const bf16*)(F.ws + WS_SZB);
    const float* LAg = (const float*)(F.ws + WS_LA); bf16* Y = (bf16*)(F.ws + WS_Y);
    const int d = tid & 255, th = tid >> 8, col = h * DV + d, v4 = lane, dg = wave, chp = h * DK + (tid & 127);
    f32x4 ssv[4]; float bsv = 0.f; if (tid < 8) { const GAS f32x4* p = (const GAS f32x4*)(VSS + (size_t)(r0 + tid) * 16); ssv[0] = p[0]; ssv[1] = p[1]; ssv[2] = p[2]; ssv[3] = p[3]; bsv = F.b_s[h * CH + tid]; }
    float wsv = 0.f; if (tid < 64) wsv = F.w_s[(size_t)h * CH * CH + (tid >> 3) * CH + (tid & 7)];
    bf16 vraw[8], uraw[4];
#pragma unroll
    for (int s2 = 0; s2 < 8; ++s2) vraw[s2] = Vb[(size_t)(r0 + s2) * EA + col];
#pragma unroll
    for (int i = 0; i < 4; ++i) uraw[i] = U[(size_t)(r0 + th * 4 + i) * EA + col];
    const float gv = F.g_v[col];
    float laraw[8]; bf16 qraw[8], kraw[8];
    if (tid < 128) {
#pragma unroll
        for (int t = 0; t < 8; ++t) { laraw[t] = LAg[(size_t)(r0 + t) * KBW + chp]; qraw[t] = Q[(size_t)(r0 + t) * KBW + chp]; kraw[t] = KBp[(size_t)(r0 + t) * KBW + chp]; } }
    v2u vvraw[8];
#pragma unroll
    for (int s2 = 0; s2 < 8; ++s2) vvraw[s2] = *(const GAS v2u*)(VB + (size_t)(r0 + s2) * EB + h * DV + 4 * v4);
    const v2u zz = *(const GAS v2u*)(SZB + (size_t)(r0 + wave) * EB + h * DV + 4 * v4); const f32x4 go = *(const GAS f32x4*)(F.g_o + h * DV + 4 * v4);
    const float* S0 = F.st0 + ((size_t)(sb * HB + h) * DK) * DV; float* SN = F.out + OUT_SS + ((size_t)(sb * HB + h) * DK) * DV;
    f32x4 s0r[16];
#pragma unroll
    for (int dd = 0; dd < 16; ++dd) s0r[dd] = __builtin_nontemporal_load((const GAS f32x4*)(S0 + (size_t)(dg * 16 + dd) * DV + 4 * v4));
    __syncthreads();
    if (tid < 8) { const f32x4 a = ssv[0], b4 = ssv[1], c4 = ssv[2], d4 = ssv[3];
        const float ss = ((a.x + a.y) + (a.z + a.w)) + ((b4.x + b4.y) + (b4.z + b4.w)) + ((c4.x + c4.y) + (c4.z + c4.w)) + ((d4.x + d4.y) + (d4.z + d4.w));
        RS[tid] = 1.0f / sqrtf(ss * (1.f / EA) + EPS); RS[8 + tid] = bsv; }
    if (tid < 64) RS[16 + tid] = wsv;
    __syncthreads();
    {
        float vn[8];
#pragma unroll
        for (int s2 = 0; s2 < 8; ++s2) vn[s2] = bf2f(vraw[s2]) * RS[s2] * gv;
#pragma unroll
        for (int i = 0; i < 4; ++i) { const int t = th * 4 + i; float S = RS[8 + t];
#pragma unroll
            for (int s2 = 0; s2 < 8; ++s2) if (s2 <= t) S += RS[16 + t * 8 + s2] * vn[s2];
            Y[(size_t)(r0 + t) * DM + col] = (bf16)f2bf(bf2f(uraw[i]) * S);
            float vt = 0.f;
#pragma unroll
            for (int s2 = 0; s2 < 8; ++s2) vt = (s2 == t) ? vn[s2] : vt;
            F.out[OUT_CV + (size_t)(sb * DSEQ + t) * EA + col] = vt; }
    }
    if (tid < 128) { const int dq = tid; float bc[8]; float run = 0.f;
#pragma unroll
        for (int t = 0; t < 8; ++t) { run += laraw[t]; bc[t] = run; }
        const float dcv = __expf(run); DC[dq] = dcv;
#pragma unroll
        for (int t = 0; t < 8; ++t) { const float q = bf2f(qraw[t]), k = bf2f(kraw[t]);
            const float eb = __expf(bc[t]), ek = __builtin_amdgcn_rcpf(eb); const float qt = q * eb, kt = k * ek; QT[dq * 8 + t] = qt; QS[t * 128 + dq] = qt; KT[t * 128 + dq] = kt; KD[dq * 8 + t] = kt * dcv; }
    }
    __syncthreads();
    { const int p = tid >> 3, part = tid & 7, t = p >> 3, s2 = p & 7; float a = 0.f;
      if (s2 <= t) {
#pragma unroll
          for (int dd = 0; dd < 16; ++dd) a += QS[t * 128 + part * 16 + dd] * KT[s2 * 128 + part * 16 + dd]; }
      a += __shfl_xor(a, 1); a += __shfl_xor(a, 2); a += __shfl_xor(a, 4);
      if (part == 0) ATT[p] = a; }
    f32x4 vv[8];
#pragma unroll
    for (int s2 = 0; s2 < 8; ++s2) vv[s2] = (f32x4){bflo(vvraw[s2].x), bfhi(vvraw[s2].x), bflo(vvraw[s2].y), bfhi(vvraw[s2].y)};
    f32x4 oacc[8];
#pragma unroll
    for (int t = 0; t < 8; ++t) oacc[t] = (f32x4){0.f, 0.f, 0.f, 0.f};
#pragma unroll
    for (int dd = 0; dd < 16; ++dd) { const int dr = dg * 16 + dd; const f32x4 s0 = s0r[dd];
        const f32x4 q0 = *(const LAS f32x4*)(QT + dr * 8), q1 = *(const LAS f32x4*)(QT + dr * 8 + 4), k0 = *(const LAS f32x4*)(KD + dr * 8), k1 = *(const LAS f32x4*)(KD + dr * 8 + 4);
        oacc[0] += q0.x * s0; oacc[1] += q0.y * s0; oacc[2] += q0.z * s0; oacc[3] += q0.w * s0; oacc[4] += q1.x * s0; oacc[5] += q1.y * s0; oacc[6] += q1.z * s0; oacc[7] += q1.w * s0;
        f32x4 sn = DC[dr] * s0; sn += k0.x * vv[0]; sn += k0.y * vv[1]; sn += k0.z * vv[2]; sn += k0.w * vv[3]; sn += k1.x * vv[4]; sn += k1.y * vv[5]; sn += k1.z * vv[6]; sn += k1.w * vv[7];
        __builtin_nontemporal_store(sn, (GAS f32x4*)(SN + (size_t)dr * DV + 4 * v4)); }
#pragma unroll
    for (int t = 0; t < 8; ++t) *(LAS f32x4*)(RED + (dg * 8 + t) * 256 + 4 * v4) = oacc[t];
    __syncthreads();
    { const int t = wave; f32x4 o = (f32x4){0.f, 0.f, 0.f, 0.f};
#pragma unroll
      for (int g2 = 0; g2 < 8; ++g2) o += *(const LAS f32x4*)(RED + (g2 * 8 + t) * 256 + 4 * v4);
#pragma unroll
      for (int s2 = 0; s2 < 8; ++s2) o += ATT[t * 8 + s2] * vv[s2];
      const float ss = wave_sum((o.x * o.x + o.y * o.y) + (o.z * o.z + o.w * o.w)); const float rs = 1.0f / sqrtf(ss * (1.f / DV) + EPS);
      v2u w; w.x = pk2(o.x * rs * go.x * bflo(zz.x), o.y * rs * go.y * bfhi(zz.x)); w.y = pk2(o.z * rs * go.z * bflo(zz.y), o.w * rs * go.w * bfhi(zz.y));
      *(GAS v2u*)(Y + (size_t)(r0 + t) * DM + EA + h * DV + 4 * v4) = w; }
}

constexpr int PRP = 264, PRT = 68;
__device__ __forceinline__ void prep_unit(Frame& F, int unit) {
    int tid = ((int)threadIdx.x); asm volatile("" : "+v"(tid));
    const int hp = unit & 1, cc = (unit >> 1) & 31, b = unit >> 6, r0 = b * SEQ + cc * GC, ch = tid & 255, th = tid >> 8, c0 = hp * 256;
    LAS bf16* QL = (LAS bf16*)F.lds;
    LAS bf16* KL = QL + 64 * PRP;
    LAS bf16* KTL = KL + 64 * PRP;
    LAS float* TOT = (LAS float*)(KTL + 256 * PRT);
    const float* LAg = (const float*)(F.ws + WS_LA); const bf16* Q = (const bf16*)(F.ws + WS_Q); const bf16* KBp = (const bf16*)(F.ws + WS_KB);
    bf16* QTg = (bf16*)(F.ws + WS_QT); bf16* KTT = (bf16*)(F.ws + WS_KTT); float* DEC = (float*)(F.ws + WS_DEC);
    __syncthreads();
    float bl[32]; float run = 0.f;
#pragma unroll
    for (int i2 = 0; i2 < 32; ++i2) { run += LAg[(size_t)(r0 + 32 * th + i2) * KBW + c0 + ch]; bl[i2] = run; }
    TOT[th * 256 + ch] = run;
    __syncthreads();
    const float t0 = TOT[ch], t1 = TOT[256 + ch], off = th ? t0 : 0.f;
    if (th == 0) DEC[((size_t)(b * HB + 2 * hp + (ch >> 7)) * NCH + cc) * DK + (ch & 127)] = __expf(t0 + t1);
#pragma unroll
    for (int i2 = 0; i2 < 32; ++i2) { const int t = 32 * th + i2; const float eb = __expf(bl[i2] + off), ek = __builtin_amdgcn_rcpf(eb);
        const float q = bf2f(Q[(size_t)(r0 + t) * KBW + c0 + ch]), k = bf2f(KBp[(size_t)(r0 + t) * KBW + c0 + ch]);
        const bf16 kb = (bf16)f2bf(k * ek); QL[t * PRP + ch] = (bf16)f2bf(q * eb); KL[t * PRP + ch] = kb; KTL[ch * PRT + t] = kb; }
    __syncthreads();
#pragma unroll
    for (int i2 = 0; i2 < 4; ++i2) { const int p = tid + NTHR * i2, t = p >> 5, c8 = (p & 31) * 8; const size_t o = ((size_t)(b * HB + 2 * hp + (c8 >> 7)) * SEQ + cc * GC + t) * DK + (c8 & 127);
        *(GAS v4u*)(QTg + o) = *(const LAS v4u*)(QL + t * PRP + c8); }
    { const int lane = tid & 63, fr = lane & 15, fq = lane >> 4, hl = F.wave >> 2, ti = F.wave & 3; bf16* ATg = (bf16*)(F.ws + WS_ATT) + ((size_t)(b * HB + 2 * hp + hl) * NCH + cc) * GC * GC;
      bf16x8 qf[4];
#pragma unroll
      for (int kk = 0; kk < 4; ++kk) qf[kk] = *(const LAS bf16x8*)(QL + (16 * ti + fr) * PRP + hl * 128 + 32 * kk + 8 * fq);
#pragma unroll
      for (int si = 0; si < 4; ++si) { pg8::f32x4 a = (pg8::f32x4){0.f, 0.f, 0.f, 0.f};
          if (si <= ti) {
#pragma unroll
              for (int kk = 0; kk < 4; ++kk) a = __builtin_amdgcn_mfma_f32_16x16x32_bf16(*(const LAS bf16x8*)(KL + (16 * si + fr) * PRP + hl * 128 + 32 * kk + 8 * fq), qf[kk], a, 0, 0, 0); }
          const int t = 16 * ti + fr, s0 = 16 * si + 4 * fq; v2u w;
          w.x = pk2(s0 <= t ? a.x : 0.f, s0 + 1 <= t ? a.y : 0.f); w.y = pk2(s0 + 2 <= t ? a.z : 0.f, s0 + 3 <= t ? a.w : 0.f);
          *(GAS v2u*)(ATg + t * GC + s0) = w; } }
#pragma unroll
    for (int i2 = 0; i2 < 4; ++i2) { const int p = tid + NTHR * i2, chh = p >> 3, t8 = (p & 7) * 8; const v2u a = *(const LAS v2u*)(KTL + chh * PRT + t8), c2 = *(const LAS v2u*)(KTL + chh * PRT + t8 + 4);
        *(GAS v4u*)(KTT + (((size_t)(b * HB + 2 * hp + (chh >> 7)) * NCH + cc) * DK + (chh & 127)) * GC + t8) = (v4u){a.x, a.y, c2.x, c2.y}; }
}

constexpr int PQ = 136, PS64 = 72;
__device__ __forceinline__ bf16x8 ldfrag(const LAS bf16* base, int row, int pitch, int k0) { return *(const LAS bf16x8*)(base + row * pitch + k0); }
struct GlaStage { v4u q[2], kt[2], at, v; float dec; };
template <int NVT>
__device__ __forceinline__ void gla_unit(Frame& F, int unit, bool fuse_norm) {
    constexpr int SW = 16 * NVT, NSL = DV / SW, VPR = SW / 8  ;
    int tid = ((int)threadIdx.x); asm volatile("" : "+v"(tid));
    const int bh = unit / NSL, j = unit % NSL, b = bh >> 2, h = bh & 3, lane = tid & 63, wave = F.wave, fr = lane & 15, fq = lane >> 4;
    constexpr int SET_E = 64 * PQ + 128 * PS64 + SW * PS64 + 64 * PS64 + 256;
    LAS bf16* L0 = (LAS bf16*)F.lds; LAS bf16* STL = L0 + 2 * SET_E;
    const bf16* QTg = (const bf16*)(F.ws + WS_QT) + (size_t)bh * SEQ * DK; const bf16* ATg = (const bf16*)(F.ws + WS_ATT) + (size_t)bh * NCH * GC * GC;
    const bf16* KTT = (const bf16*)(F.ws + WS_KTT) + (size_t)bh * NCH * DK * GC; const float* DEC = (const float*)(F.ws + WS_DEC) + (size_t)bh * NCH * DK;
    const bf16* VB = (const bf16*)(F.ws + WS_VB) + (size_t)(b * SEQ) * EB + h * DV + j * SW; bf16* O = (bf16*)(F.ws + WS_O) + (size_t)(b * SEQ) * EB + h * DV + j * SW;
    __syncthreads();
    for (int i = tid; i < 2 * SW * PQ / 2; i += NTHR) ((LAS unsigned*)STL)[i] = 0u;
#define GLA_LD16(dst, ptr) asm volatile("global_load_dwordx4 %0, %1, off" : "=v"(dst) : "v"(ptr) : "memory")
#define GLA_FETCH(R, c) do { const int c_ = (c) < NCH ? (c) : NCH - 1; \
        GLA_LD16(R.q[0], QTg + (size_t)c_ * GC * DK + tid * 8); GLA_LD16(R.q[1], QTg + (size_t)c_ * GC * DK + (tid + NTHR) * 8); \
        GLA_LD16(R.kt[0], KTT + (size_t)c_ * DK * GC + tid * 8); GLA_LD16(R.kt[1], KTT + (size_t)c_ * DK * GC + (tid + NTHR) * 8); \
        GLA_LD16(R.at, ATg + (size_t)c_ * GC * GC + tid * 8); \
        { const int tv_ = tid % (64 * VPR), s_ = tv_ / VPR, hf_ = tv_ % VPR; GLA_LD16(R.v, VB + (size_t)(c_ * GC + s_) * EB + hf_ * 8); } \
        asm volatile("global_load_dword %0, %1, off" : "=v"(R.dec) : "v"(DEC + c_ * DK + (tid & 127)) : "memory"); } while (0)
#define GLA_WAIT(R, n) asm volatile("s_waitcnt vmcnt(" #n ")" : "+v"(R.q[0]), "+v"(R.q[1]), "+v"(R.kt[0]), "+v"(R.kt[1]), "+v"(R.at), "+v"(R.v), "+v"(R.dec) :: "memory")
#define GLA_COMMIT(R, set) do { LAS bf16* QL_ = L0 + (set) * SET_E; LAS bf16* KTL_ = QL_ + 64 * PQ; LAS bf16* VTL_ = KTL_ + 128 * PS64; LAS bf16* ATL_ = VTL_ + SW * PS64; LAS float* DCL_ = (LAS float*)(ATL_ + 64 * PS64); \
        _Pragma("unroll") for (int i_ = 0; i_ < 2; ++i_) { const int p_ = tid + NTHR * i_; { const int r_ = p_ >> 4, cch_ = p_ & 15; *(LAS v4u*)(QL_ + r_ * PQ + cch_ * 8) = R.q[i_]; } \
            { const int r_ = p_ >> 3, cch_ = p_ & 7; *(LAS v4u*)(KTL_ + r_ * PS64 + cch_ * 8) = R.kt[i_]; } } \
        { const int r_ = tid >> 3, cch_ = tid & 7; *(LAS v4u*)(ATL_ + r_ * PS64 + cch_ * 8) = R.at; } \
        if (tid < 64 * VPR) { const int s_ = tid / VPR, hf_ = tid % VPR; const unsigned w_[4] = {R.v.x, R.v.y, R.v.z, R.v.w}; \
            _Pragma("unroll") for (int e_ = 0; e_ < 4; ++e_) { VTL_[(hf_ * 8 + 2 * e_) * PS64 + s_] = (bf16)(w_[e_] & 0xffffu); VTL_[(hf_ * 8 + 2 * e_ + 1) * PS64 + s_] = (bf16)(w_[e_] >> 16); } } \
        if (tid < 128) DCL_[tid] = R.dec; } while (0)
    pg8::f32x4 sacc[2][NVT];
#pragma unroll
    for (int e = 0; e < 2; ++e)
#pragma unroll
        for (int vt = 0; vt < NVT; ++vt) sacc[e][vt] = (pg8::f32x4){0.f, 0.f, 0.f, 0.f};
    GlaStage ra, rb, rc;
    GLA_FETCH(ra, 0); GLA_WAIT(ra, 0); GLA_COMMIT(ra, 0); GLA_FETCH(ra, 1); GLA_FETCH(rb, 2); GLA_FETCH(rc, 3);
    __syncthreads();
#define GLA_STEP(R, cc) { const int c = (cc); GLA_WAIT(R, 14); if (c + 1 < NCH) GLA_COMMIT(R, (c + 1) & 1); GLA_FETCH(R, c + 4);
    for (int c3 = 0; c3 < NCH; c3 += 3) {
        GLA_STEP(ra, c3)
        const LAS bf16* QL = L0 + (c & 1) * SET_E; const LAS bf16* KTL = QL + 64 * PQ; const LAS bf16* VTL = KTL + 128 * PS64; const LAS bf16* ATL = VTL + SW * PS64; const LAS float* DCL = (const LAS float*)(ATL + 64 * PS64);
        const LAS bf16* STc = STL + (c & 1) * SW * PQ; LAS bf16* STn = STL + ((c + 1) & 1) * SW * PQ;
        if (wave < 4) {
            const int ti = wave; pg8::f32x4 o[NVT];
#pragma unroll
            for (int vt = 0; vt < NVT; ++vt) o[vt] = (pg8::f32x4){0.f, 0.f, 0.f, 0.f};
#pragma unroll
            for (int kk = 0; kk < 2; ++kk) { const bf16x8 bf = ldfrag(ATL, 16 * ti + fr, PS64, 32 * kk + 8 * fq);
#pragma unroll
                for (int vt = 0; vt < NVT; ++vt) o[vt] = __builtin_amdgcn_mfma_f32_16x16x32_bf16(ldfrag(VTL, 16 * vt + fr, PS64, 32 * kk + 8 * fq), bf, o[vt], 0, 0, 0); }
#pragma unroll
            for (int kk = 0; kk < 4; ++kk) { const bf16x8 bf = ldfrag(QL, 16 * ti + fr, PQ, 32 * kk + 8 * fq);
#pragma unroll
                for (int vt = 0; vt < NVT; ++vt) o[vt] = __builtin_amdgcn_mfma_f32_16x16x32_bf16(ldfrag(STc, 16 * vt + fr, PQ, 32 * kk + 8 * fq), bf, o[vt], 0, 0, 0); }
#pragma unroll
            for (int vt = 0; vt < NVT; ++vt) *(GAS v2u*)(O + (size_t)(c * GC + 16 * ti + fr) * EB + 16 * vt + 4 * fq) = (v2u){pk2(o[vt].x, o[vt].y), pk2(o[vt].z, o[vt].w)};
        } else {
#pragma unroll
            for (int e = 0; e < 2; ++e) { const int dt = 2 * (wave - 4) + e; const pg8::f32x4 dc = *(const LAS pg8::f32x4*)(DCL + 16 * dt + 4 * fq);
                const bf16x8 a0 = ldfrag(KTL, 16 * dt + fr, PS64, 8 * fq), a1 = ldfrag(KTL, 16 * dt + fr, PS64, 32 + 8 * fq);
#pragma unroll
                for (int vt = 0; vt < NVT; ++vt) { pg8::f32x4 sv = sacc[e][vt];
                    sv = __builtin_amdgcn_mfma_f32_16x16x32_bf16(a0, ldfrag(VTL, 16 * vt + fr, PS64, 8 * fq), sv, 0, 0, 0);
                    sv = __builtin_amdgcn_mfma_f32_16x16x32_bf16(a1, ldfrag(VTL, 16 * vt + fr, PS64, 32 + 8 * fq), sv, 0, 0, 0);
                    sv = sv * dc; sacc[e][vt] = sv; v2u w; w.x = pk2(sv.x, sv.y); w.y = pk2(sv.z, sv.w);
                    *(LAS v2u*)(STn + (16 * vt + fr) * PQ + 16 * dt + 4 * fq) = w; } }
        }
        __syncthreads();
        }
        if (c3 + 1 < NCH) GLA_STEP(rb, c3 + 1)
        const LAS bf16* QL = L0 + (c & 1) * SET_E; const LAS bf16* KTL = QL + 64 * PQ; const LAS bf16* VTL = KTL + 128 * PS64; const LAS bf16* ATL = VTL + SW * PS64; const LAS float* DCL = (const LAS float*)(ATL + 64 * PS64);
        const LAS bf16* STc = STL + (c & 1) * SW * PQ; LAS bf16* STn = STL + ((c + 1) & 1) * SW * PQ;
        if (wave < 4) {
            const int ti = wave; pg8::f32x4 o[NVT];
#pragma unroll
            for (int vt = 0; vt < NVT; ++vt) o[vt] = (pg8::f32x4){0.f, 0.f, 0.f, 0.f};
#pragma unroll
            for (int kk = 0; kk < 2; ++kk) { const bf16x8 bf = ldfrag(ATL, 16 * ti + fr, PS64, 32 * kk + 8 * fq);
#pragma unroll
                for (int vt = 0; vt < NVT; ++vt) o[vt] = __builtin_amdgcn_mfma_f32_16x16x32_bf16(ldfrag(VTL, 16 * vt + fr, PS64, 32 * kk + 8 * fq), bf, o[vt], 0, 0, 0); }
#pragma unroll
            for (int kk = 0; kk < 4; ++kk) { const bf16x8 bf = ldfrag(QL, 16 * ti + fr, PQ, 32 * kk + 8 * fq);
#pragma unroll
                for (int vt = 0; vt < NVT; ++vt) o[vt] = __builtin_amdgcn_mfma_f32_16x16x32_bf16(ldfrag(STc, 16 * vt + fr, PQ, 32 * kk + 8 * fq), bf, o[vt], 0, 0, 0); }
#pragma unroll
            for (int vt = 0; vt < NVT; ++vt) *(GAS v2u*)(O + (size_t)(c * GC + 16 * ti + fr) * EB + 16 * vt + 4 * fq) = (v2u){pk2(o[vt].x, o[vt].y), pk2(o[vt].z, o[vt].w)};
        } else {
#pragma unroll
            for (int e = 0; e < 2; ++e) { const int dt = 2 * (wave - 4) + e; const pg8::f32x4 dc = *(const LAS pg8::f32x4*)(DCL + 16 * dt + 4 * fq);
                const bf16x8 a0 = ldfrag(KTL, 16 * dt + fr, PS64, 8 * fq), a1 = ldfrag(KTL, 16 * dt + fr, PS64, 32 + 8 * fq);
#pragma unroll
                for (int vt = 0; vt < NVT; ++vt) { pg8::f32x4 sv = sacc[e][vt];
                    sv = __builtin_amdgcn_mfma_f32_16x16x32_bf16(a0, ldfrag(VTL, 16 * vt + fr, PS64, 8 * fq), sv, 0, 0, 0);
                    sv = __builtin_amdgcn_mfma_f32_16x16x32_bf16(a1, ldfrag(VTL, 16 * vt + fr, PS64, 32 + 8 * fq), sv, 0, 0, 0);
                    sv = sv * dc; sacc[e][vt] = sv; v2u w; w.x = pk2(sv.x, sv.y); w.y = pk2(sv.z, sv.w);
                    *(LAS v2u*)(STn + (16 * vt + fr) * PQ + 16 * dt + 4 * fq) = w; } }
        }
        __syncthreads();
        }
        if (c3 + 2 < NCH) GLA_STEP(rc, c3 + 2)
        const LAS bf16* QL = L0 + (c & 1) * SET_E; const LAS bf16* KTL = QL + 64 * PQ; const LAS bf16* VTL = KTL + 128 * PS64; const LAS bf16* ATL = VTL + SW * PS64; const LAS float* DCL = (const LAS float*)(ATL + 64 * PS64);
        const LAS bf16* STc = STL + (c & 1) * SW * PQ; LAS bf16* STn = STL + ((c + 1) & 1) * SW * PQ;
        if (wave < 4) {
            const int ti = wave; pg8::f32x4 o[NVT];
#pragma unroll
            for (int vt = 0; vt < NVT; ++vt) o[vt] = (pg8::f32x4){0.f, 0.f, 0.f, 0.f};
#pragma unroll
            for (int kk = 0; kk < 2; ++kk) { const bf16x8 bf = ldfrag(ATL, 16 * ti + fr, PS64, 32 * kk + 8 * fq);
#pragma unroll
                for (int vt = 0; vt < NVT; ++vt) o[vt] = __builtin_amdgcn_mfma_f32_16x16x32_bf16(ldfrag(VTL, 16 * vt + fr, PS64, 32 * kk + 8 * fq), bf, o[vt], 0, 0, 0); }
#pragma unroll
            for (int kk = 0; kk < 4; ++kk) { const bf16x8 bf = ldfrag(QL, 16 * ti + fr, PQ, 32 * kk + 8 * fq);
#pragma unroll
                for (int vt = 0; vt < NVT; ++vt) o[vt] = __builtin_amdgcn_mfma_f32_16x16x32_bf16(ldfrag(STc, 16 * vt + fr, PQ, 32 * kk + 8 * fq), bf, o[vt], 0, 0, 0); }
#pragma unroll
            for (int vt = 0; vt < NVT; ++vt) *(GAS v2u*)(O + (size_t)(c * GC + 16 * ti + fr) * EB + 16 * vt + 4 * fq) = (v2u){pk2(o[vt].x, o[vt].y), pk2(o[vt].z, o[vt].w)};
        } else {
#pragma unroll
            for (int e = 0; e < 2; ++e) { const int dt = 2 * (wave - 4) + e; const pg8::f32x4 dc = *(const LAS pg8::f32x4*)(DCL + 16 * dt + 4 * fq);
                const bf16x8 a0 = ldfrag(KTL, 16 * dt + fr, PS64, 8 * fq), a1 = ldfrag(KTL, 16 * dt + fr, PS64, 32 + 8 * fq);
#pragma unroll
                for (int vt = 0; vt < NVT; ++vt) { pg8::f32x4 sv = sacc[e][vt];
                    sv = __builtin_amdgcn_mfma_f32_16x16x32_bf16(a0, ldfrag(VTL, 16 * vt + fr, PS64, 8 * fq), sv, 0, 0, 0);
                    sv = __builtin_amdgcn_mfma_f32_16x16x32_bf16(a1, ldfrag(VTL, 16 * vt + fr, PS64, 32 + 8 * fq), sv, 0, 0, 0);
                    sv = sv * dc; sacc[e][vt] = sv; v2u w; w.x = pk2(sv.x, sv.y); w.y = pk2(sv.z, sv.w);
                    *(LAS v2u*)(STn + (16 * vt + fr) * PQ + 16 * dt + 4 * fq) = w; } }
        }
        __syncthreads();
        }
    }
#undef GLA_STEP
    GLA_WAIT(ra, 0); GLA_WAIT(rb, 0); GLA_WAIT(rc, 0);
    if (wave >= 4) { float* SP = F.out + OUT_SP + (size_t)bh * DK * DV + j * SW;
#pragma unroll
        for (int e = 0; e < 2; ++e) { const int dt = 2 * (wave - 4) + e;
#pragma unroll
            for (int vt = 0; vt < NVT; ++vt)
#pragma unroll
                for (int i = 0; i < 4; ++i) SP[(size_t)(16 * dt + 4 * fq + i) * DV + 16 * vt + fr] = sacc[e][vt][i]; } }
#undef GLA_FETCH
#undef GLA_COMMIT
#undef GLA_WAIT
#undef GLA_LD16
    if (fuse_norm) {
        asm volatile("s_waitcnt vmcnt(0)" ::: "memory");
        __syncthreads();
        if (tid == 0) { unsigned* cnt = (unsigned*)(F.ws + WS_CTL) + CW_GRP + 64 * bh;
            __builtin_amdgcn_fence(__ATOMIC_RELEASE, "agent"); asm volatile("s_waitcnt vmcnt(0)" ::: "memory");
            (void)__hip_atomic_fetch_add(cnt, 1u, __ATOMIC_RELAXED, __HIP_MEMORY_SCOPE_AGENT); }
    }
}
__device__ __forceinline__ void head_norm(Frame& F, int bh, int rlo, unsigned need) {
    const int tid = (int)threadIdx.x, lane = tid & 63, wave = F.wave, b = bh >> 2, h = bh & 3;
    if (tid == 0) { unsigned* cnt = (unsigned*)(F.ws + WS_CTL) + CW_GRP + 64 * bh;
        unsigned sp = 0; while (__hip_atomic_load(cnt, __ATOMIC_RELAXED, __HIP_MEMORY_SCOPE_AGENT) < need) { __builtin_amdgcn_s_sleep(2); if (++sp > (1u << 20)) break; }
        __builtin_amdgcn_fence(__ATOMIC_ACQUIRE, "agent"); asm volatile("s_waitcnt vmcnt(0)" ::: "memory"); }
    __syncthreads();
    const bf16* Oh = (const bf16*)(F.ws + WS_O) + (size_t)(b * SEQ) * EB + h * DV; const bf16* SZB = (const bf16*)(F.ws + WS_SZB) + (size_t)(b * SEQ) * EB + h * DV; bf16* Y = (bf16*)(F.ws + WS_Y) + (size_t)(b * SEQ) * DM + EA + h * DV;
    const f32x4 go = *(const GAS f32x4*)(F.g_o + h * DV + 4 * lane);
    constexpr int NB = 16; v2u ob[NB], zz[NB];
#pragma unroll
    for (int q = 0; q < NB; ++q) { const int row = rlo + wave + NWAVES * q; ob[q] = *(const GAS v2u*)(Oh + (size_t)row * EB + 4 * lane); zz[q] = *(const GAS v2u*)(SZB + (size_t)row * EB + 4 * lane); }
#pragma unroll
    for (int q = 0; q < NB; ++q) { const int row = rlo + wave + NWAVES * q;
        const f32x4 o = (f32x4){bflo(ob[q].x), bfhi(ob[q].x), bflo(ob[q].y), bfhi(ob[q].y)};
        const float ss = wave_sum((o.x * o.x + o.y * o.y) + (o.z * o.z + o.w * o.w)); const float rs = 1.0f / sqrtf(ss * (1.f / DV) + EPS);
        v2u w; w.x = pk2(o.x * rs * go.x * bflo(zz[q].x), o.y * rs * go.y * bfhi(zz[q].x)); w.y = pk2(o.z * rs * go.z * bflo(zz[q].y), o.w * rs * go.w * bfhi(zz[q].y));
        *(GAS v2u*)(Y + (size_t)row * DM + 4 * lane) = w; }
}

struct Args { const float* in[19]; float* out; unsigned char* ws; int ph_lo, ph_hi, li, pad; };
constexpr int NPHASE = 11;
__global__ void __launch_bounds__(NTHR, 2) fwd_kernel(Args args) {
    extern __shared__ __attribute__((aligned(16))) unsigned char lds[];
    Frame F;
    F.lds = (LAS unsigned char*)lds; F.ws = args.ws; F.out = args.out;
    F.wave = __builtin_amdgcn_readfirstlane((int)threadIdx.x >> 6);
    F.G = gridDim.x; { const int bx = blockIdx.x; F.vcu = (F.G % 8 == 0) ? (bx % 8) * (F.G / 8) + bx / 8 : bx; }
    F.xp = args.in[0]; F.xs = args.in[1]; F.pp = args.in[2]; F.ps = args.in[3]; F.st0 = args.in[4]; F.g_pre = args.in[5]; F.w_in = args.in[6]; F.g_v = args.in[7]; F.w_s = args.in[8]; F.b_s = args.in[9];
    F.w_a2 = args.in[10]; F.b_a = args.in[11]; F.g_o = args.in[12]; F.w_pa = args.in[13]; F.w_pb = args.in[14]; F.w_o = args.in[15]; F.g_post = args.in[16]; F.w_pg = args.in[17]; F.w_pe = args.in[18];
    volatile LAS unsigned* MISC = (volatile LAS unsigned*)(F.lds + MISC_OFF);
    if (((int)threadIdx.x) < 64) MISC[((int)threadIdx.x)] = 0u;
    __syncthreads();
    XcdBarrier bar; bar.bar = (unsigned*)(F.ws + WS_CTL) + CW_BAR + args.li * XCD_BAR_WORDS; bar.x = 0; bar.st = nullptr;
    const int lo = args.ph_lo, hi = args.ph_hi;
    if (hi - lo > 1) bar = xcd_barrier_post(bar.bar, MISC + 8);
#define IN(k) (lo <= (k) && (k) < hi)
#define SEAM(k) do { if (IN(k) && IN((k) + 1)) xcd_barrier(bar); } while (0)
    unsigned char* ws = F.ws;

    if (IN(0)) { p0_prologue(F); } SEAM(0);

    if (IN(1)) {
        pg8::Gemm g{(const bf16*)(ws + WS_XN), (const bf16*)(ws + WS_W1T), DM, DM}; pg8::StaticOrder S; S.init(MT, N1, DM, F.G, (int)blockIdx.x);
        EpiG1 E{ws, F.b_a};
        pg8::gemm_phase<EpiG1, pg8::StaticOrder>(F.lds, g, S, E);
        { const int nfullc = S.nwg % F.G;
          pg8::Gemm g2{(const bf16*)(ws + WS_PBF), (const bf16*)(ws + WS_WPE), PLE, PLE}; pg8::ESampleOrder S2{nfullc ? F.G - nfullc : F.G, nfullc ? (int)blockIdx.x - nfullc : (int)blockIdx.x};
          EpiBf E2{(bf16*)(ws + WS_ES) - (size_t)MP * DM, DM};
          pg8::gemm_phase<EpiBf, pg8::ESampleOrder>(F.lds, g2, S2, E2); }
    } SEAM(1);

    const bool hetero = (F.G == 256);
    const bool fuse_norm = hetero || (F.G % 16) == 0;
    if (IN(2)) {
        if (hetero) { for (int u = F.vcu; u < 512; u += F.G) { if (u < 256) prep_unit(F, u); else gate_prompt_unit(F, u - 256); } }
        else { for (int u = F.vcu; u < 1024; u += F.G) { if (u < 256) gate_prompt_unit(F, u); else if (u < 768) sample_unit(F, u - 256); else prep_unit(F, u - 768); } }
    } SEAM(2);

    if (IN(3)) {
        if (hetero) { const int xcd = F.vcu >> 5, l = F.vcu & 31;
            if (l < 16) gla_unit<2>(F, (xcd * 2 + (l >> 3)) * 8 + (l & 7), true);
            else { for (int u = xcd * 16 + (l - 16); u < 512; u += 128) sample_unit(F, u); }
            __syncthreads(); head_norm(F, F.vcu >> 4, 128 * (F.vcu & 15), 8u); }
        else { for (int u = F.vcu; u < 256; u += F.G) gla_unit<1>(F, u, fuse_norm);
               if (fuse_norm) { for (int u = F.vcu; u < 256; u += F.G) head_norm(F, u >> 4, 128 * (u & 15), 16u); } }
    } SEAM(3);

    if (IN(4) && !fuse_norm) {
        const int gw = F.vcu * NWAVES + F.wave, NGW = F.G * NWAVES; const bf16* O = (const bf16*)(ws + WS_O); const bf16* SZB = (const bf16*)(ws + WS_SZB); bf16* Y = (bf16*)(ws + WS_Y);
        for (int m = gw; m < MP; m += NGW) {
#pragma unroll
            for (int h = 0; h < HB; ++h) { const v2u ob = *(const GAS v2u*)(O + (size_t)m * EB + h * DV + 4 * ((int)(threadIdx.x & 63u))); const f32x4 o = (f32x4){bflo(ob.x), bfhi(ob.x), bflo(ob.y), bfhi(ob.y)};
                const float ss = wave_sum((o.x * o.x + o.y * o.y) + (o.z * o.z + o.w * o.w)); const float rs = 1.0f / sqrtf(ss * (1.f / DV) + EPS);
                const f32x4 go = *(const GAS f32x4*)(F.g_o + h * DV + 4 * ((int)(threadIdx.x & 63u))); const v2u zz = *(const GAS v2u*)(SZB + (size_t)m * EB + h * DV + 4 * ((int)(threadIdx.x & 63u)));
                v2u w; w.x = pk2(o.x * rs * go.x * bflo(zz.x), o.y * rs * go.y * bfhi(zz.x)); w.y = pk2(o.z * rs * go.z * bflo(zz.y), o.w * rs * go.w * bfhi(zz.y));
                *(GAS v2u*)(Y + (size_t)m * DM + EA + h * DV + 4 * ((int)(threadIdx.x & 63u))) = w; } }
    } if (!fuse_norm) SEAM(4);

    bf16* const slabA_lo = (bf16*)(ws + WS_SLABA); bf16* const slabA_hi = slabA_lo + (size_t)4 * MS * DM;
    bf16* const slabB_lo = (bf16*)(ws + WS_GA); bf16* const slabB_hi = slabB_lo + (size_t)4 * MS * DM;
    if (IN(5)) {
        { pg8::Gemm g{(const bf16*)(ws + WS_Y), (const bf16*)(ws + WS_WPAB), DM, DM}; pg8::TailOrder S{F.G, (int)blockIdx.x, (int)((blockIdx.x >> 6) & 1)};
          EpiG2 E{ws + WS_GA, ws + WS_GB, (bf16*)(ws + WS_M), slabA_lo, slabA_hi};
          pg8::gemm_phase<EpiG2, pg8::TailOrder>(F.lds, g, S, E); }
        { pg8::Gemm g{(const bf16*)(ws + WS_PBF), (const bf16*)(ws + WS_WPE), PLE, PLE}; pg8::EPromptOrder S{F.G, (int)blockIdx.x};
          EpiBf E{(bf16*)(ws + WS_E), DM};
          pg8::gemm_phase<EpiBf, pg8::EPromptOrder>(F.lds, g, S, E); }
    } SEAM(5);

    if (IN(6)) {
        const int gt = F.vcu * NTHR + ((int)threadIdx.x), NGT = F.G * NTHR; const unsigned char* GA = ws + WS_GA; const unsigned char* GB = ws + WS_GB; bf16* Mo = (bf16*)(ws + WS_M);
        for (int p = gt; p < MS * DM / 8; p += NGT) { const size_t off = (size_t)p * 8, og = (size_t)MP * DM + off;
            f32x4 a0, a1, b0, b1; slab_sum8(slabA_lo, slabA_hi, off, 0, 4, a0, a1); slab_sum8(slabA_lo, slabA_hi, off, 4, 8, b0, b1);
            float fa[8], fb[8]; u8x8_to_f32(*(const GAS v2u*)(GA + og), fa); u8x8_to_f32(*(const GAS v2u*)(GB + og), fb); const float k = 1.f / 255.f; v4u w;
            w.x = pk2((fa[0] * a0.x + fb[0] * b0.x) * k, (fa[1] * a0.y + fb[1] * b0.y) * k); w.y = pk2((fa[2] * a0.z + fb[2] * b0.z) * k, (fa[3] * a0.w + fb[3] * b0.w) * k);
            w.z = pk2((fa[4] * a1.x + fb[4] * b1.x) * k, (fa[5] * a1.y + fb[5] * b1.y) * k); w.w = pk2((fa[6] * a1.z + fb[6] * b1.z) * k, (fa[7] * a1.w + fb[7] * b1.w) * k);
            *(GAS v4u*)(Mo + og) = w; }
    } SEAM(6);

    if (IN(7)) {
        pg8::Gemm g{(const bf16*)(ws + WS_M), (const bf16*)(ws + WS_WO), DM, DM}; pg8::TailOrder S{F.G, (int)blockIdx.x, (int)((blockIdx.x >> 6) & 1)};
        EpiG3 E{(bf16*)(ws + WS_T), (float*)(ws + WS_TSS), slabB_lo, slabB_hi, hetero ? 1 : 0, (bf16*)(ws + WS_H), (float*)(ws + WS_TSS), (unsigned*)(ws + WS_CTL) + CW_PAN, F.xp, F.g_post, F.lds + pg8::STAGE_BYTES};
        pg8::gemm_phase<EpiG3, pg8::TailOrder>(F.lds, g, S, E);
    } SEAM(7);

    if (IN(8)) {
        const bf16* T = (const bf16*)(ws + WS_T); const float* TSS = (const float*)(ws + WS_TSS); bf16* H = (bf16*)(ws + WS_H);
        for (int r = F.wave * F.G + F.vcu; r < MS; r += NWAVES * F.G) { const int m = MP + r;
            f32x4 t4[8]; float ss = 0.f;
#pragma unroll
            for (int j2 = 0; j2 < 8; ++j2) { t4[j2] = slab_sum4(slabB_lo, slabB_hi, (size_t)r * DM + 4 * ((int)(threadIdx.x & 63u)) + 256 * j2); ss += (t4[j2].x * t4[j2].x + t4[j2].y * t4[j2].y) + (t4[j2].z * t4[j2].z + t4[j2].w * t4[j2].w); }
            const float rs = 1.0f / sqrtf(wave_sum(ss) * (1.f / DM) + EPS);
            const GAS f32x4* xr = (const GAS f32x4*)xrow(F, m) + ((int)(threadIdx.x & 63u)); const GAS f32x4* gr = (const GAS f32x4*)F.g_post + ((int)(threadIdx.x & 63u)); GAS v2u* ho = (GAS v2u*)(H + (size_t)m * DM) + ((int)(threadIdx.x & 63u));
#pragma unroll
            for (int j2 = 0; j2 < 8; ++j2) { const f32x4 xv = xr[64 * j2], gg = gr[64 * j2], tv = t4[j2]; v2u o, tb; tb.x = pk2(tv.x, tv.y); tb.y = pk2(tv.z, tv.w);
                o.x = pk2(xv.x + bflo(tb.x) * rs * gg.x, xv.y + bfhi(tb.x) * rs * gg.y); o.y = pk2(xv.z + bflo(tb.y) * rs * gg.z, xv.w + bfhi(tb.y) * rs * gg.w); ho[64 * j2] = o; }
        }
        const int gw = F.vcu * NWAVES + F.wave, NGW = F.G * NWAVES;
        for (int m = hetero ? MP : gw; m < MP; m += NGW) {
            float ss = ((int)(threadIdx.x & 63u)) < 32 ? TSS[(size_t)m * 32 + ((int)(threadIdx.x & 63u))] : 0.f; ss = wave_sum(ss); const float rs = 1.0f / sqrtf(ss * (1.f / DM) + EPS);
            const GAS f32x4* xr = (const GAS f32x4*)xrow(F, m) + ((int)(threadIdx.x & 63u)); const GAS f32x4* gr = (const GAS f32x4*)F.g_post + ((int)(threadIdx.x & 63u)); const GAS v2u* tr = (const GAS v2u*)(T + (size_t)m * DM) + ((int)(threadIdx.x & 63u)); GAS v2u* ho = (GAS v2u*)(H + (size_t)m * DM) + ((int)(threadIdx.x & 63u));
#pragma unroll
            for (int j2 = 0; j2 < 8; ++j2) { const f32x4 xv = xr[64 * j2], gg = gr[64 * j2]; const v2u tv = tr[64 * j2]; v2u o;
                o.x = pk2(xv.x + bflo(tv.x) * rs * gg.x, xv.y + bfhi(tv.x) * rs * gg.y); o.y = pk2(xv.z + bflo(tv.y) * rs * gg.z, xv.w + bfhi(tv.y) * rs * gg.w); ho[64 * j2] = o; }
        }
    } SEAM(8);

    if (IN(9)) {
        pg8::Gemm g{(const bf16*)(ws + WS_H), (const bf16*)(ws + WS_WPG), DM, DM}; pg8::TailOrder S{F.G, (int)blockIdx.x, (int)((blockIdx.x >> 6) & 1)};
        EpiG4 E{(const bf16*)(ws + WS_H), (const bf16*)(ws + WS_E), F.out + OUT_Y, slabB_lo, slabB_hi};
        pg8::gemm_phase<EpiG4, pg8::TailOrder>(F.lds, g, S, E);
    } SEAM(9);

    if (IN(10)) {
        const int gt = F.vcu * NTHR + ((int)threadIdx.x), NGT = F.G * NTHR; const bf16* Hb = (const bf16*)(ws + WS_H); const bf16* Es = (const bf16*)(ws + WS_ES); float* out = F.out + OUT_Y;
        for (int p = gt; p < MS * DM / 4; p += NGT) { const size_t off = (size_t)p * 4, og = (size_t)MP * DM + off;
            const f32x4 a = slab_sum4(slabB_lo, slabB_hi, off); const v2u hv = *(const GAS v2u*)(Hb + og), ev = *(const GAS v2u*)(Es + off);
            f32x4 o; o.x = bflo(hv.x) + sigm(a.x) * bflo(ev.x); o.y = bfhi(hv.x) + sigm(a.y) * bfhi(ev.x); o.z = bflo(hv.y) + sigm(a.z) * bflo(ev.y); o.w = bfhi(hv.y) + sigm(a.w) * bfhi(ev.y);
            *(GAS f32x4*)(out + og) = o; }
    }
#undef IN
#undef SEAM
}

__global__ void dbg_dump(const unsigned short* src, float* dst, size_t n) { for (size_t i = blockIdx.x * (size_t)blockDim.x + threadIdx.x; i < n; i += (size_t)gridDim.x * blockDim.x) dst[i] = __uint_as_float((unsigned)src[i] << 16); }
extern "C" void kernel_launch(void* const* d_in, const int* in_sizes, int n_in, void* d_out, int out_size, void* d_ws, size_t ws_size, hipStream_t stream) {
    static int grid = 0;
    if (grid == 0) {
        if (n_in != 19 || ws_size < WS_END) { fprintf(stderr, "kernel_launch: built for 19 inputs and >= %zu bytes of workspace; got n_in %d, ws %zu\n", (size_t)WS_END, n_in, ws_size); grid = -1; return; }
        int dev = 0, cus = 0, per_cu = 0;
        if (hipGetDevice(&dev) != hipSuccess || hipDeviceGetAttribute(&cus, hipDeviceAttributeMultiprocessorCount, dev) != hipSuccess) { grid = -1; return; }
        if (hipFuncSetAttribute((const void*)fwd_kernel, hipFuncAttributeMaxDynamicSharedMemorySize, LDS_BYTES) != hipSuccess) { fprintf(stderr, "kernel_launch: hipFuncSetAttribute failed\n"); grid = -1; return; }
        if (hipOccupancyMaxActiveBlocksPerMultiprocessor(&per_cu, (const void*)fwd_kernel, NTHR, LDS_BYTES) != hipSuccess || per_cu < 1) { fprintf(stderr, "kernel_launch: occupancy query says %d blocks per CU\n", per_cu); per_cu = 1; }
        (void)hipGetLastError();
        grid = cus;
    }
    if (grid < 0) return;
    (void)hipMemsetAsync((char*)d_ws + WS_CTL, 0, CTL_ZERO_BYTES, stream);
    Args a{};
    for (int i = 0; i < 19; ++i) a.in[i] = (const float*)d_in[i];
    a.out = (float*)d_out; a.ws = (unsigned char*)d_ws;
#if MK_N_LAUNCHES == 1
    a.ph_lo = 0; a.ph_hi = NPHASE; a.li = 0;
    hipLaunchKernelGGL(fwd_kernel, dim3(grid), dim3(NTHR), LDS_BYTES, stream, a);
#else
#ifndef DBG_LAST
#define DBG_LAST (NPHASE - 1)
#endif
    if (DBG_LAST < NPHASE - 1) (void)hipMemsetAsync(d_out, 0, (size_t)out_size * 4, stream);
    for (int li = 0; li <= DBG_LAST; ++li) { const int rep = 1; for (int r = 0; r < rep; ++r) { a.ph_lo = li; a.ph_hi = li + 1; a.li = 0; hipLaunchKernelGGL(fwd_kernel, dim3(grid), dim3(NTHR), LDS_BYTES, stream, a); } }
#ifdef DBG_DUMP
    hipLaunchKernelGGL(dbg_dump, dim3(2048), dim3(256), 0, stream, (const unsigned short*)((char*)d_ws + DBG_DUMP), (float*)d_out, (size_t)MT * DM);
#endif
#endif
}
```

```cpp
#include <hip/hip_runtime.h>
#include <cstdio>
#include <cstdint>

#ifndef MK_N_LAUNCHES
#define MK_N_LAUNCHES 1
#endif

namespace pg8 {
#define PG8_LAS __attribute__((address_space(3)))
typedef unsigned short bf16_t;
typedef short bf16x8 __attribute__((ext_vector_type(8)));
typedef float f32x4 __attribute__((ext_vector_type(4)));
typedef unsigned u32x4 __attribute__((ext_vector_type(4)));
typedef unsigned u32x2 __attribute__((ext_vector_type(2)));
constexpr int BM = 256, BK = 64, HALF = 128, HTB = HALF * BK * 2, STAGE_BYTES = 8 * HTB, NXCD = 8, WGM = 8;

__host__ __device__ __forceinline__ int lds_byte(int r, int c) { const int st = (r >> 4) * 2 + (c >> 5), rr = r & 15, cc = c & 31, ob = rr * 64 + cc * 2; return st * 1024 + (ob ^ (((ob >> 9) & 1) << 5)); }
__host__ __device__ __forceinline__ void stage_rc(int b, int& R, int& C) { const int st = b / 1024, sb = b % 1024, swz = sb ^ (((sb >> 9) & 1) << 5); R = (st >> 1) * 16 + swz / 64; C = (st & 1) * 32 + (swz % 64) / 2; }
__host__ __device__ __forceinline__ int perm32(int rho) { const int n = rho >> 4, i = rho & 15; return 8 * (i >> 2) + 4 * n + (i & 3); }

struct Unit { int pm, pn, kt0, nkt, kind; };
struct Gemm { const bf16_t* A; const bf16_t* Bt; int lda, ldb; };

struct StaticOrder {
    int nM, nN, nwg, G, c, nkt;
    __host__ __device__ void init(int M, int N, int K, int G_, int c_) { nM = M / BM; nN = N / BM; nwg = nM * nN; G = G_; c = c_; nkt = K / BK; }
    __host__ __device__ bool next(int i, Unit& u) const {
        const long L = (long)i * G + c; if (L >= nwg) return false;
        int wgid = (int)L; { const int q = nwg / NXCD, r = nwg % NXCD, xcd = wgid % NXCD, off = wgid / NXCD; wgid = (xcd < r ? xcd * (q + 1) : r * (q + 1) + (xcd - r) * q) + off; }
        const int nig = WGM * nN, gid = wgid / nig, fm = gid * WGM, gsz = (nM - fm) < WGM ? (nM - fm) : WGM;
        u.pm = fm + ((wgid % nig) % gsz); u.pn = (wgid % nig) / gsz; u.kt0 = 0; u.nkt = nkt; u.kind = 0; return true;
    }
};
struct TailOrder {
    int G, c, swap;
    __host__ __device__ bool next(int i, Unit& u) const {
        long L = (long)i * G + c; if (swap && G == 256 && i < 2) L = (long)(1 - i) * G + c;
        if (L < 256) { const int x = (int)L & 7, kk = (int)L >> 3; u.pm = 4 * x + (kk >> 3); u.pn = kk & 7; u.kt0 = 0; u.nkt = 32; u.kind = 0; return true; }
        if (L < 512) { const int l2 = (int)L - 256, x = l2 & 7, kk = l2 >> 3; u.pm = 32 + (kk >> 3); u.pn = kk & 7; u.kt0 = 4 * x; u.nkt = 4; u.kind = 1; return true; }
        return false;
    }
};
struct EPromptOrder {
    int G, c;
    __host__ __device__ bool next(int i, Unit& u) const {
        const long L = (long)i * G + c; if (L >= 256) return false;
        const int x = (int)L & 7, kk = (int)L >> 3; u.pm = 4 * x + (kk >> 3); u.pn = kk & 7; u.kt0 = 0; u.nkt = 4; u.kind = 0; return true; }
};
struct ESampleOrder {
    int G2, c2;
    __host__ __device__ bool next(int i, Unit& u) const {
        if (c2 < 0 || G2 <= 0) return false; const long L = (long)i * G2 + c2; if (L >= 32) return false;
        u.pm = 32 + ((int)L >> 3); u.pn = (int)L & 7; u.kt0 = 0; u.nkt = 4; u.kind = 0; return true; }
};

typedef __bf16 bf2_t __attribute__((ext_vector_type(2)));
typedef float f2_t __attribute__((ext_vector_type(2)));
__device__ __forceinline__ unsigned cvt_pk_bf16(float lo, float hi) { return __builtin_bit_cast(unsigned, __builtin_convertvector((f2_t){lo, hi}, bf2_t)); }

template <class Epi, class Sched>
__device__ __forceinline__ void gemm_phase(PG8_LAS unsigned char* lds, const Gemm g, const Sched& S, const Epi& E) {
    const int tid = threadIdx.x, wid = __builtin_amdgcn_readfirstlane(tid >> 6), lane = tid & 63, wr = wid >> 2, wc = wid & 3, fr = lane & 15, fq = lane >> 4;
    unsigned voffA[2], voffB[2];
#pragma unroll
    for (int i = 0; i < 2; ++i) { int R, C; stage_rc(tid * 16 + i * 8192, R, C); const int Rb = Epi::PERM ? ((R & ~31) + perm32(R & 31)) : R;
        voffA[i] = (unsigned)(R * g.lda + C) * 2u; voffB[i] = (unsigned)(Rb * g.ldb + C) * 2u; }
    const size_t kstep = (size_t)(BK * 2);
    const size_t hstepA = (size_t)HALF * g.lda * 2, hstepB = (size_t)HALF * g.ldb * 2;
    const size_t tstepA = 2 * hstepA, tstepB = 2 * hstepB;
    const unsigned ldsw = (unsigned)wid * 1024u;
    const int aoff = lds_byte(wr * 64 + fr, fq * 8), boff = lds_byte(wc * 32 + fr, fq * 8);
#define PG8_SA(b, h) (((b) * 2 + (h)) * HTB)
#define PG8_SB(b, h) ((4 + (b) * 2 + (h)) * HTB)
#define PG8_STAGE(bufoff, gbase, voff) do { _Pragma("unroll") for (int _i = 0; _i < 2; ++_i) \
        __builtin_amdgcn_global_load_lds((const unsigned*)((const char*)(gbase) + (voff)[_i]), (PG8_LAS unsigned*)(lds + (bufoff) + ldsw + _i * 8192), 16, 0, 0); } while (0)
#define PG8_LDA(dst, b, h) do { _Pragma("unroll") for (int m = 0; m < 4; ++m) _Pragma("unroll") for (int k = 0; k < 2; ++k) dst[m][k] = *(const PG8_LAS bf16x8*)(lds + PG8_SA(b, h) + aoff + m * 2048 + k * 1024); } while (0)
#define PG8_LDB(dst, b, h) do { _Pragma("unroll") for (int n = 0; n < 2; ++n) _Pragma("unroll") for (int k = 0; k < 2; ++k) dst[n][k] = *(const PG8_LAS bf16x8*)(lds + PG8_SB(b, h) + boff + n * 2048 + k * 1024); } while (0)
#define PG8_MMA(ai, bj, At, Bt) do { __builtin_amdgcn_s_setprio(1); _Pragma("unroll") for (int m = 0; m < 4; ++m) _Pragma("unroll") for (int n = 0; n < 2; ++n) _Pragma("unroll") for (int k = 0; k < 2; ++k) \
        acc[ai][bj][m][n] = __builtin_amdgcn_mfma_f32_16x16x32_bf16(Bt[n][k], At[m][k], acc[ai][bj][m][n], 0, 0, 0); __builtin_amdgcn_s_setprio(0); } while (0)
#define PG8_WAIT_V(n) asm volatile("s_waitcnt vmcnt(" #n ")" ::: "memory")
#define PG8_WAIT_L(n) asm volatile("s_waitcnt lgkmcnt(" #n ")" ::: "memory")
#define PG8_BAR __builtin_amdgcn_s_barrier()
#define PG8_SCHED __builtin_amdgcn_sched_barrier(0)
    Unit cur, nxt; int ui = 0;
    if (!S.next(0, cur)) return;
    f32x4 acc[2][2][4][2];
#pragma unroll
    for (int a = 0; a < 2; ++a)
#pragma unroll
        for (int b = 0; b < 2; ++b)
#pragma unroll
            for (int m = 0; m < 4; ++m)
#pragma unroll
                for (int n = 0; n < 2; ++n) acc[a][b][m][n] = (f32x4){0.f, 0.f, 0.f, 0.f};
    bf16x8 At[4][2], B0[2][2], B1[2][2];
    const char* cA = (const char*)g.A + (size_t)cur.pm * tstepA + (size_t)cur.kt0 * kstep; const char* cB = (const char*)g.Bt + (size_t)cur.pn * tstepB + (size_t)cur.kt0 * kstep;
    int nt = cur.nkt; asm volatile("" : "+s"(nt));
    PG8_STAGE(PG8_SB(0, 0), cB, voffB); PG8_STAGE(PG8_SB(0, 1), cB + hstepB, voffB); PG8_STAGE(PG8_SA(0, 0), cA, voffA); PG8_STAGE(PG8_SA(0, 1), cA + hstepA, voffA);
    if (wr == 1) PG8_BAR;
    PG8_WAIT_V(2); PG8_BAR;
    PG8_STAGE(PG8_SB(1, 0), cB + kstep, voffB); PG8_STAGE(PG8_SA(1, 0), cA + kstep, voffA); PG8_STAGE(PG8_SB(1, 1), cB + hstepB + kstep, voffB);
    PG8_WAIT_V(6); PG8_BAR;
    for (;;) {
        const bool has_next = S.next(ui + 1, nxt);
        const char* nA = has_next ? (const char*)g.A + (size_t)nxt.pm * tstepA + (size_t)nxt.kt0 * kstep : cA; const char* nB = has_next ? (const char*)g.Bt + (size_t)nxt.pn * tstepB + (size_t)nxt.kt0 * kstep : cB;
        for (int t = 0; t < nt; t += 2) {
            const bool last = (t == nt - 2);
            const char* a1 = cA + (size_t)(t + 1) * kstep;
            const char* a2 = last ? nA : cA + (size_t)(t + 2) * kstep; const char* b2 = last ? nB : cB + (size_t)(t + 2) * kstep;
            const char* a3 = a2 + kstep; const char* b3 = b2 + kstep;
            if constexpr (Epi::HAS_MID) { if (cur.kind == 0 && t == (nt >> 1)) E.mid(acc, cur, wr, wc, fr, fq); }
            PG8_LDB(B0, 0, 0); PG8_LDB(B1, 0, 1); PG8_SCHED; PG8_LDA(At, 0, 0); PG8_STAGE(PG8_SA(1, 1), a1 + hstepA, voffA);
            PG8_WAIT_V(8); PG8_WAIT_L(0); PG8_BAR; PG8_MMA(0, 0, At, B0); PG8_MMA(0, 1, At, B1); PG8_BAR; PG8_SCHED;
            PG8_LDA(At, 0, 1); PG8_STAGE(PG8_SB(0, 0), b2, voffB); PG8_STAGE(PG8_SB(0, 1), b2 + hstepB, voffB); PG8_STAGE(PG8_SA(0, 0), a2, voffA);
            PG8_WAIT_V(8); PG8_WAIT_L(0); PG8_BAR; PG8_MMA(1, 0, At, B0); PG8_MMA(1, 1, At, B1); PG8_BAR; PG8_SCHED;
            PG8_LDB(B0, 1, 0); PG8_LDB(B1, 1, 1); PG8_SCHED; PG8_LDA(At, 1, 0); PG8_STAGE(PG8_SA(0, 1), a2 + hstepA, voffA);
            PG8_WAIT_V(8); PG8_WAIT_L(0); PG8_BAR; PG8_MMA(0, 0, At, B0); PG8_MMA(0, 1, At, B1); PG8_BAR; PG8_SCHED;
            PG8_LDA(At, 1, 1); PG8_STAGE(PG8_SB(1, 0), b3, voffB); PG8_STAGE(PG8_SB(1, 1), b3 + hstepB, voffB); PG8_STAGE(PG8_SA(1, 0), a3, voffA);
            PG8_WAIT_V(8); PG8_WAIT_L(0); PG8_BAR; PG8_MMA(1, 0, At, B0); PG8_MMA(1, 1, At, B1); PG8_BAR; PG8_SCHED;
        }
        if (wr == 0) PG8_BAR;
        E(acc, cur, wr, wc, fr, fq);
        if (!has_next) break;
#pragma unroll
        for (int a = 0; a < 2; ++a)
#pragma unroll
            for (int b = 0; b < 2; ++b)
#pragma unroll
                for (int m = 0; m < 4; ++m)
#pragma unroll
                    for (int n = 0; n < 2; ++n) acc[a][b][m][n] = (f32x4){0.f, 0.f, 0.f, 0.f};
        cur = nxt; cA = nA; cB = nB; ++ui; nt = cur.nkt; asm volatile("" : "+s"(nt));
        if (wr == 1) PG8_BAR;
    }
    PG8_WAIT_V(0);
    PG8_BAR;
#undef PG8_SA
#undef PG8_SB
#undef PG8_STAGE
#undef PG8_LDA
#undef PG8_LDB
#undef PG8_MMA
#undef PG8_WAIT_V
#undef PG8_WAIT_L
#undef PG8_BAR
#undef PG8_SCHED
}
}

constexpr int NWAVES = 8, NTHR = 512;
constexpr int DM = 2048, MP = 8192, MS = 1024, MT = 9216, SEQ = 2048, NBAT = 4, DBAT = 128, DSEQ = 8;
constexpr int EA = 1024, KBW = 512, EB = 1024, NIN = 10256, N1 = 10752, PLE = 256;
constexpr int HB = 4, DK = 128, DV = 256, GR = 16, CH = 128, GC = 64  , NCH = SEQ / GC;
constexpr float EPS = 1e-6f;
constexpr int C_ALR = 6144, C_MA = 6160;

constexpr size_t OUT_Y = 0, OUT_SP = (size_t)MT * DM, OUT_SS = OUT_SP + (size_t)NBAT * HB * DK * DV, OUT_CV = OUT_SS + (size_t)DBAT * HB * DK * DV;

constexpr size_t MiB = 1u << 20;
constexpr size_t WS_CTL = 0, CTL_ZERO_BYTES = 64 * 1024;
constexpr size_t WS_WPE = 1 * MiB, WS_WPAB = 2 * MiB, WS_WO = 10 * MiB, WS_WPG = 18 * MiB, WS_PBF = 26 * MiB;
constexpr size_t WS_VSS = 30 * MiB + 512 * 1024;
constexpr size_t WS_TSS = WS_VSS + (size_t)MT * 16 * 4;
constexpr size_t WS_RSTD = WS_TSS + (size_t)MT * 32 * 4;
constexpr size_t WS_DEC = 33 * MiB;
constexpr size_t WS_W1T = 34 * MiB;
constexpr size_t WS_QT = 34 * MiB, WS_ATT = 42 * MiB, WS_KTT = 50 * MiB;
constexpr size_t WS_E = 34 * MiB;
constexpr size_t WS_XN = 76 * MiB, WS_Y = 76 * MiB;
constexpr size_t WS_U = 112 * MiB  , WS_V = 130 * MiB, WS_Q = 166 * MiB, WS_KB = 175 * MiB, WS_VB = 184 * MiB, WS_SZB = 202 * MiB, WS_GA = 220 * MiB, WS_GB = 256 * MiB;
constexpr size_t WS_LA = 292 * MiB;
constexpr size_t WS_O = 58 * MiB;
constexpr size_t WS_SLABA = 112 * MiB;
constexpr size_t WS_M = 148 * MiB;
constexpr size_t WS_T = 184 * MiB;
constexpr size_t WS_H = 112 * MiB;
constexpr size_t WS_ES = 312 * MiB;
constexpr size_t WS_END = 316 * MiB;
static_assert(WS_RSTD + (size_t)MT * 4 <= WS_DEC && WS_DEC + 16 * 32 * 128 * 4 <= WS_W1T && WS_W1T + (size_t)N1 * 2048 * 2 <= WS_XN, "ws map");
constexpr int CW_GRP = 8192;
constexpr int CW_PAN = 9216;
constexpr int CW_BAR = 4096;

constexpr int LDS_BYTES = 155648;
constexpr int MISC_OFF = LDS_BYTES - 256;

#define GAS __attribute__((address_space(1)))
#define LAS __attribute__((address_space(3)))
typedef unsigned short bf16;
typedef unsigned v4u __attribute__((ext_vector_type(4)));
typedef unsigned v2u __attribute__((ext_vector_type(2)));
typedef float f32x4 __attribute__((ext_vector_type(4)));
typedef short bf16x8 __attribute__((ext_vector_type(8)));
typedef GAS unsigned gu32;
#define RLX_AGENT __ATOMIC_RELAXED, __HIP_MEMORY_SCOPE_AGENT
__device__ __forceinline__ unsigned pk2(float lo, float hi) { return pg8::cvt_pk_bf16(lo, hi); }
__device__ __forceinline__ unsigned f2bf(float f) { return pg8::cvt_pk_bf16(f, 0.f) & 0xffffu; }
__device__ __forceinline__ float bflo(unsigned w) { return __uint_as_float(w << 16); }
__device__ __forceinline__ float bfhi(unsigned w) { return __uint_as_float(w & 0xffff0000u); }
__device__ __forceinline__ float bf2f(bf16 h) { return __uint_as_float((unsigned)h << 16); }
__device__ __forceinline__ float sigm(float x) { return __builtin_amdgcn_rcpf(1.f + __expf(-x)); }
__device__ __forceinline__ float wave_sum(float v) {
#pragma unroll
    for (int o = 1; o < 64; o <<= 1) v += __shfl_xor(v, o);
    return v;
}

#define XB_TMO      128
#define XB_XCNT(j)  (256  + 64 * (j))
#define XB_XSUB(j)  (1280 + 64 * (j))
#define XB_XGEN(j)  (2304 + 64 * (j))
#define XB_TOP      3328
#define XB_TOPGEN   3392
#define XCD_BAR_WORDS 3456
#define XB_SPIN_CAP (1u << 18)
__device__ __forceinline__ unsigned xb_ld(unsigned* p)              { return __hip_atomic_load(p, __ATOMIC_RELAXED, __HIP_MEMORY_SCOPE_AGENT); }
__device__ __forceinline__ unsigned xb_add(unsigned* p, unsigned v) { return __hip_atomic_fetch_add(p, v, __ATOMIC_RELAXED, __HIP_MEMORY_SCOPE_AGENT); }
__device__ __forceinline__ unsigned xb_xcc_id() { return (unsigned)__builtin_amdgcn_s_getreg((3 << 11) | 20) & 0xFu; }
#define XB_SPIN(cond, bar) do { unsigned _sp = 0; while (cond) { __builtin_amdgcn_s_sleep(1); \
    if ((++_sp & 255u) == 0u) { if (xb_ld(&(bar)[XB_TMO])) break; if (_sp > XB_SPIN_CAP) { atomicAdd(&(bar)[XB_TMO], 1u); break; } } } } while (0)
struct XcdBarrier { unsigned* bar; unsigned x; volatile LAS unsigned* st; };
__device__ __forceinline__ XcdBarrier xcd_barrier_post(unsigned* bar, volatile LAS unsigned* st) {
    XcdBarrier b; b.bar = bar; b.x = xb_xcc_id(); b.st = st;
    if (threadIdx.x == 0) (void)xb_add(&bar[XB_XCNT(b.x)], 1u);
    return b;
}
__device__ __forceinline__ void xcd_barrier_complete(unsigned* bar, unsigned x, unsigned& nloc, unsigned& nx) {
    const unsigned G = gridDim.x * gridDim.y * gridDim.z;
    unsigned sum, cnt, mine, sp = 0u;
    for (;;) {
        sum = 0u; cnt = 0u; mine = 0u;
#pragma unroll
        for (unsigned j = 0; j < 16; ++j) { const unsigned c = xb_ld(&bar[XB_XCNT(j)]); sum += c; cnt += (c > 0u) ? 1u : 0u; mine = (j == x) ? c : mine; }
        if (sum == G) break;
        __builtin_amdgcn_s_sleep(1);
        if ((++sp & 255u) == 0u) { if (xb_ld(&bar[XB_TMO])) break; if (sp > XB_SPIN_CAP) { atomicAdd(&bar[XB_TMO], 1u); break; } }
    }
    nloc = mine > 0u ? mine : 1u; nx = cnt > 0u ? cnt : 1u;
}
__device__ __forceinline__ void xcd_barrier(const XcdBarrier& b) {
    asm volatile("s_waitcnt vmcnt(0)" ::: "memory");
    __syncthreads();
    if (threadIdx.x == 0) {
        unsigned* bar = b.bar;
        __builtin_amdgcn_s_waitcnt(0);
        unsigned nloc = b.st[0], nx = b.st[1];
        if (nloc == 0u) { xcd_barrier_complete(bar, b.x, nloc, nx); b.st[0] = nloc; b.st[1] = nx; }
        const unsigned old = xb_add(&bar[XB_XSUB(b.x)], 1u);
        const unsigned gen = old / nloc;
        if (old + 1u == (gen + 1u) * nloc) {
            __builtin_amdgcn_fence(__ATOMIC_RELEASE, "agent");
            asm volatile("s_waitcnt vmcnt(0)" ::: "memory");
            const unsigned og = xb_add(&bar[XB_TOP], 1u);
            const unsigned tg = og / nx;
            if (og + 1u == (tg + 1u) * nx) xb_add(&bar[XB_TOPGEN], 1u);
            else XB_SPIN(xb_ld(&bar[XB_TOPGEN]) == tg, bar);
            __builtin_amdgcn_fence(__ATOMIC_ACQUIRE, "agent");
            xb_add(&bar[XB_XGEN(b.x)], 1u);
            asm volatile("s_waitcnt vmcnt(0)" ::: "memory");
        } else {
            XB_SPIN(xb_ld(&bar[XB_XGEN(b.x)]) == gen, bar);
            __builtin_amdgcn_fence(__ATOMIC_ACQUIRE, "agent");
            asm volatile("s_waitcnt vmcnt(0)" ::: "memory");
        }
    }
    __syncthreads();
}

struct Frame {
    LAS unsigned char* lds;
    unsigned char* ws;
    int wave, vcu, G;
    const float *xp, *xs, *pp, *ps, *st0, *g_pre, *w_in, *g_v, *w_s, *b_s, *w_a2, *b_a, *g_o, *w_pa, *w_pb, *w_o, *g_post, *w_pg, *w_pe;
    float* out;
};
__device__ __forceinline__ const float* xrow(const Frame& F, int m) { return m < MP ? F.xp + (size_t)m * DM : F.xs + (size_t)(m - MP) * DM; }

struct ConvItem { const float* src; bf16* dst; int spitch, dpitch; };
constexpr int I_IN = 32 * 320, I_PA = 16 * 64, I_PB = 16 * 64, I_O = 32 * 64, I_PG = 32 * 64, I_PE = 4 * 64, NITEMS = I_IN + I_PA + I_PB + I_O + I_PG + I_PE;
__device__ __forceinline__ void conv_item(const Frame& F, int it, ConvItem& d) {
    int r = it;
    if (r < I_IN) { const int kb = r / 320, n0 = (r % 320) * 32;
        const int src = n0 < 2048 ? ((n0 & 128) ? 2048 + 128 * (n0 >> 8) + (n0 & 127) : 128 * (n0 >> 8) + (n0 & 127)) : n0 < 3072 ? n0 - 1024 : n0 + (n0 >= C_ALR ? GR : 0);
        d.src = F.w_in + (size_t)(kb * 64) * NIN + src; d.spitch = NIN; d.dst = (bf16*)(F.ws + WS_W1T) + (size_t)n0 * 2048 + kb * 64; d.dpitch = 2048; return; } r -= I_IN;
    const int k0 = (r / 64) * 64, n0 = (r % 64) * 32; d.spitch = DM; d.dpitch = 2048;
    if (r < I_PA) { d.src = F.w_pa + (size_t)k0 * DM + n0; d.dst = (bf16*)(F.ws + WS_WPAB) + (size_t)n0 * 2048 + k0; return; } r -= I_PA;
    { const int k1 = (r / 64) * 64, n1 = (r % 64) * 32;
      if (r < I_PB) { d.src = F.w_pb + (size_t)k1 * DM + n1; d.dst = (bf16*)(F.ws + WS_WPAB) + (size_t)n1 * 2048 + 1024 + k1; return; } } r -= I_PB;
    { const int k1 = (r / 64) * 64, n1 = (r % 64) * 32;
      if (r < I_O) { d.src = F.w_o + (size_t)k1 * DM + n1; d.dst = (bf16*)(F.ws + WS_WO) + (size_t)n1 * 2048 + k1; return; } } r -= I_O;
    { const int k1 = (r / 64) * 64, n1 = (r % 64) * 32;
      if (r < I_PG) { d.src = F.w_pg + (size_t)k1 * DM + n1; d.dst = (bf16*)(F.ws + WS_WPG) + (size_t)n1 * 2048 + k1; return; } } r -= I_PG;
    { const int k1 = (r / 64) * 64, n1 = (r % 64) * 32; d.src = F.w_pe + (size_t)k1 * DM + n1; d.dst = (bf16*)(F.ws + WS_WPE) + (size_t)n1 * 256 + k1; d.dpitch = 256; }
}
__device__ __forceinline__ void conv_load(const ConvItem& d, f32x4 (&v)[8], int lane) {
    const int r = lane >> 3, c4 = (lane & 7) * 4;
#pragma unroll
    for (int i = 0; i < 8; ++i) v[i] = __builtin_nontemporal_load((const GAS f32x4*)(d.src + (size_t)(8 * i + r) * d.spitch + c4));
}
__device__ __forceinline__ void conv_finish(const ConvItem& d, const f32x4 (&v)[8], LAS float* scr, int lane) {
    const int r = lane >> 3, c4 = (lane & 7) * 4;
#pragma unroll
    for (int i = 0; i < 8; ++i) { LAS float* p = scr + (8 * i + r) * 33 + c4; p[0] = v[i].x; p[1] = v[i].y; p[2] = v[i].z; p[3] = v[i].w; }
    asm volatile("s_waitcnt lgkmcnt(0)" ::: "memory");
    const int c = lane & 7;
#pragma unroll
    for (int j = 0; j < 4; ++j) { const int n = (lane >> 3) + 8 * j; const LAS float* s = scr + (8 * c) * 33 + n;
        v4u o; o.x = pk2(s[0 * 33], s[1 * 33]); o.y = pk2(s[2 * 33], s[3 * 33]); o.z = pk2(s[4 * 33], s[5 * 33]); o.w = pk2(s[6 * 33], s[7 * 33]);
        *(GAS v4u*)(d.dst + (size_t)n * d.dpitch + 8 * c) = o; }
    asm volatile("s_waitcnt lgkmcnt(0)" ::: "memory");
}
__device__ __forceinline__ void p0_prologue(Frame& F) {
    LAS float* scr = (LAS float*)(F.lds + F.wave * 16384);
    const int gw = F.vcu * NWAVES + F.wave, NGW = F.G * NWAVES, ln = (int)(threadIdx.x & 63u);
    bf16* W1T = (bf16*)(F.ws + WS_W1T);
    { f32x4 va[8], vb[8]; ConvItem da, db; int it = gw; bool ha = it < NITEMS;
      if (ha) { conv_item(F, it, da); conv_load(da, va, ln); }
      while (ha) {
          const int it2 = it + NGW; const bool hb = it2 < NITEMS;
          if (hb) { conv_item(F, it2, db); conv_load(db, vb, ln); }
          conv_finish(da, va, scr, ln);
          if (!hb) break;
          it = it2 + NGW; ha = it < NITEMS;
          if (ha) { conv_item(F, it, da); conv_load(da, va, ln); }
          conv_finish(db, vb, scr, ln);
      } }
    {
        const int gt = F.vcu * NTHR + ((int)threadIdx.x), NGT = F.G * NTHR;
        for (int p = gt; p < 512 * 256; p += NGT) { const int ch = p & 511, k0 = (p >> 9) * 8; float wa[16];
#pragma unroll
            for (int r = 0; r < 16; ++r) wa[r] = F.w_a2[r * KBW + ch];
            float t[8];
#pragma unroll
            for (int i = 0; i < 8; ++i) { const GAS f32x4* wr4 = (const GAS f32x4*)(F.w_in + (size_t)(k0 + i) * NIN + C_ALR); float a = 0.f;
#pragma unroll
                for (int r4 = 0; r4 < 4; ++r4) { const f32x4 w = wr4[r4]; a += w.x * wa[4 * r4] + w.y * wa[4 * r4 + 1] + w.z * wa[4 * r4 + 2] + w.w * wa[4 * r4 + 3]; }
                t[i] = a; }
            v4u o; o.x = pk2(t[0], t[1]); o.y = pk2(t[2], t[3]); o.z = pk2(t[4], t[5]); o.w = pk2(t[6], t[7]);
            *(GAS v4u*)(W1T + (size_t)(10240 + ch) * 2048 + k0) = o; }
        bf16* PBF = (bf16*)(F.ws + WS_PBF);
        for (int p = gt; p < MT * PLE / 8; p += NGT) { const size_t e = (size_t)p * 8; const float* src = e < (size_t)MP * PLE ? F.pp + e : F.ps + (e - (size_t)MP * PLE);
            const f32x4 a = __builtin_nontemporal_load((const GAS f32x4*)src), b = __builtin_nontemporal_load((const GAS f32x4*)(src + 4)); v4u o; o.x = pk2(a.x, a.y); o.y = pk2(a.z, a.w); o.z = pk2(b.x, b.y); o.w = pk2(b.z, b.w);
            *(GAS v4u*)(PBF + e) = o; }
    }
    bf16* XN = (bf16*)(F.ws + WS_XN);
    { const GAS f32x4* gr = (const GAS f32x4*)F.g_pre + ln; f32x4 va[8], vb[8]; int m = gw; bool ha = m < MT;
#define XN_LOAD(v, mm) do { const GAS f32x4* xr_ = (const GAS f32x4*)xrow(F, (mm)) + ln; _Pragma("unroll") for (int j_ = 0; j_ < 8; ++j_) v[j_] = __builtin_nontemporal_load(xr_ + 64 * j_); } while (0)
#define XN_FINISH(v, mm) do { float s_ = 0.f; _Pragma("unroll") for (int j_ = 0; j_ < 8; ++j_) s_ += (v[j_].x * v[j_].x + v[j_].y * v[j_].y) + (v[j_].z * v[j_].z + v[j_].w * v[j_].w); \
        const float rstd_ = 1.0f / sqrtf(wave_sum(s_) * (1.f / DM) + EPS); GAS v2u* o8_ = (GAS v2u*)(XN + (size_t)(mm) * DM) + ln; \
        _Pragma("unroll") for (int j_ = 0; j_ < 8; ++j_) { const f32x4 gg_ = gr[64 * j_]; v2u o_; o_.x = pk2(v[j_].x * rstd_ * gg_.x, v[j_].y * rstd_ * gg_.y); o_.y = pk2(v[j_].z * rstd_ * gg_.z, v[j_].w * rstd_ * gg_.w); o8_[64 * j_] = o_; } } while (0)
      if (ha) XN_LOAD(va, m);
      while (ha) {
          const int m2 = m + NGW; const bool hb = m2 < MT;
          if (hb) XN_LOAD(vb, m2);
          XN_FINISH(va, m);
          if (!hb) break;
          m = m2 + NGW; ha = m < MT;
          if (ha) XN_LOAD(va, m);
          XN_FINISH(vb, m2);
      }
#undef XN_LOAD
#undef XN_FINISH
    }
}

using pg8::Unit;
template <int ACT>
__device__ __forceinline__ void g1_store(const pg8::f32x4 (&acc)[2][2][4][2], bf16* base, int ldc, int row0, int col0, float* vss, int wc, int fq) {
#pragma unroll
    for (int ai = 0; ai < 2; ++ai)
#pragma unroll
        for (int m = 0; m < 4; ++m) { const int row = row0 + ai * 128 + m * 16; bf16* rowp = base + (size_t)row * ldc + col0; float ss = 0.f;
#pragma unroll
            for (int bj = 0; bj < 2; ++bj) { float v[8];
#pragma unroll
                for (int e = 0; e < 8; ++e) { float x = acc[ai][bj][m][e >> 2][e & 3];
                    if (ACT == 1) x = x * sigm(x); else if (ACT == 2) x = sigm(x); else if (ACT == 3) x = x * 0.08838834764831845f;
                    if (ACT == 4) ss += x * x; v[e] = x; }
                v4u w; w.x = pg8::cvt_pk_bf16(v[0], v[1]); w.y = pg8::cvt_pk_bf16(v[2], v[3]); w.z = pg8::cvt_pk_bf16(v[4], v[5]); w.w = pg8::cvt_pk_bf16(v[6], v[7]);
                *(GAS v4u*)(rowp + bj * 128) = w; }
            if (ACT == 4) { ss += __shfl_xor(ss, 16); ss += __shfl_xor(ss, 32); if (fq == 0) vss[(size_t)row * 16 + wc] = ss; } }
}
__device__ __forceinline__ float log_sigmoid(float z) { return -(fmaxf(-z, 0.f) + __logf(1.f + __expf(-fabsf(z)))); }
__device__ __forceinline__ unsigned q8(float x) { const unsigned q = (unsigned)__builtin_fmaf(sigm(x), 255.f, 0.5f); return q < 1u ? 1u : q; }
__device__ __forceinline__ void g1_store_u8(const pg8::f32x4 (&acc)[2][2][4][2], unsigned char* base, int row0, int col0) {
#pragma unroll
    for (int ai = 0; ai < 2; ++ai)
#pragma unroll
        for (int m = 0; m < 4; ++m) { unsigned char* rowp = base + (size_t)(row0 + ai * 128 + m * 16) * DM + col0;
#pragma unroll
            for (int bj = 0; bj < 2; ++bj) { const pg8::f32x4 a = acc[ai][bj][m][0], b = acc[ai][bj][m][1]; v2u w;
                w.x = q8(a.x) | (q8(a.y) << 8) | (q8(a.z) << 16) | (q8(a.w) << 24); w.y = q8(b.x) | (q8(b.y) << 8) | (q8(b.z) << 16) | (q8(b.w) << 24);
                *(GAS v2u*)(rowp + bj * 128) = w; } }
}
__device__ __forceinline__ void u8x8_to_f32(v2u w, float (&f)[8]) {
    f[0] = (float)(w.x & 0xffu); f[1] = (float)((w.x >> 8) & 0xffu); f[2] = (float)((w.x >> 16) & 0xffu); f[3] = (float)(w.x >> 24);
    f[4] = (float)(w.y & 0xffu); f[5] = (float)((w.y >> 8) & 0xffu); f[6] = (float)((w.y >> 16) & 0xffu); f[7] = (float)(w.y >> 24);
}
struct EpiG1 {
    static constexpr bool PERM = true, HAS_MID = false;
    unsigned char* ws; const float* b_a;
    __device__ __forceinline__ void operator()(const pg8::f32x4 (&acc)[2][2][4][2], const Unit& u, int wr, int wc, int fr, int fq) const {
        const int pn = u.pn, row0 = u.pm * 256 + wr * 64 + fr, cin = wc * 32 + 8 * fq;
        if (pn < 8) {
            bf16* UZ = (bf16*)(ws + WS_U);
#pragma unroll
            for (int ai = 0; ai < 2; ++ai)
#pragma unroll
                for (int m = 0; m < 4; ++m) { const pg8::f32x4 u0 = acc[ai][0][m][0], u1 = acc[ai][0][m][1], z0 = acc[ai][1][m][0], z1 = acc[ai][1][m][1]; v4u w;
                    w.x = pg8::cvt_pk_bf16(u0.x * z0.x * sigm(z0.x), u0.y * z0.y * sigm(z0.y)); w.y = pg8::cvt_pk_bf16(u0.z * z0.z * sigm(z0.z), u0.w * z0.w * sigm(z0.w));
                    w.z = pg8::cvt_pk_bf16(u1.x * z1.x * sigm(z1.x), u1.y * z1.y * sigm(z1.y)); w.w = pg8::cvt_pk_bf16(u1.z * z1.z * sigm(z1.z), u1.w * z1.w * sigm(z1.w));
                    *(GAS v4u*)(UZ + (size_t)(row0 + ai * 128 + m * 16) * EA + pn * 128 + cin) = w; } }
        else if (pn < 12) g1_store<4>(acc, (bf16*)(ws + WS_V), 1024, row0, (pn - 8) * 256 + cin, (float*)(ws + WS_VSS) + (pn - 8) * 4, wc, fq);
        else if (pn < 14) g1_store<3>(acc, (bf16*)(ws + WS_Q), 512, row0, (pn - 12) * 256 + cin, nullptr, wc, fq);
        else if (pn < 16) g1_store<0>(acc, (bf16*)(ws + WS_KB), 512, row0, (pn - 14) * 256 + cin, nullptr, wc, fq);
        else if (pn < 20) g1_store<0>(acc, (bf16*)(ws + WS_VB), 1024, row0, (pn - 16) * 256 + cin, nullptr, wc, fq);
        else if (pn < 24) g1_store<1>(acc, (bf16*)(ws + WS_SZB), 1024, row0, (pn - 20) * 256 + cin, nullptr, wc, fq);
        else if (pn < 32) g1_store_u8(acc, ws + WS_GA, row0, (pn - 24) * 256 + cin);
        else if (pn < 40) g1_store_u8(acc, ws + WS_GB, row0, (pn - 32) * 256 + cin);
        else {
            float* la = (float*)(ws + WS_LA); const int c0 = (pn - 40) * 256 + cin;
            pg8::f32x4 bb[2][2];
#pragma unroll
            for (int bj = 0; bj < 2; ++bj) { bb[bj][0] = *(const GAS pg8::f32x4*)(b_a + c0 + bj * 128); bb[bj][1] = *(const GAS pg8::f32x4*)(b_a + c0 + bj * 128 + 4); }
#pragma unroll
            for (int ai = 0; ai < 2; ++ai)
#pragma unroll
                for (int m = 0; m < 4; ++m) { float* rp = la + (size_t)(row0 + ai * 128 + m * 16) * KBW + c0;
#pragma unroll
                    for (int bj = 0; bj < 2; ++bj)
#pragma unroll
                        for (int n = 0; n < 2; ++n) { const pg8::f32x4 z = acc[ai][bj][m][n] + bb[bj][n]; pg8::f32x4 o;
                            o.x = log_sigmoid(z.x) * 0.0625f; o.y = log_sigmoid(z.y) * 0.0625f; o.z = log_sigmoid(z.z) * 0.0625f; o.w = log_sigmoid(z.w) * 0.0625f;
                            *(GAS pg8::f32x4*)(rp + bj * 128 + n * 4) = o; } }
        }
    }
};
struct EpiBf {
    static constexpr bool PERM = true, HAS_MID = false;
    bf16* O; int ldc;
    __device__ __forceinline__ void operator()(const pg8::f32x4 (&acc)[2][2][4][2], const Unit& u, int wr, int wc, int fr, int fq) const {
        g1_store<0>(acc, O, ldc, u.pm * 256 + wr * 64 + fr, u.pn * 256 + wc * 32 + 8 * fq, nullptr, wc, fq);
    }
};
template <bool PERM>
__device__ __forceinline__ void slab_store(const pg8::f32x4 (&acc)[2][2][4][2], bf16* lo, bf16* hi, const Unit& u, int wr, int wc, int fr, int fq) {
    const int ks = u.kt0 >> 2; bf16* sl = ks < 4 ? lo + (size_t)ks * MS * DM : hi + (size_t)(ks - 4) * MS * DM;
    const int row0 = (u.pm - 32) * 256 + wr * 64 + fr, col0 = u.pn * 256 + wc * 32 + (PERM ? 8 : 4) * fq;
#pragma unroll
    for (int ai = 0; ai < 2; ++ai)
#pragma unroll
        for (int m = 0; m < 4; ++m) { bf16* rp = sl + (size_t)(row0 + ai * 128 + m * 16) * DM + col0;
#pragma unroll
            for (int bj = 0; bj < 2; ++bj) {
                if (PERM) { const pg8::f32x4 a = acc[ai][bj][m][0], b = acc[ai][bj][m][1]; *(GAS v4u*)(rp + bj * 128) = (v4u){pk2(a.x, a.y), pk2(a.z, a.w), pk2(b.x, b.y), pk2(b.z, b.w)}; }
                else {
#pragma unroll
                    for (int n = 0; n < 2; ++n) { const pg8::f32x4 a = acc[ai][bj][m][n]; *(GAS v2u*)(rp + bj * 128 + n * 16) = (v2u){pk2(a.x, a.y), pk2(a.z, a.w)}; } } } }
}
__device__ __forceinline__ const bf16* slab_ptr(const bf16* lo, const bf16* hi, int ks) { return ks < 4 ? lo + (size_t)ks * MS * DM : hi + (size_t)(ks - 4) * MS * DM; }
__device__ __forceinline__ void slab_sum8(const bf16* lo, const bf16* hi, size_t off, int k0, int k1, pg8::f32x4& s0, pg8::f32x4& s1) {
    s0 = (pg8::f32x4){0.f, 0.f, 0.f, 0.f}; s1 = s0;
#pragma unroll
    for (int ks = 0; ks < 8; ++ks) if (ks >= k0 && ks < k1) { const v4u w = *(const GAS v4u*)(slab_ptr(lo, hi, ks) + off);
        s0.x += bflo(w.x); s0.y += bfhi(w.x); s0.z += bflo(w.y); s0.w += bfhi(w.y); s1.x += bflo(w.z); s1.y += bfhi(w.z); s1.z += bflo(w.w); s1.w += bfhi(w.w); }
}
__device__ __forceinline__ pg8::f32x4 slab_sum4(const bf16* lo, const bf16* hi, size_t off) {
    pg8::f32x4 a = (pg8::f32x4){0.f, 0.f, 0.f, 0.f};
#pragma unroll
    for (int ks = 0; ks < 8; ++ks) { const v2u w = *(const GAS v2u*)(slab_ptr(lo, hi, ks) + off); a.x += bflo(w.x); a.y += bfhi(w.x); a.z += bflo(w.y); a.w += bfhi(w.y); }
    return a;
}
struct EpiG2 {
    static constexpr bool PERM = true, HAS_MID = true;
    const unsigned char* GA; const unsigned char* GB; bf16* Mo; bf16* slo; bf16* shi;
    __device__ __forceinline__ void mid(pg8::f32x4 (&acc)[2][2][4][2], const Unit& u, int wr, int wc, int fr, int fq) const {
        asm volatile("" : "+v"(fr));
        const unsigned off0 = (unsigned)((u.pm * 256 + wr * 64 + fr) * DM + u.pn * 256 + wc * 32 + 8 * fq);
#pragma unroll
        for (int ai = 0; ai < 2; ++ai)
#pragma unroll
            for (int m = 0; m < 4; ++m) { const unsigned off = off0 + (unsigned)((ai * 128 + m * 16) * DM);
#pragma unroll
                for (int bj = 0; bj < 2; ++bj) { const v2u a = *(const GAS v2u*)(GA + off + bj * 128), b = *(const GAS v2u*)(GB + off + bj * 128); float fa[8], fb[8]; u8x8_to_f32(a, fa); u8x8_to_f32(b, fb);
#pragma unroll
                    for (int e = 0; e < 8; ++e) acc[ai][bj][m][e >> 2][e & 3] *= fa[e] * __builtin_amdgcn_rcpf(fb[e]); }
                if (m == 3) asm volatile("" ::: "memory"); }
    }
    __device__ __forceinline__ void operator()(const pg8::f32x4 (&acc)[2][2][4][2], const Unit& u, int wr, int wc, int fr, int fq) const {
        if (u.kind) { slab_store<true>(acc, slo, shi, u, wr, wc, fr, fq); return; }
        const int row0 = u.pm * 256 + wr * 64 + fr, col0 = u.pn * 256 + wc * 32 + 8 * fq;
#pragma unroll
        for (int ai = 0; ai < 2; ++ai)
#pragma unroll
            for (int m = 0; m < 4; ++m) { const size_t off = (size_t)(row0 + ai * 128 + m * 16) * DM + col0;
#pragma unroll
                for (int bj = 0; bj < 2; ++bj) { const v2u b = *(const GAS v2u*)(GB + off + bj * 128); float fb[8]; u8x8_to_f32(b, fb); unsigned w[4];
#pragma unroll
                    for (int p = 0; p < 4; ++p) w[p] = pg8::cvt_pk_bf16(acc[ai][bj][m][p >> 1][(p & 1) * 2] * (fb[2 * p] * (1.f / 255.f)), acc[ai][bj][m][p >> 1][(p & 1) * 2 + 1] * (fb[2 * p + 1] * (1.f / 255.f)));
                    *(GAS v4u*)(Mo + off + bj * 128) = (v4u){w[0], w[1], w[2], w[3]}; }
                if (m & 1) asm volatile("" ::: "memory"); }
    }
};
struct EpiG3 {
    static constexpr bool PERM = true, HAS_MID = false;
    bf16* T; float* tss; bf16* slo; bf16* shi;
    int fused; bf16* H; float* xs; unsigned* cnt; const float* xp; const float* gpost; LAS unsigned char* lx;
    __device__ __forceinline__ void operator()(const pg8::f32x4 (&acc)[2][2][4][2], const Unit& u, int wr, int wc, int fr, int fq) const {
        if (u.kind) { slab_store<true>(acc, slo, shi, u, wr, wc, fr, fq); return; }
        const int row0 = u.pm * 256 + wr * 64 + fr, col0 = u.pn * 256 + wc * 32 + 8 * fq;
        if (!fused) {
#pragma unroll
            for (int ai = 0; ai < 2; ++ai)
#pragma unroll
                for (int m = 0; m < 4; ++m) { const int row = row0 + ai * 128 + m * 16; bf16* rowp = T + (size_t)row * DM + col0; float ss = 0.f;
#pragma unroll
                    for (int bj = 0; bj < 2; ++bj) { const pg8::f32x4 a = acc[ai][bj][m][0], b = acc[ai][bj][m][1];
                        ss += (a.x * a.x + a.y * a.y) + (a.z * a.z + a.w * a.w) + (b.x * b.x + b.y * b.y) + (b.z * b.z + b.w * b.w);
                        v4u w; w.x = pg8::cvt_pk_bf16(a.x, a.y); w.y = pg8::cvt_pk_bf16(a.z, a.w); w.z = pg8::cvt_pk_bf16(b.x, b.y); w.w = pg8::cvt_pk_bf16(b.z, b.w);
                        *(GAS v4u*)(rowp + bj * 128) = w; }
                    ss += __shfl_xor(ss, 16); ss += __shfl_xor(ss, 32); if (fq == 0) tss[(size_t)row * 32 + u.pn * 4 + wc] = ss; }
            return;
        }
        LAS float* P = (LAS float*)lx; LAS float* S = P + 1024; volatile LAS unsigned* flag = (volatile LAS unsigned*)(S + 256);
        const int tid = threadIdx.x, lane = tid & 63, wid = __builtin_amdgcn_readfirstlane(tid >> 6);
#pragma unroll
        for (int ai = 0; ai < 2; ++ai)
#pragma unroll
            for (int m = 0; m < 4; ++m) { float ss = 0.f;
#pragma unroll
                for (int bj = 0; bj < 2; ++bj) { const pg8::f32x4 a = acc[ai][bj][m][0], b = acc[ai][bj][m][1]; ss += (a.x * a.x + a.y * a.y) + (a.z * a.z + a.w * a.w) + (b.x * b.x + b.y * b.y) + (b.z * b.z + b.w * b.w); }
                ss += __shfl_xor(ss, 16); ss += __shfl_xor(ss, 32); if (fq == 0) P[(ai * 128 + wr * 64 + m * 16 + fr) * 4 + wc] = ss; }
        asm volatile("s_waitcnt lgkmcnt(0)" ::: "memory"); __builtin_amdgcn_s_barrier(); asm volatile("" ::: "memory");
        if (tid < 256) { const pg8::f32x4 p = *(const LAS pg8::f32x4*)(P + tid * 4);
            __hip_atomic_store(xs + (size_t)(u.pm * 256 + tid) * 8 + u.pn, (p.x + p.y) + (p.z + p.w), __ATOMIC_RELAXED, __HIP_MEMORY_SCOPE_AGENT); }
        asm volatile("s_waitcnt vmcnt(0)" ::: "memory");
        if (tid < 256 && lane == 0) (void)__hip_atomic_fetch_add(cnt + 64 * u.pm, 1u, __ATOMIC_RELAXED, __HIP_MEMORY_SCOPE_AGENT);
        if (wid == 0) { unsigned sp = 0;
            while ((unsigned)__builtin_amdgcn_readfirstlane(__hip_atomic_load(cnt + 64 * u.pm, __ATOMIC_RELAXED, __HIP_MEMORY_SCOPE_AGENT)) < 32u) { __builtin_amdgcn_s_sleep(2); if (++sp > (1u << 20)) break; }
            __builtin_amdgcn_fence(__ATOMIC_ACQUIRE, "agent"); asm volatile("s_waitcnt vmcnt(0)" ::: "memory"); if (lane == 0) flag[0] = 1u; }
        asm volatile("s_waitcnt lgkmcnt(0)" ::: "memory"); __builtin_amdgcn_s_barrier(); asm volatile("" ::: "memory");
        if (tid < 256) { const float* sl = xs + (size_t)(u.pm * 256 + tid) * 8; float t = 0.f;
#pragma unroll
            for (int q = 0; q < 8; ++q) t += __hip_atomic_load(sl + q, __ATOMIC_RELAXED, __HIP_MEMORY_SCOPE_AGENT);
            S[tid] = 1.0f / sqrtf(t * (1.f / DM) + EPS); }
        asm volatile("s_waitcnt lgkmcnt(0)" ::: "memory"); __builtin_amdgcn_s_barrier(); asm volatile("" ::: "memory");
        pg8::f32x4 gp[2][2];
#pragma unroll
        for (int bj = 0; bj < 2; ++bj) { gp[bj][0] = *(const GAS pg8::f32x4*)(gpost + col0 + bj * 128); gp[bj][1] = *(const GAS pg8::f32x4*)(gpost + col0 + bj * 128 + 4); }
#pragma unroll
        for (int ai = 0; ai < 2; ++ai)
#pragma unroll
            for (int m = 0; m < 4; ++m) { const int rl = ai * 128 + wr * 64 + m * 16 + fr; const float rs = S[rl]; const size_t off = (size_t)(u.pm * 256 + rl) * DM + col0;
#pragma unroll
                for (int bj = 0; bj < 2; ++bj) { const pg8::f32x4 x0 = *(const GAS pg8::f32x4*)(xp + off + bj * 128), x1 = *(const GAS pg8::f32x4*)(xp + off + bj * 128 + 4); const pg8::f32x4 a = acc[ai][bj][m][0], b = acc[ai][bj][m][1], g0 = gp[bj][0], g1 = gp[bj][1];
                    v4u w; w.x = pg8::cvt_pk_bf16(x0.x + a.x * rs * g0.x, x0.y + a.y * rs * g0.y); w.y = pg8::cvt_pk_bf16(x0.z + a.z * rs * g0.z, x0.w + a.w * rs * g0.w);
                    w.z = pg8::cvt_pk_bf16(x1.x + b.x * rs * g1.x, x1.y + b.y * rs * g1.y); w.w = pg8::cvt_pk_bf16(x1.z + b.z * rs * g1.z, x1.w + b.w * rs * g1.w);
                    *(GAS v4u*)(H + off + bj * 128) = w; }
                if (m & 1) asm volatile("" ::: "memory"); }
    }
};
struct EpiG4 {
    static constexpr bool PERM = true, HAS_MID = false;
    const bf16 *H, *E; float* out; bf16* slo; bf16* shi;
    __device__ __forceinline__ void operator()(const pg8::f32x4 (&acc)[2][2][4][2], const Unit& u, int wr, int wc, int fr, int fq) const {
        if (u.kind) { slab_store<true>(acc, slo, shi, u, wr, wc, fr, fq); return; }
        const int row0 = u.pm * 256 + wr * 64 + fr, col0 = u.pn * 256 + wc * 32 + 8 * fq;
#pragma unroll
        for (int ai = 0; ai < 2; ++ai)
#pragma unroll
            for (int m = 0; m < 4; ++m) {
#pragma unroll
                for (int bj = 0; bj < 2; ++bj) { const size_t o2 = (size_t)(row0 + ai * 128 + m * 16) * DM + col0 + bj * 128; const v4u h4 = *(const GAS v4u*)(H + o2), e4 = *(const GAS v4u*)(E + o2);
                    const pg8::f32x4 a = acc[ai][bj][m][0], b = acc[ai][bj][m][1];
                    pg8::f32x4 o0, o1; o0.x = bflo(h4.x) + sigm(a.x) * bflo(e4.x); o0.y = bfhi(h4.x) + sigm(a.y) * bfhi(e4.x); o0.z = bflo(h4.y) + sigm(a.z) * bflo(e4.y); o0.w = bfhi(h4.y) + sigm(a.w) * bfhi(e4.y);
                    o1.x = bflo(h4.z) + sigm(b.x) * bflo(e4.z); o1.y = bfhi(h4.z) + sigm(b.y) * bfhi(e4.z); o1.z = bflo(h4.w) + sigm(b.z) * bflo(e4.w); o1.w = bfhi(h4.w) + sigm(b.w) * bfhi(e4.w);
                    *(GAS pg8::f32x4*)(out + o2) = o0; *(GAS pg8::f32x4*)(out + o2 + 4) = o1; }
                asm volatile("" ::: "memory"); }
    }
};

constexpr int GWP = 136, GVP = 68;
__device__ __forceinline__ void gate_prompt_unit(Frame& F, int unit) {
    int tid = ((int)threadIdx.x); asm volatile("" : "+v"(tid));
    const int g = unit & 3, c = (unit >> 2) & 15, b = unit >> 6, r0 = b * SEQ + c * CH, lane = tid & 63, wave = F.wave, fr = lane & 15, fq = lane >> 4;
    LAS bf16* WL = (LAS bf16*)F.lds;
    LAS unsigned* VT = (LAS unsigned*)(F.lds + 128 * GWP * 2);
    LAS float* RS = (LAS float*)(F.lds + 128 * GWP * 2 + 256 * GVP * 4);
    const bf16* U = (const bf16*)(F.ws + WS_U); const bf16* V = (const bf16*)(F.ws + WS_V); const float* VSS = (const float*)(F.ws + WS_VSS);
    bf16* Y = (bf16*)(F.ws + WS_Y);
    __syncthreads();
    if (tid < 128) { const GAS f32x4* p = (const GAS f32x4*)(VSS + (size_t)(r0 + tid) * 16); const f32x4 a = p[0], b4 = p[1], c4 = p[2], d4 = p[3];
        const float ss = ((a.x + a.y) + (a.z + a.w)) + ((b4.x + b4.y) + (b4.z + b4.w)) + ((c4.x + c4.y) + (c4.z + c4.w)) + ((d4.x + d4.y) + (d4.z + d4.w));
        RS[tid] = 1.0f / sqrtf(ss * (1.f / EA) + EPS); }
    { const float* W = F.w_s + (size_t)g * CH * CH;
#pragma unroll
      for (int i = 0; i < 4; ++i) { const int p = tid + NTHR * i, t = p >> 4, s8 = (p & 15) * 8; const f32x4 w0 = *(const GAS f32x4*)(W + t * CH + s8), w1 = *(const GAS f32x4*)(W + t * CH + s8 + 4); v4u o;
          o.x = pk2(s8 <= t ? w0.x : 0.f, s8 + 1 <= t ? w0.y : 0.f); o.y = pk2(s8 + 2 <= t ? w0.z : 0.f, s8 + 3 <= t ? w0.w : 0.f);
          o.z = pk2(s8 + 4 <= t ? w1.x : 0.f, s8 + 5 <= t ? w1.y : 0.f); o.w = pk2(s8 + 6 <= t ? w1.z : 0.f, s8 + 7 <= t ? w1.w : 0.f);
          *(LAS v4u*)(WL + t * GWP + s8) = o; } }
    __syncthreads();
#pragma unroll
    for (int i = 0; i < 4; ++i) { const int idx = tid + NTHR * i, cg = ((idx >> 5) & 3) * 8 + (idx & 7), sp = (idx >> 7) * 4 + ((idx >> 3) & 3), s0 = 2 * sp;
        const v4u ra = *(const GAS v4u*)(V + (size_t)(r0 + s0) * EA + g * DV + 8 * cg), rb = *(const GAS v4u*)(V + (size_t)(r0 + s0 + 1) * EA + g * DV + 8 * cg);
        const GAS f32x4* gv = (const GAS f32x4*)(F.g_v + g * DV + 8 * cg); const f32x4 g0 = gv[0], g1 = gv[1]; const float ra_s = RS[s0], rb_s = RS[s0 + 1];
        const float gg[8] = {g0.x, g0.y, g0.z, g0.w, g1.x, g1.y, g1.z, g1.w}; const unsigned wa[4] = {ra.x, ra.y, ra.z, ra.w}, wb[4] = {rb.x, rb.y, rb.z, rb.w};
        LAS unsigned* dst = VT + (8 * cg) * GVP + (sp ^ (4 * (cg & 7)));
#pragma unroll
        for (int e = 0; e < 4; ++e) { dst[(2 * e) * GVP] = pk2(bflo(wa[e]) * ra_s * gg[2 * e], bflo(wb[e]) * rb_s * gg[2 * e]); dst[(2 * e + 1) * GVP] = pk2(bfhi(wa[e]) * ra_s * gg[2 * e + 1], bfhi(wb[e]) * rb_s * gg[2 * e + 1]); } }
    __syncthreads();
    pg8::f32x4 acc[16];
#pragma unroll
    for (int q = 0; q < 16; ++q) acc[q] = (pg8::f32x4){0.f, 0.f, 0.f, 0.f};
    const int nkk = (wave >> 1) + 1;
    for (int kk = 0; kk < nkk; ++kk) { const bf16x8 bw = *(const LAS bf16x8*)(WL + (16 * wave + fr) * GWP + 32 * kk + 8 * fq);
#pragma unroll
        for (int q = 0; q < 16; ++q) { const int d = 64 * (q >> 2) + 16 * (fr >> 2) + 4 * (q & 3) + (fr & 3);
            const bf16x8 af = *(const LAS bf16x8*)(VT + d * GVP + ((16 * kk + 4 * fq) ^ (4 * ((d >> 3) & 7))));
            acc[q] = __builtin_amdgcn_mfma_f32_16x16x32_bf16(af, bw, acc[q], 0, 0, 0); } }
    { const int t = 16 * wave + fr; const float bs = F.b_s[g * CH + t];
#pragma unroll
      for (int G4 = 0; G4 < 4; ++G4) { const size_t o1 = (size_t)(r0 + t) * EA + g * DV + 64 * G4 + 16 * fq; const v4u u0 = *(const GAS v4u*)(U + o1), u1 = *(const GAS v4u*)(U + o1 + 8);
          const unsigned uw[8] = {u0.x, u0.y, u0.z, u0.w, u1.x, u1.y, u1.z, u1.w}; unsigned yw[8];
#pragma unroll
          for (int n = 0; n < 4; ++n) { const pg8::f32x4 sv = acc[G4 * 4 + n];
              yw[2 * n] = pk2(bflo(uw[2 * n]) * (sv.x + bs), bfhi(uw[2 * n]) * (sv.y + bs));
              yw[2 * n + 1] = pk2(bflo(uw[2 * n + 1]) * (sv.z + bs), bfhi(uw[2 * n + 1]) * (sv.w + bs)); }
          bf16* yp = Y + (size_t)(r0 + t) * DM + g * DV + 64 * G4 + 16 * fq;
          *(GAS v4u*)yp = (v4u){yw[0], yw[1], yw[2], yw[3]}; *(GAS v4u*)(yp + 8) = (v4u){yw[4], yw[5], yw[6], yw[7]}; } }
}

__device__ __forceinline__ void sample_unit(Frame& F, int unit) {
    int tid = ((int)threadIdx.x); asm volatile("" : "+v"(tid));
    const int h = unit & 3, sb = unit >> 2, r0 = MP + sb * DSEQ, lane = tid & 63, wave = F.wave;
    LAS float* L = (LAS float*)F.lds;
    LAS float* QT = L; LAS float* KT = L + 1024; LAS float* KD = L + 2048; LAS float* DC = L + 3072; LAS float* ATT = L + 3200; LAS float* RS = L + 3264; LAS float* QS = L + 3400; LAS float* RED = L + 4608;
    const bf16* Vb = (const bf16*)(F.ws + WS_V); const bf16* U = (const bf16*)(F.ws + WS_U); const float* VSS = (const float*)(F.ws + WS_VSS);
    const bf16* Q = (const bf16*)(F.ws + WS_Q); const bf16* KBp = (const bf16*)(F.ws + WS_KB); const bf16* VB = (const bf16*)(F.ws + WS_VB); const bf16* SZB = (const bf16*)(F.ws + WS_SZB);
    const float* LAg = (const float*)(F.ws + WS_LA); bf16* Y = (bf16*)(F.ws + WS_Y);
    const int d = tid & 255, th = tid >> 8, col = h * DV + d, v4 = lane, dg = wave, chp = h * DK + (tid & 127);
    f32x4 ssv[4]; float bsv = 0.f; if (tid < 8) { const GAS f32x4* p = (const GAS f32x4*)(VSS + (size_t)(r0 + tid) * 16); ssv[0] = p[0]; ssv[1] = p[1]; ssv[2] = p[2]; ssv[3] = p[3]; bsv = F.b_s[h * CH + tid]; }
    float wsv = 0.f; if (tid < 64) wsv = F.w_s[(size_t)h * CH * CH + (tid >> 3) * CH + (tid & 7)];
    bf16 vraw[8], uraw[4];
#pragma unroll
    for (int s2 = 0; s2 < 8; ++s2) vraw[s2] = Vb[(size_t)(r0 + s2) * EA + col];
#pragma unroll
    for (int i = 0; i < 4; ++i) uraw[i] = U[(size_t)(r0 + th * 4 + i) * EA + col];
    const float gv = F.g_v[col];
    float laraw[8]; bf16 qraw[8], kraw[8];
    if (tid < 128) {
#pragma unroll
        for (int t = 0; t < 8; ++t) { laraw[t] = LAg[(size_t)(r0 + t) * KBW + chp]; qraw[t] = Q[(size_t)(r0 + t) * KBW + chp]; kraw[t] = KBp[(size_t)(r0 + t) * KBW + chp]; } }
    v2u vvraw[8];
#pragma unroll
    for (int s2 = 0; s2 < 8; ++s2) vvraw[s2] = *(const GAS v2u*)(VB + (size_t)(r0 + s2) * EB + h * DV + 4 * v4);
    const v2u zz = *(const GAS v2u*)(SZB + (size_t)(r0 + wave) * EB + h * DV + 4 * v4); const f32x4 go = *(const GAS f32x4*)(F.g_o + h * DV + 4 * v4);
    const float* S0 = F.st0 + ((size_t)(sb * HB + h) * DK) * DV; float* SN = F.out + OUT_SS + ((size_t)(sb * HB + h) * DK) * DV;
    f32x4 s0r[16];
#pragma unroll
    for (int dd = 0; dd < 16; ++dd) s0r[dd] = __builtin_nontemporal_load((const GAS f32x4*)(S0 + (size_t)(dg * 16 + dd) * DV + 4 * v4));
    __syncthreads();
    if (tid < 8) { const f32x4 a = ssv[0], b4 = ssv[1], c4 = ssv[2], d4 = ssv[3];
        const float ss = ((a.x + a.y) + (a.z + a.w)) + ((b4.x + b4.y) + (b4.z + b4.w)) + ((c4.x + c4.y) + (c4.z + c4.w)) + ((d4.x + d4.y) + (d4.z + d4.w));
        RS[tid] = 1.0f / sqrtf(ss * (1.f / EA) + EPS); RS[8 + tid] = bsv; }
    if (tid < 64) RS[16 + tid] = wsv;
    __syncthreads();
    {
        float vn[8];
#pragma unroll
        for (int s2 = 0; s2 < 8; ++s2) vn[s2] = bf2f(vraw[s2]) * RS[s2] * gv;
#pragma unroll
        for (int i = 0; i < 4; ++i) { const int t = th * 4 + i; float S = RS[8 + t];
#pragma unroll
            for (int s2 = 0; s2 < 8; ++s2) if (s2 <= t) S += RS[16 + t * 8 + s2] * vn[s2];
            Y[(size_t)(r0 + t) * DM + col] = (bf16)f2bf(bf2f(uraw[i]) * S);
            float vt = 0.f;
#pragma unroll
            for (int s2 = 0; s2 < 8; ++s2) vt = (s2 == t) ? vn[s2] : vt;
            F.out[OUT_CV + (size_t)(sb * DSEQ + t) * EA + col] = vt; }
    }
    if (tid < 128) { const int dq = tid; float bc[8]; float run = 0.f;
#pragma unroll
        for (int t = 0; t < 8; ++t) { run += laraw[t]; bc[t] = run; }
        const float dcv = __expf(run); DC[dq] = dcv;
#pragma unroll
        for (int t = 0; t < 8; ++t) { const float q = bf2f(qraw[t]), k = bf2f(kraw[t]);
            const float eb = __expf(bc[t]), ek = __builtin_amdgcn_rcpf(eb); const float qt = q * eb, kt = k * ek; QT[dq * 8 + t] = qt; QS[t * 128 + dq] = qt; KT[t * 128 + dq] = kt; KD[dq * 8 + t] = kt * dcv; }
    }
    __syncthreads();
    { const int p = tid >> 3, part = tid & 7, t = p >> 3, s2 = p & 7; float a = 0.f;
      if (s2 <= t) {
#pragma unroll
          for (int dd = 0; dd < 16; ++dd) a += QS[t * 128 + part * 16 + dd] * KT[s2 * 128 + part * 16 + dd]; }
      a += __shfl_xor(a, 1); a += __shfl_xor(a, 2); a += __shfl_xor(a, 4);
      if (part == 0) ATT[p] = a; }
    f32x4 vv[8];
#pragma unroll
    for (int s2 = 0; s2 < 8; ++s2) vv[s2] = (f32x4){bflo(vvraw[s2].x), bfhi(vvraw[s2].x), bflo(vvraw[s2].y), bfhi(vvraw[s2].y)};
    f32x4 oacc[8];
#pragma unroll
    for (int t = 0; t < 8; ++t) oacc[t] = (f32x4){0.f, 0.f, 0.f, 0.f};
#pragma unroll
    for (int dd = 0; dd < 16; ++dd) { const int dr = dg * 16 + dd; const f32x4 s0 = s0r[dd];
        const f32x4 q0 = *(const LAS f32x4*)(QT + dr * 8), q1 = *(const LAS f32x4*)(QT + dr * 8 + 4), k0 = *(const LAS f32x4*)(KD + dr * 8), k1 = *(const LAS f32x4*)(KD + dr * 8 + 4);
        oacc[0] += q0.x * s0; oacc[1] += q0.y * s0; oacc[2] += q0.z * s0; oacc[3] += q0.w * s0; oacc[4] += q1.x * s0; oacc[5] += q1.y * s0; oacc[6] += q1.z * s0; oacc[7] += q1.w * s0;
        f32x4 sn = DC[dr] * s0; sn += k0.x * vv[0]; sn += k0.y * vv[1]; sn += k0.z * vv[2]; sn += k0.w * vv[3]; sn += k1.x * vv[4]; sn += k1.y * vv[5]; sn += k1.z * vv[6]; sn += k1.w * vv[7];
        __builtin_nontemporal_store(sn, (GAS f32x4*)(SN + (size_t)dr * DV + 4 * v4)); }
#pragma unroll
    for (int t = 0; t < 8; ++t) *(LAS f32x4*)(RED + (dg * 8 + t) * 256 + 4 * v4) = oacc[t];
    __syncthreads();
    { const int t = wave; f32x4 o = (f32x4){0.f, 0.f, 0.f, 0.f};
#pragma unroll
      for (int g2 = 0; g2 < 8; ++g2) o += *(const LAS f32x4*)(RED + (g2 * 8 + t) * 256 + 4 * v4);
#pragma unroll
      for (int s2 = 0; s2 < 8; ++s2) o += ATT[t * 8 + s2] * vv[s2];
      const float ss = wave_sum((o.x * o.x + o.y * o.y) + (o.z * o.z + o.w * o.w)); const float rs = 1.0f / sqrtf(ss * (1.f / DV) + EPS);
      v2u w; w.x = pk2(o.x * rs * go.x * bflo(zz.x), o.y * rs * go.y * bfhi(zz.x)); w.y = pk2(o.z * rs * go.z * bflo(zz.y), o.w * rs * go.w * bfhi(zz.y));
      *(GAS v2u*)(Y + (size_t)(r0 + t) * DM + EA + h * DV + 4 * v4) = w; }
}

constexpr int PRP = 264, PRT = 68;
__device__ __forceinline__ void prep_unit(Frame& F, int unit) {
    int tid = ((int)threadIdx.x); asm volatile("" : "+v"(tid));
    const int hp = unit & 1, cc = (unit >> 1) & 31, b = unit >> 6, r0 = b * SEQ + cc * GC, ch = tid & 255, th = tid >> 8, c0 = hp * 256;
    LAS bf16* QL = (LAS bf16*)F.lds;
    LAS bf16* KL = QL + 64 * PRP;
    LAS bf16* KTL = KL + 64 * PRP;
    LAS float* TOT = (LAS float*)(KTL + 256 * PRT);
    const float* LAg = (const float*)(F.ws + WS_LA); const bf16* Q = (const bf16*)(F.ws + WS_Q); const bf16* KBp = (const bf16*)(F.ws + WS_KB);
    bf16* QTg = (bf16*)(F.ws + WS_QT); bf16* KTT = (bf16*)(F.ws + WS_KTT); float* DEC = (float*)(F.ws + WS_DEC);
    __syncthreads();
    float bl[32]; float run = 0.f;
#pragma unroll
    for (int i2 = 0; i2 < 32; ++i2) { run += LAg[(size_t)(r0 + 32 * th + i2) * KBW + c0 + ch]; bl[i2] = run; }
    TOT[th * 256 + ch] = run;
    __syncthreads();
    const float t0 = TOT[ch], t1 = TOT[256 + ch], off = th ? t0 : 0.f;
    if (th == 0) DEC[((size_t)(b * HB + 2 * hp + (ch >> 7)) * NCH + cc) * DK + (ch & 127)] = __expf(t0 + t1);
#pragma unroll
    for (int i2 = 0; i2 < 32; ++i2) { const int t = 32 * th + i2; const float eb = __expf(bl[i2] + off), ek = __builtin_amdgcn_rcpf(eb);
        const float q = bf2f(Q[(size_t)(r0 + t) * KBW + c0 + ch]), k = bf2f(KBp[(size_t)(r0 + t) * KBW + c0 + ch]);
        const bf16 kb = (bf16)f2bf(k * ek); QL[t * PRP + ch] = (bf16)f2bf(q * eb); KL[t * PRP + ch] = kb; KTL[ch * PRT + t] = kb; }
    __syncthreads();
#pragma unroll
    for (int i2 = 0; i2 < 4; ++i2) { const int p = tid + NTHR * i2, t = p >> 5, c8 = (p & 31) * 8; const size_t o = ((size_t)(b * HB + 2 * hp + (c8 >> 7)) * SEQ + cc * GC + t) * DK + (c8 & 127);
        *(GAS v4u*)(QTg + o) = *(const LAS v4u*)(QL + t * PRP + c8); }
    { const int lane = tid & 63, fr = lane & 15, fq = lane >> 4, hl = F.wave >> 2, ti = F.wave & 3; bf16* ATg = (bf16*)(F.ws + WS_ATT) + ((size_t)(b * HB + 2 * hp + hl) * NCH + cc) * GC * GC;
      bf16x8 qf[4];
#pragma unroll
      for (int kk = 0; kk < 4; ++kk) qf[kk] = *(const LAS bf16x8*)(QL + (16 * ti + fr) * PRP + hl * 128 + 32 * kk + 8 * fq);
#pragma unroll
      for (int si = 0; si < 4; ++si) { pg8::f32x4 a = (pg8::f32x4){0.f, 0.f, 0.f, 0.f};
          if (si <= ti) {
#pragma unroll
              for (int kk = 0; kk < 4; ++kk) a = __builtin_amdgcn_mfma_f32_16x16x32_bf16(*(const LAS bf16x8*)(KL + (16 * si + fr) * PRP + hl * 128 + 32 * kk + 8 * fq), qf[kk], a, 0, 0, 0); }
          const int t = 16 * ti + fr, s0 = 16 * si + 4 * fq; v2u w;
          w.x = pk2(s0 <= t ? a.x : 0.f, s0 + 1 <= t ? a.y : 0.f); w.y = pk2(s0 + 2 <= t ? a.z : 0.f, s0 + 3 <= t ? a.w : 0.f);
          *(GAS v2u*)(ATg + t * GC + s0) = w; } }
#pragma unroll
    for (int i2 = 0; i2 < 4; ++i2) { const int p = tid + NTHR * i2, chh = p >> 3, t8 = (p & 7) * 8; const v2u a = *(const LAS v2u*)(KTL + chh * PRT + t8), c2 = *(const LAS v2u*)(KTL + chh * PRT + t8 + 4);
        *(GAS v4u*)(KTT + (((size_t)(b * HB + 2 * hp + (chh >> 7)) * NCH + cc) * DK + (chh & 127)) * GC + t8) = (v4u){a.x, a.y, c2.x, c2.y}; }
}

constexpr int PQ = 136, PS64 = 72;
__device__ __forceinline__ bf16x8 ldfrag(const LAS bf16* base, int row, int pitch, int k0) { return *(const LAS bf16x8*)(base + row * pitch + k0); }
struct GlaStage { v4u q[2], kt[2], at, v; float dec; };
template <int NVT>
__device__ __forceinline__ void gla_unit(Frame& F, int unit, bool fuse_norm) {
    constexpr int SW = 16 * NVT, NSL = DV / SW, VPR = SW / 8  ;
    int tid = ((int)threadIdx.x); asm volatile("" : "+v"(tid));
    const int bh = unit / NSL, j = unit % NSL, b = bh >> 2, h = bh & 3, lane = tid & 63, wave = F.wave, fr = lane & 15, fq = lane >> 4;
    constexpr int SET_E = 64 * PQ + 128 * PS64 + SW * PS64 + 64 * PS64 + 256;
    LAS bf16* L0 = (LAS bf16*)F.lds; LAS bf16* STL = L0 + 2 * SET_E;
    const bf16* QTg = (const bf16*)(F.ws + WS_QT) + (size_t)bh * SEQ * DK; const bf16* ATg = (const bf16*)(F.ws + WS_ATT) + (size_t)bh * NCH * GC * GC;
    const bf16* KTT = (const bf16*)(F.ws + WS_KTT) + (size_t)bh * NCH * DK * GC; const float* DEC = (const float*)(F.ws + WS_DEC) + (size_t)bh * NCH * DK;
    const bf16* VB = (const bf16*)(F.ws + WS_VB) + (size_t)(b * SEQ) * EB + h * DV + j * SW; bf16* O = (bf16*)(F.ws + WS_O) + (size_t)(b * SEQ) * EB + h * DV + j * SW;
    __syncthreads();
    for (int i = tid; i < 2 * SW * PQ / 2; i += NTHR) ((LAS unsigned*)STL)[i] = 0u;
#define GLA_LD16(dst, ptr) asm volatile("global_load_dwordx4 %0, %1, off" : "=v"(dst) : "v"(ptr) : "memory")
#define GLA_FETCH(R, c) do { const int c_ = (c) < NCH ? (c) : NCH - 1; \
        GLA_LD16(R.q[0], QTg + (size_t)c_ * GC * DK + tid * 8); GLA_LD16(R.q[1], QTg + (size_t)c_ * GC * DK + (tid + NTHR) * 8); \
        GLA_LD16(R.kt[0], KTT + (size_t)c_ * DK * GC + tid * 8); GLA_LD16(R.kt[1], KTT + (size_t)c_ * DK * GC + (tid + NTHR) * 8); \
        GLA_LD16(R.at, ATg + (size_t)c_ * GC * GC + tid * 8); \
        { const int tv_ = tid % (64 * VPR), s_ = tv_ / VPR, hf_ = tv_ % VPR; GLA_LD16(R.v, VB + (size_t)(c_ * GC + s_) * EB + hf_ * 8); } \
        asm volatile("global_load_dword %0, %1, off" : "=v"(R.dec) : "v"(DEC + c_ * DK + (tid & 127)) : "memory"); } while (0)
#define GLA_WAIT(R, n) asm volatile("s_waitcnt vmcnt(" #n ")" : "+v"(R.q[0]), "+v"(R.q[1]), "+v"(R.kt[0]), "+v"(R.kt[1]), "+v"(R.at), "+v"(R.v), "+v"(R.dec) :: "memory")
#define GLA_COMMIT(R, set) do { LAS bf16* QL_ = L0 + (set) * SET_E; LAS bf16* KTL_ = QL_ + 64 * PQ; LAS bf16* VTL_ = KTL_ + 128 * PS64; LAS bf16* ATL_ = VTL_ + SW * PS64; LAS float* DCL_ = (LAS float*)(ATL_ + 64 * PS64); \
        _Pragma("unroll") for (int i_ = 0; i_ < 2; ++i_) { const int p_ = tid + NTHR * i_; { const int r_ = p_ >> 4, cch_ = p_ & 15; *(LAS v4u*)(QL_ + r_ * PQ + cch_ * 8) = R.q[i_]; } \
            { const int r_ = p_ >> 3, cch_ = p_ & 7; *(LAS v4u*)(KTL_ + r_ * PS64 + cch_ * 8) = R.kt[i_]; } } \
        { const int r_ = tid >> 3, cch_ = tid & 7; *(LAS v4u*)(ATL_ + r_ * PS64 + cch_ * 8) = R.at; } \
        if (tid < 64 * VPR) { const int s_ = tid / VPR, hf_ = tid % VPR; const unsigned w_[4] = {R.v.x, R.v.y, R.v.z, R.v.w}; \
            _Pragma("unroll") for (int e_ = 0; e_ < 4; ++e_) { VTL_[(hf_ * 8 + 2 * e_) * PS64 + s_] = (bf16)(w_[e_] & 0xffffu); VTL_[(hf_ * 8 + 2 * e_ + 1) * PS64 + s_] = (bf16)(w_[e_] >> 16); } } \
        if (tid < 128) DCL_[tid] = R.dec; } while (0)
    pg8::f32x4 sacc[2][NVT];
#pragma unroll
    for (int e = 0; e < 2; ++e)
#pragma unroll
        for (int vt = 0; vt < NVT; ++vt) sacc[e][vt] = (pg8::f32x4){0.f, 0.f, 0.f, 0.f};
    GlaStage ra, rb, rc;
    GLA_FETCH(ra, 0); GLA_WAIT(ra, 0); GLA_COMMIT(ra, 0); GLA_FETCH(ra, 1); GLA_FETCH(rb, 2); GLA_FETCH(rc, 3);
    __syncthreads();
#define GLA_STEP(R, cc) { const int c = (cc); GLA_WAIT(R, 14); if (c + 1 < NCH) GLA_COMMIT(R, (c + 1) & 1); GLA_FETCH(R, c + 4);
    for (int c3 = 0; c3 < NCH; c3 += 3) {
        GLA_STEP(ra, c3)
        const LAS bf16* QL = L0 + (c & 1) * SET_E; const LAS bf16* KTL = QL + 64 * PQ; const LAS bf16* VTL = KTL + 128 * PS64; const LAS bf16* ATL = VTL + SW * PS64; const LAS float* DCL = (const LAS float*)(ATL + 64 * PS64);
        const LAS bf16* STc = STL + (c & 1) * SW * PQ; LAS bf16* STn = STL + ((c + 1) & 1) * SW * PQ;
        if (wave < 4) {
            const int ti = wave; pg8::f32x4 o[NVT];
#pragma unroll
            for (int vt = 0; vt < NVT; ++vt) o[vt] = (pg8::f32x4){0.f, 0.f, 0.f, 0.f};
#pragma unroll
            for (int kk = 0; kk < 2; ++kk) { const bf16x8 bf = ldfrag(ATL, 16 * ti + fr, PS64, 32 * kk + 8 * fq);
#pragma unroll
                for (int vt = 0; vt < NVT; ++vt) o[vt] = __builtin_amdgcn_mfma_f32_16x16x32_bf16(ldfrag(VTL, 16 * vt + fr, PS64, 32 * kk + 8 * fq), bf, o[vt], 0, 0, 0); }
#pragma unroll
            for (int kk = 0; kk < 4; ++kk) { const bf16x8 bf = ldfrag(QL, 16 * ti + fr, PQ, 32 * kk + 8 * fq);
#pragma unroll
                for (int vt = 0; vt < NVT; ++vt) o[vt] = __builtin_amdgcn_mfma_f32_16x16x32_bf16(ldfrag(STc, 16 * vt + fr, PQ, 32 * kk + 8 * fq), bf, o[vt], 0, 0, 0); }
#pragma unroll
            for (int vt = 0; vt < NVT; ++vt) *(GAS v2u*)(O + (size_t)(c * GC + 16 * ti + fr) * EB + 16 * vt + 4 * fq) = (v2u){pk2(o[vt].x, o[vt].y), pk2(o[vt].z, o[vt].w)};
        } else {
#pragma unroll
            for (int e = 0; e < 2; ++e) { const int dt = 2 * (wave - 4) + e; const pg8::f32x4 dc = *(const LAS pg8::f32x4*)(DCL + 16 * dt + 4 * fq);
                const bf16x8 a0 = ldfrag(KTL, 16 * dt + fr, PS64, 8 * fq), a1 = ldfrag(KTL, 16 * dt + fr, PS64, 32 + 8 * fq);
#pragma unroll
                for (int vt = 0; vt < NVT; ++vt) { pg8::f32x4 sv = sacc[e][vt];
                    sv = __builtin_amdgcn_mfma_f32_16x16x32_bf16(a0, ldfrag(VTL, 16 * vt + fr, PS64, 8 * fq), sv, 0, 0, 0);
                    sv = __builtin_amdgcn_mfma_f32_16x16x32_bf16(a1, ldfrag(VTL, 16 * vt + fr, PS64, 32 + 8 * fq), sv, 0, 0, 0);
                    sv = sv * dc; sacc[e][vt] = sv; v2u w; w.x = pk2(sv.x, sv.y); w.y = pk2(sv.z, sv.w);
                    *(LAS v2u*)(STn + (16 * vt + fr) * PQ + 16 * dt + 4 * fq) = w; } }
        }
        __syncthreads();
        }
        if (c3 + 1 < NCH) GLA_STEP(rb, c3 + 1)
        const LAS bf16* QL = L0 + (c & 1) * SET_E; const LAS bf16* KTL = QL + 64 * PQ; const LAS bf16* VTL = KTL + 128 * PS64; const LAS bf16* ATL = VTL + SW * PS64; const LAS float* DCL = (const LAS float*)(ATL + 64 * PS64);
        const LAS bf16* STc = STL + (c & 1) * SW * PQ; LAS bf16* STn = STL + ((c + 1) & 1) * SW * PQ;
        if (wave < 4) {
            const int ti = wave; pg8::f32x4 o[NVT];
#pragma unroll
            for (int vt = 0; vt < NVT; ++vt) o[vt] = (pg8::f32x4){0.f, 0.f, 0.f, 0.f};
#pragma unroll
            for (int kk = 0; kk < 2; ++kk) { const bf16x8 bf = ldfrag(ATL, 16 * ti + fr, PS64, 32 * kk + 8 * fq);
#pragma unroll
                for (int vt = 0; vt < NVT; ++vt) o[vt] = __builtin_amdgcn_mfma_f32_16x16x32_bf16(ldfrag(VTL, 16 * vt + fr, PS64, 32 * kk + 8 * fq), bf, o[vt], 0, 0, 0); }
#pragma unroll
            for (int kk = 0; kk < 4; ++kk) { const bf16x8 bf = ldfrag(QL, 16 * ti + fr, PQ, 32 * kk + 8 * fq);
#pragma unroll
                for (int vt = 0; vt < NVT; ++vt) o[vt] = __builtin_amdgcn_mfma_f32_16x16x32_bf16(ldfrag(STc, 16 * vt + fr, PQ, 32 * kk + 8 * fq), bf, o[vt], 0, 0, 0); }
#pragma unroll
            for (int vt = 0; vt < NVT; ++vt) *(GAS v2u*)(O + (size_t)(c * GC + 16 * ti + fr) * EB + 16 * vt + 4 * fq) = (v2u){pk2(o[vt].x, o[vt].y), pk2(o[vt].z, o[vt].w)};
        } else {
#pragma unroll
            for (int e = 0; e < 2; ++e) { const int dt = 2 * (wave - 4) + e; const pg8::f32x4 dc = *(const LAS pg8::f32x4*)(DCL + 16 * dt + 4 * fq);
                const bf16x8 a0 = ldfrag(KTL, 16 * dt + fr, PS64, 8 * fq), a1 = ldfrag(KTL, 16 * dt + fr, PS64, 32 + 8 * fq);
#pragma unroll
                for (int vt = 0; vt < NVT; ++vt) { pg8::f32x4 sv = sacc[e][vt];
                    sv = __builtin_amdgcn_mfma_f32_16x16x32_bf16(a0, ldfrag(VTL, 16 * vt + fr, PS64, 8 * fq), sv, 0, 0, 0);
                    sv = __builtin_amdgcn_mfma_f32_16x16x32_bf16(a1, ldfrag(VTL, 16 * vt + fr, PS64, 32 + 8 * fq), sv, 0, 0, 0);
                    sv = sv * dc; sacc[e][vt] = sv; v2u w; w.x = pk2(sv.x, sv.y); w.y = pk2(sv.z, sv.w);
                    *(LAS v2u*)(STn + (16 * vt + fr) * PQ + 16 * dt + 4 * fq) = w; } }
        }
        __syncthreads();
        }
        if (c3 + 2 < NCH) GLA_STEP(rc, c3 + 2)
        const LAS bf16* QL = L0 + (c & 1) * SET_E; const LAS bf16* KTL = QL + 64 * PQ; const LAS bf16* VTL = KTL + 128 * PS64; const LAS bf16* ATL = VTL + SW * PS64; const LAS float* DCL = (const LAS float*)(ATL + 64 * PS64);
        const LAS bf16* STc = STL + (c & 1) * SW * PQ; LAS bf16* STn = STL + ((c + 1) & 1) * SW * PQ;
        if (wave < 4) {
            const int ti = wave; pg8::f32x4 o[NVT];
#pragma unroll
            for (int vt = 0; vt < NVT; ++vt) o[vt] = (pg8::f32x4){0.f, 0.f, 0.f, 0.f};
#pragma unroll
            for (int kk = 0; kk < 2; ++kk) { const bf16x8 bf = ldfrag(ATL, 16 * ti + fr, PS64, 32 * kk + 8 * fq);
#pragma unroll
                for (int vt = 0; vt < NVT; ++vt) o[vt] = __builtin_amdgcn_mfma_f32_16x16x32_bf16(ldfrag(VTL, 16 * vt + fr, PS64, 32 * kk + 8 * fq), bf, o[vt], 0, 0, 0); }
#pragma unroll
            for (int kk = 0; kk < 4; ++kk) { const bf16x8 bf = ldfrag(QL, 16 * ti + fr, PQ, 32 * kk + 8 * fq);
#pragma unroll
                for (int vt = 0; vt < NVT; ++vt) o[vt] = __builtin_amdgcn_mfma_f32_16x16x32_bf16(ldfrag(STc, 16 * vt + fr, PQ, 32 * kk + 8 * fq), bf, o[vt], 0, 0, 0); }
#pragma unroll
            for (int vt = 0; vt < NVT; ++vt) *(GAS v2u*)(O + (size_t)(c * GC + 16 * ti + fr) * EB + 16 * vt + 4 * fq) = (v2u){pk2(o[vt].x, o[vt].y), pk2(o[vt].z, o[vt].w)};
        } else {
#pragma unroll
            for (int e = 0; e < 2; ++e) { const int dt = 2 * (wave - 4) + e; const pg8::f32x4 dc = *(const LAS pg8::f32x4*)(DCL + 16 * dt + 4 * fq);
                const bf16x8 a0 = ldfrag(KTL, 16 * dt + fr, PS64, 8 * fq), a1 = ldfrag(KTL, 16 * dt + fr, PS64, 32 + 8 * fq);
#pragma unroll
                for (int vt = 0; vt < NVT; ++vt) { pg8::f32x4 sv = sacc[e][vt];
                    sv = __builtin_amdgcn_mfma_f32_16x16x32_bf16(a0, ldfrag(VTL, 16 * vt + fr, PS64, 8 * fq), sv, 0, 0, 0);
                    sv = __builtin_amdgcn_mfma_f32_16x16x32_bf16(a1, ldfrag(VTL, 16 * vt + fr, PS64, 32 + 8 * fq), sv, 0, 0, 0);
                    sv = sv * dc; sacc[e][vt] = sv; v2u w; w.x = pk2(sv.x, sv.y); w.y = pk2(sv.z, sv.w);
                    *(LAS v2u*)(STn + (16 * vt + fr) * PQ + 16 * dt + 4 * fq) = w; } }
        }
        __syncthreads();
        }
    }
#undef GLA_STEP
    GLA_WAIT(ra, 0); GLA_WAIT(rb, 0); GLA_WAIT(rc, 0);
    if (wave >= 4) { float* SP = F.out + OUT_SP + (size_t)bh * DK * DV + j * SW;
#pragma unroll
        for (int e = 0; e < 2; ++e) { const int dt = 2 * (wave - 4) + e;
#pragma unroll
            for (int vt = 0; vt < NVT; ++vt)
#pragma unroll
                for (int i = 0; i < 4; ++i) SP[(size_t)(16 * dt + 4 * fq + i) * DV + 16 * vt + fr] = sacc[e][vt][i]; } }
#undef GLA_FETCH
#undef GLA_COMMIT
#undef GLA_WAIT
#undef GLA_LD16
    if (fuse_norm) {
        asm volatile("s_waitcnt vmcnt(0)" ::: "memory");
        __syncthreads();
        if (tid == 0) { unsigned* cnt = (unsigned*)(F.ws + WS_CTL) + CW_GRP + 64 * bh;
            __builtin_amdgcn_fence(__ATOMIC_RELEASE, "agent"); asm volatile("s_waitcnt vmcnt(0)" ::: "memory");
            (void)__hip_atomic_fetch_add(cnt, 1u, __ATOMIC_RELAXED, __HIP_MEMORY_SCOPE_AGENT); }
    }
}
__device__ __forceinline__ void head_norm(Frame& F, int bh, int rlo, unsigned need) {
    const int tid = (int)threadIdx.x, lane = tid & 63, wave = F.wave, b = bh >> 2, h = bh & 3;
    if (tid == 0) { unsigned* cnt = (unsigned*)(F.ws + WS_CTL) + CW_GRP + 64 * bh;
        unsigned sp = 0; while (__hip_atomic_load(cnt, __ATOMIC_RELAXED, __HIP_MEMORY_SCOPE_AGENT) < need) { __builtin_amdgcn_s_sleep(2); if (++sp > (1u << 20)) break; }
        __builtin_amdgcn_fence(__ATOMIC_ACQUIRE, "agent"); asm volatile("s_waitcnt vmcnt(0)" ::: "memory"); }
    __syncthreads();
    const bf16* Oh = (const bf16*)(F.ws + WS_O) + (size_t)(b * SEQ) * EB + h * DV; const bf16* SZB = (const bf16*)(F.ws + WS_SZB) + (size_t)(b * SEQ) * EB + h * DV; bf16* Y = (bf16*)(F.ws + WS_Y) + (size_t)(b * SEQ) * DM + EA + h * DV;
    const f32x4 go = *(const GAS f32x4*)(F.g_o + h * DV + 4 * lane);
    constexpr int NB = 16; v2u ob[NB], zz[NB];
#pragma unroll
    for (int q = 0; q < NB; ++q) { const int row = rlo + wave + NWAVES * q; ob[q] = *(const GAS v2u*)(Oh + (size_t)row * EB + 4 * lane); zz[q] = *(const GAS v2u*)(SZB + (size_t)row * EB + 4 * lane); }
#pragma unroll
    for (int q = 0; q < NB; ++q) { const int row = rlo + wave + NWAVES * q;
        const f32x4 o = (f32x4){bflo(ob[q].x), bfhi(ob[q].x), bflo(ob[q].y), bfhi(ob[q].y)};
        const float ss = wave_sum((o.x * o.x + o.y * o.y) + (o.z * o.z + o.w * o.w)); const float rs = 1.0f / sqrtf(ss * (1.f / DV) + EPS);
        v2u w; w.x = pk2(o.x * rs * go.x * bflo(zz[q].x), o.y * rs * go.y * bfhi(zz[q].x)); w.y = pk2(o.z * rs * go.z * bflo(zz[q].y), o.w * rs * go.w * bfhi(zz[q].y));
        *(GAS v2u*)(Y + (size_t)row * DM + 4 * lane) = w; }
}

struct Args { const float* in[19]; float* out; unsigned char* ws; int ph_lo, ph_hi, li, pad; };
constexpr int NPHASE = 11;
__global__ void __launch_bounds__(NTHR, 2) fwd_kernel(Args args) {
    extern __shared__ __attribute__((aligned(16))) unsigned char lds[];
    Frame F;
    F.lds = (LAS unsigned char*)lds; F.ws = args.ws; F.out = args.out;
    F.wave = __builtin_amdgcn_readfirstlane((int)threadIdx.x >> 6);
    F.G = gridDim.x; { const int bx = blockIdx.x; F.vcu = (F.G % 8 == 0) ? (bx % 8) * (F.G / 8) + bx / 8 : bx; }
    F.xp = args.in[0]; F.xs = args.in[1]; F.pp = args.in[2]; F.ps = args.in[3]; F.st0 = args.in[4]; F.g_pre = args.in[5]; F.w_in = args.in[6]; F.g_v = args.in[7]; F.w_s = args.in[8]; F.b_s = args.in[9];
    F.w_a2 = args.in[10]; F.b_a = args.in[11]; F.g_o = args.in[12]; F.w_pa = args.in[13]; F.w_pb = args.in[14]; F.w_o = args.in[15]; F.g_post = args.in[16]; F.w_pg = args.in[17]; F.w_pe = args.in[18];
    volatile LAS unsigned* MISC = (volatile LAS unsigned*)(F.lds + MISC_OFF);
    if (((int)threadIdx.x) < 64) MISC[((int)threadIdx.x)] = 0u;
    __syncthreads();
    XcdBarrier bar; bar.bar = (unsigned*)(F.ws + WS_CTL) + CW_BAR + args.li * XCD_BAR_WORDS; bar.x = 0; bar.st = nullptr;
    const int lo = args.ph_lo, hi = args.ph_hi;
    if (hi - lo > 1) bar = xcd_barrier_post(bar.bar, MISC + 8);
#define IN(k) (lo <= (k) && (k) < hi)
#define SEAM(k) do { if (IN(k) && IN((k) + 1)) xcd_barrier(bar); } while (0)
    unsigned char* ws = F.ws;

    if (IN(0)) { p0_prologue(F); } SEAM(0);

    if (IN(1)) {
        pg8::Gemm g{(const bf16*)(ws + WS_XN), (const bf16*)(ws + WS_W1T), DM, DM}; pg8::StaticOrder S; S.init(MT, N1, DM, F.G, (int)blockIdx.x);
        EpiG1 E{ws, F.b_a};
        pg8::gemm_phase<EpiG1, pg8::StaticOrder>(F.lds, g, S, E);
        { const int nfullc = S.nwg % F.G;
          pg8::Gemm g2{(const bf16*)(ws + WS_PBF), (const bf16*)(ws + WS_WPE), PLE, PLE}; pg8::ESampleOrder S2{nfullc ? F.G - nfullc : F.G, nfullc ? (int)blockIdx.x - nfullc : (int)blockIdx.x};
          EpiBf E2{(bf16*)(ws + WS_ES) - (size_t)MP * DM, DM};
          pg8::gemm_phase<EpiBf, pg8::ESampleOrder>(F.lds, g2, S2, E2); }
    } SEAM(1);

    const bool hetero = (F.G == 256);
    const bool fuse_norm = hetero || (F.G % 16) == 0;
    if (IN(2)) {
        if (hetero) { for (int u = F.vcu; u < 512; u += F.G) { if (u < 256) prep_unit(F, u); else gate_prompt_unit(F, u - 256); } }
        else { for (int u = F.vcu; u < 1024; u += F.G) { if (u < 256) gate_prompt_unit(F, u); else if (u < 768) sample_unit(F, u - 256); else prep_unit(F, u - 768); } }
    } SEAM(2);

    if (IN(3)) {
        if (hetero) { const int xcd = F.vcu >> 5, l = F.vcu & 31;
            if (l < 16) gla_unit<2>(F, (xcd * 2 + (l >> 3)) * 8 + (l & 7), true);
            else { for (int u = xcd * 16 + (l - 16); u < 512; u += 128) sample_unit(F, u); }
            __syncthreads(); head_norm(F, F.vcu >> 4, 128 * (F.vcu & 15), 8u); }
        else { for (int u = F.vcu; u < 256; u += F.G) gla_unit<1>(F, u, fuse_norm);
               if (fuse_norm) { for (int u = F.vcu; u < 256; u += F.G) head_norm(F, u >> 4, 128 * (u & 15), 16u); } }
    } SEAM(3);

    if (IN(4) && !fuse_norm) {
        const int gw = F.vcu * NWAVES + F.wave, NGW = F.G * NWAVES; const bf16* O = (const bf16*)(ws + WS_O); const bf16* SZB = (const bf16*)(ws + WS_SZB); bf16* Y = (bf16*)(ws + WS_Y);
        for (int m = gw; m < MP; m += NGW) {
#pragma unroll
            for (int h = 0; h < HB; ++h) { const v2u ob = *(const GAS v2u*)(O + (size_t)m * EB + h * DV + 4 * ((int)(threadIdx.x & 63u))); const f32x4 o = (f32x4){bflo(ob.x), bfhi(ob.x), bflo(ob.y), bfhi(ob.y)};
                const float ss = wave_sum((o.x * o.x + o.y * o.y) + (o.z * o.z + o.w * o.w)); const float rs = 1.0f / sqrtf(ss * (1.f / DV) + EPS);
                const f32x4 go = *(const GAS f32x4*)(F.g_o + h * DV + 4 * ((int)(threadIdx.x & 63u))); const v2u zz = *(const GAS v2u*)(SZB + (size_t)m * EB + h * DV + 4 * ((int)(threadIdx.x & 63u)));
                v2u w; w.x = pk2(o.x * rs * go.x * bflo(zz.x), o.y * rs * go.y * bfhi(zz.x)); w.y = pk2(o.z * rs * go.z * bflo(zz.y), o.w * rs * go.w * bfhi(zz.y));
                *(GAS v2u*)(Y + (size_t)m * DM + EA + h * DV + 4 * ((int)(threadIdx.x & 63u))) = w; } }
    } if (!fuse_norm) SEAM(4);

    bf16* const slabA_lo = (bf16*)(ws + WS_SLABA); bf16* const slabA_hi = slabA_lo + (size_t)4 * MS * DM;
    bf16* const slabB_lo = (bf16*)(ws + WS_GA); bf16* const slabB_hi = slabB_lo + (size_t)4 * MS * DM;
    if (IN(5)) {
        { pg8::Gemm g{(const bf16*)(ws + WS_Y), (const bf16*)(ws + WS_WPAB), DM, DM}; pg8::TailOrder S{F.G, (int)blockIdx.x, (int)((blockIdx.x >> 6) & 1)};
          EpiG2 E{ws + WS_GA, ws + WS_GB, (bf16*)(ws + WS_M), slabA_lo, slabA_hi};
          pg8::gemm_phase<EpiG2, pg8::TailOrder>(F.lds, g, S, E); }
        { pg8::Gemm g{(const bf16*)(ws + WS_PBF), (const bf16*)(ws + WS_WPE), PLE, PLE}; pg8::EPromptOrder S{F.G, (int)blockIdx.x};
          EpiBf E{(bf16*)(ws + WS_E), DM};
          pg8::gemm_phase<EpiBf, pg8::EPromptOrder>(F.lds, g, S, E); }
    } SEAM(5);

    if (IN(6)) {
        const int gt = F.vcu * NTHR + ((int)threadIdx.x), NGT = F.G * NTHR; const unsigned char* GA = ws + WS_GA; const unsigned char* GB = ws + WS_GB; bf16* Mo = (bf16*)(ws + WS_M);
        for (int p = gt; p < MS * DM / 8; p += NGT) { const size_t off = (size_t)p * 8, og = (size_t)MP * DM + off;
            f32x4 a0, a1, b0, b1; slab_sum8(slabA_lo, slabA_hi, off, 0, 4, a0, a1); slab_sum8(slabA_lo, slabA_hi, off, 4, 8, b0, b1);
            float fa[8], fb[8]; u8x8_to_f32(*(const GAS v2u*)(GA + og), fa); u8x8_to_f32(*(const GAS v2u*)(GB + og), fb); const float k = 1.f / 255.f; v4u w;
            w.x = pk2((fa[0] * a0.x + fb[0] * b0.x) * k, (fa[1] * a0.y + fb[1] * b0.y) * k); w.y = pk2((fa[2] * a0.z + fb[2] * b0.z) * k, (fa[3] * a0.w + fb[3] * b0.w) * k);
            w.z = pk2((fa[4] * a1.x + fb[4] * b1.x) * k, (fa[5] * a1.y + fb[5] * b1.y) * k); w.w = pk2((fa[6] * a1.z + fb[6] * b1.z) * k, (fa[7] * a1.w + fb[7] * b1.w) * k);
            *(GAS v4u*)(Mo + og) = w; }
    } SEAM(6);

    if (IN(7)) {
        pg8::Gemm g{(const bf16*)(ws + WS_M), (const bf16*)(ws + WS_WO), DM, DM}; pg8::TailOrder S{F.G, (int)blockIdx.x, (int)((blockIdx.x >> 6) & 1)};
        EpiG3 E{(bf16*)(ws + WS_T), (float*)(ws + WS_TSS), slabB_lo, slabB_hi, hetero ? 1 : 0, (bf16*)(ws + WS_H), (float*)(ws + WS_TSS), (unsigned*)(ws + WS_CTL) + CW_PAN, F.xp, F.g_post, F.lds + pg8::STAGE_BYTES};
        pg8::gemm_phase<EpiG3, pg8::TailOrder>(F.lds, g, S, E);
    } SEAM(7);

    if (IN(8)) {
        const bf16* T = (const bf16*)(ws + WS_T); const float* TSS = (const float*)(ws + WS_TSS); bf16* H = (bf16*)(ws + WS_H);
        for (int r = F.wave * F.G + F.vcu; r < MS; r += NWAVES * F.G) { const int m = MP + r;
            f32x4 t4[8]; float ss = 0.f;
#pragma unroll
            for (int j2 = 0; j2 < 8; ++j2) { t4[j2] = slab_sum4(slabB_lo, slabB_hi, (size_t)r * DM + 4 * ((int)(threadIdx.x & 63u)) + 256 * j2); ss += (t4[j2].x * t4[j2].x + t4[j2].y * t4[j2].y) + (t4[j2].z * t4[j2].z + t4[j2].w * t4[j2].w); }
            const float rs = 1.0f / sqrtf(wave_sum(ss) * (1.f / DM) + EPS);
            const GAS f32x4* xr = (const GAS f32x4*)xrow(F, m) + ((int)(threadIdx.x & 63u)); const GAS f32x4* gr = (const GAS f32x4*)F.g_post + ((int)(threadIdx.x & 63u)); GAS v2u* ho = (GAS v2u*)(H + (size_t)m * DM) + ((int)(threadIdx.x & 63u));
#pragma unroll
            for (int j2 = 0; j2 < 8; ++j2) { const f32x4 xv = xr[64 * j2], gg = gr[64 * j2], tv = t4[j2]; v2u o, tb; tb.x = pk2(tv.x, tv.y); tb.y = pk2(tv.z, tv.w);
                o.x = pk2(xv.x + bflo(tb.x) * rs * gg.x, xv.y + bfhi(tb.x) * rs * gg.y); o.y = pk2(xv.z + bflo(tb.y) * rs * gg.z, xv.w + bfhi(tb.y) * rs * gg.w); ho[64 * j2] = o; }
        }
        const int gw = F.vcu * NWAVES + F.wave, NGW = F.G * NWAVES;
        for (int m = hetero ? MP : gw; m < MP; m += NGW) {
            float ss = ((int)(threadIdx.x & 63u)) < 32 ? TSS[(size_t)m * 32 + ((int)(threadIdx.x & 63u))] : 0.f; ss = wave_sum(ss); const float rs = 1.0f / sqrtf(ss * (1.f / DM) + EPS);
            const GAS f32x4* xr = (const GAS f32x4*)xrow(F, m) + ((int)(threadIdx.x & 63u)); const GAS f32x4* gr = (const GAS f32x4*)F.g_post + ((int)(threadIdx.x & 63u)); const GAS v2u* tr = (const GAS v2u*)(T + (size_t)m * DM) + ((int)(threadIdx.x & 63u)); GAS v2u* ho = (GAS v2u*)(H + (size_t)m * DM) + ((int)(threadIdx.x & 63u));
#pragma unroll
            for (int j2 = 0; j2 < 8; ++j2) { const f32x4 xv = xr[64 * j2], gg = gr[64 * j2]; const v2u tv = tr[64 * j2]; v2u o;
                o.x = pk2(xv.x + bflo(tv.x) * rs * gg.x, xv.y + bfhi(tv.x) * rs * gg.y); o.y = pk2(xv.z + bflo(tv.y) * rs * gg.z, xv.w + bfhi(tv.y) * rs * gg.w); ho[64 * j2] = o; }
        }
    } SEAM(8);

    if (IN(9)) {
        pg8::Gemm g{(const bf16*)(ws + WS_H), (const bf16*)(ws + WS_WPG), DM, DM}; pg8::TailOrder S{F.G, (int)blockIdx.x, (int)((blockIdx.x >> 6) & 1)};
        EpiG4 E{(const bf16*)(ws + WS_H), (const bf16*)(ws + WS_E), F.out + OUT_Y, slabB_lo, slabB_hi};
        pg8::gemm_phase<EpiG4, pg8::TailOrder>(F.lds, g, S, E);
    } SEAM(9);

    if (IN(10)) {
        const int gt = F.vcu * NTHR + ((int)threadIdx.x), NGT = F.G * NTHR; const bf16* Hb = (const bf16*)(ws + WS_H); const bf16* Es = (const bf16*)(ws + WS_ES); float* out = F.out + OUT_Y;
        for (int p = gt; p < MS * DM / 4; p += NGT) { const size_t off = (size_t)p * 4, og = (size_t)MP * DM + off;
            const f32x4 a = slab_sum4(slabB_lo, slabB_hi, off); const v2u hv = *(const GAS v2u*)(Hb + og), ev = *(const GAS v2u*)(Es + off);
            f32x4 o; o.x = bflo(hv.x) + sigm(a.x) * bflo(ev.x); o.y = bfhi(hv.x) + sigm(a.y) * bfhi(ev.x); o.z = bflo(hv.y) + sigm(a.z) * bflo(ev.y); o.w = bfhi(hv.y) + sigm(a.w) * bfhi(ev.y);
            *(GAS f32x4*)(out + og) = o; }
    }
#undef IN
#undef SEAM
}

__global__ void dbg_dump(const unsigned short* src, float* dst, size_t n) { for (size_t i = blockIdx.x * (size_t)blockDim.x + threadIdx.x; i < n; i += (size_t)gridDim.x * blockDim.x) dst[i] = __uint_as_float((unsigned)src[i] << 16); }
extern "C" void kernel_launch(void* const* d_in, const int* in_sizes, int n_in, void* d_out, int out_size, void* d_ws, size_t ws_size, hipStream_t stream) {
    static int grid = 0;
    if (grid == 0) {
        if (n_in != 19 || ws_size < WS_END) { fprintf(stderr, "kernel_launch: built for 19 inputs and >= %zu bytes of workspace; got n_in %d, ws %zu\n", (size_t)WS_END, n_in, ws_size); grid = -1; return; }
        int dev = 0, cus = 0, per_cu = 0;
        if (hipGetDevice(&dev) != hipSuccess || hipDeviceGetAttribute(&cus, hipDeviceAttributeMultiprocessorCount, dev) != hipSuccess) { grid = -1; return; }
        if (hipFuncSetAttribute((const void*)fwd_kernel, hipFuncAttributeMaxDynamicSharedMemorySize, LDS_BYTES) != hipSuccess) { fprintf(stderr, "kernel_launch: hipFuncSetAttribute failed\n"); grid = -1; return; }
        if (hipOccupancyMaxActiveBlocksPerMultiprocessor(&per_cu, (const void*)fwd_kernel, NTHR, LDS_BYTES) != hipSuccess || per_cu < 1) { fprintf(stderr, "kernel_launch: occupancy query says %d blocks per CU\n", per_cu); per_cu = 1; }
        (void)hipGetLastError();
        grid = cus;
    }
    if (grid < 0) return;
    (void)hipMemsetAsync((char*)d_ws + WS_CTL, 0, CTL_ZERO_BYTES, stream);
    Args a{};
    for (int i = 0; i < 19; ++i) a.in[i] = (const float*)d_in[i];
    a.out = (float*)d_out; a.ws = (unsigned char*)d_ws;
#if MK_N_LAUNCHES == 1
    a.ph_lo = 0; a.ph_hi = NPHASE; a.li = 0;
    hipLaunchKernelGGL(fwd_kernel, dim3(grid), dim3(NTHR), LDS_BYTES, stream, a);
#else
#ifndef DBG_LAST
#define DBG_LAST (NPHASE - 1)
#endif
    if (DBG_LAST < NPHASE - 1) (void)hipMemsetAsync(d_out, 0, (size_t)out_size * 4, stream);
    for (int li = 0; li <= DBG_LAST; ++li) { const int rep = 1; for (int r = 0; r < rep; ++r) { a.ph_lo = li; a.ph_hi = li + 1; a.li = 0; hipLaunchKernelGGL(fwd_kernel, dim3(grid), dim3(NTHR), LDS_BYTES, stream, a); } }
#ifdef DBG_DUMP
    hipLaunchKernelGGL(dbg_dump, dim3(2048), dim3(256), 0, stream, (const unsigned short*)((char*)d_ws + DBG_DUMP), (float*)d_out, (size_t)MT * DM);
#endif
#endif
}
```

```cpp
#include <hip/hip_runtime.h>
#include <cstdio>
#include <cstdint>

#ifndef MK_N_LAUNCHES
#define MK_N_LAUNCHES 1
#endif

namespace pg8 {
#define PG8_LAS __attribute__((address_space(3)))
typedef unsigned short bf16_t;
typedef short bf16x8 __attribute__((ext_vector_type(8)));
typedef float f32x4 __attribute__((ext_vector_type(4)));
typedef unsigned u32x4 __attribute__((ext_vector_type(4)));
typedef unsigned u32x2 __attribute__((ext_vector_type(2)));
constexpr int BM = 256, BK = 64, HALF = 128, HTB = HALF * BK * 2, STAGE_BYTES = 8 * HTB, NXCD = 8, WGM = 8;

__host__ __device__ __forceinline__ int lds_byte(int r, int c) { const int st = (r >> 4) * 2 + (c >> 5), rr = r & 15, cc = c & 31, ob = rr * 64 + cc * 2; return st * 1024 + (ob ^ (((ob >> 9) & 1) << 5)); }
__host__ __device__ __forceinline__ void stage_rc(int b, int& R, int& C) { const int st = b / 1024, sb = b % 1024, swz = sb ^ (((sb >> 9) & 1) << 5); R = (st >> 1) * 16 + swz / 64; C = (st & 1) * 32 + (swz % 64) / 2; }
__host__ __device__ __forceinline__ int perm32(int rho) { const int n = rho >> 4, i = rho & 15; return 8 * (i >> 2) + 4 * n + (i & 3); }

struct Unit { int pm, pn, kt0, nkt, kind; };
struct Gemm { const bf16_t* A; const bf16_t* Bt; int lda, ldb; };

struct StaticOrder {
    int nM, nN, nwg, G, c, nkt;
    __host__ __device__ void init(int M, int N, int K, int G_, int c_) { nM = M / BM; nN = N / BM; nwg = nM * nN; G = G_; c = c_; nkt = K / BK; }
    __host__ __device__ bool next(int i, Unit& u) const {
        const long L = (long)i * G + c; if (L >= nwg) return false;
        int wgid = (int)L; { const int q = nwg / NXCD, r = nwg % NXCD, xcd = wgid % NXCD, off = wgid / NXCD; wgid = (xcd < r ? xcd * (q + 1) : r * (q + 1) + (xcd - r) * q) + off; }
        const int nig = WGM * nN, gid = wgid / nig, fm = gid * WGM, gsz = (nM - fm) < WGM ? (nM - fm) : WGM;
        u.pm = fm + ((wgid % nig) % gsz); u.pn = (wgid % nig) / gsz; u.kt0 = 0; u.nkt = nkt; u.kind = 0; return true;
    }
};
struct TailOrder {
    int G, c, swap;
    __host__ __device__ bool next(int i, Unit& u) const {
        long L = (long)i * G + c; if (swap && G == 256 && i < 2) L = (long)(1 - i) * G + c;
        if (L < 256) { const int x = (int)L & 7, kk = (int)L >> 3; u.pm = 4 * x + (kk >> 3); u.pn = kk & 7; u.kt0 = 0; u.nkt = 32; u.kind = 0; return true; }
        if (L < 512) { const int l2 = (int)L - 256, x = l2 & 7, kk = l2 >> 3; u.pm = 32 + (kk >> 3); u.pn = kk & 7; u.kt0 = 4 * x; u.nkt = 4; u.kind = 1; return true; }
        return false;
    }
};
struct EPromptOrder {
    int G, c;
    __host__ __device__ bool next(int i, Unit& u) const {
        const long L = (long)i * G + c; if (L >= 256) return false;
        const int x = (int)L & 7, kk = (int)L >> 3; u.pm = 4 * x + (kk >> 3); u.pn = kk & 7; u.kt0 = 0; u.nkt = 4; u.kind = 0; return true; }
};
struct ESampleOrder {
    int G2, c2;
    __host__ __device__ bool next(int i, Unit& u) const {
        if (c2 < 0 || G2 <= 0) return false; const long L = (long)i * G2 + c2; if (L >= 32) return false;
        u.pm = 32 + ((int)L >> 3); u.pn = (int)L & 7; u.kt0 = 0; u.nkt = 4; u.kind = 0; return true; }
};

typedef __bf16 bf2_t __attribute__((ext_vector_type(2)));
typedef float f2_t __attribute__((ext_vector_type(2)));
__device__ __forceinline__ unsigned cvt_pk_bf16(float lo, float hi) { return __builtin_bit_cast(unsigned, __builtin_convertvector((f2_t){lo, hi}, bf2_t)); }

template <class Epi, class Sched>
__device__ __forceinline__ void gemm_phase(PG8_LAS unsigned char* lds, const Gemm g, const Sched& S, const Epi& E) {
    const int tid = threadIdx.x, wid = __builtin_amdgcn_readfirstlane(tid >> 6), lane = tid & 63, wr = wid >> 2, wc = wid & 3, fr = lane & 15, fq = lane >> 4;
    unsigned voffA[2], voffB[2];
#pragma unroll
    for (int i = 0; i < 2; ++i) { int R, C; stage_rc(tid * 16 + i * 8192, R, C); const int Rb = Epi::PERM ? (64 * (R >> 5) + perm32(R & 31)) : R;
        voffA[i] = (unsigned)(R * g.lda + C) * 2u; voffB[i] = (unsigned)(Rb * g.ldb + C) * 2u; }
    const size_t kstep = (size_t)(BK * 2);
    const size_t hstepA = (size_t)HALF * g.lda * 2, hstepB = (size_t)(Epi::PERM ? 32 : HALF) * g.ldb * 2;
    const size_t tstepA = 2 * hstepA, tstepB = (size_t)BM * g.ldb * 2;
    const unsigned ldsw = (unsigned)wid * 1024u;
    const int aoff = lds_byte(wr * 64 + fr, fq * 8), boff = lds_byte(wc * 32 + fr, fq * 8);
#define PG8_SA(b, h) (((b) * 2 + (h)) * HTB)
#define PG8_SB(b, h) ((4 + (b) * 2 + (h)) * HTB)
#define PG8_STAGE(bufoff, gbase, voff) do { _Pragma("unroll") for (int _i = 0; _i < 2; ++_i) \
        __builtin_amdgcn_global_load_lds((const unsigned*)((const char*)(gbase) + (voff)[_i]), (PG8_LAS unsigned*)(lds + (bufoff) + ldsw + _i * 8192), 16, 0, 0); } while (0)
#define PG8_LDA(dst, b, h) do { _Pragma("unroll") for (int m = 0; m < 4; ++m) _Pragma("unroll") for (int k = 0; k < 2; ++k) dst[m][k] = *(const PG8_LAS bf16x8*)(lds + PG8_SA(b, h) + aoff + m * 2048 + k * 1024); } while (0)
#define PG8_LDB(dst, b, h) do { _Pragma("unroll") for (int n = 0; n < 2; ++n) _Pragma("unroll") for (int k = 0; k < 2; ++k) dst[n][k] = *(const PG8_LAS bf16x8*)(lds + PG8_SB(b, h) + boff + n * 2048 + k * 1024); } while (0)
#define PG8_MMA(ai, bj, At, Bt) do { __builtin_amdgcn_s_setprio(1); _Pragma("unroll") for (int m = 0; m < 4; ++m) _Pragma("unroll") for (int n = 0; n < 2; ++n) _Pragma("unroll") for (int k = 0; k < 2; ++k) \
        acc[ai][bj][m][n] = __builtin_amdgcn_mfma_f32_16x16x32_bf16(Bt[n][k], At[m][k], acc[ai][bj][m][n], 0, 0, 0); __builtin_amdgcn_s_setprio(0); } while (0)
#define PG8_WAIT_V(n) asm volatile("s_waitcnt vmcnt(" #n ")" ::: "memory")
#define PG8_WAIT_L(n) asm volatile("s_waitcnt lgkmcnt(" #n ")" ::: "memory")
#define PG8_BAR __builtin_amdgcn_s_barrier()
#define PG8_SCHED __builtin_amdgcn_sched_barrier(0)
    Unit cur, nxt; int ui = 0;
    if (!S.next(0, cur)) return;
    f32x4 acc[2][2][4][2];
#pragma unroll
    for (int a = 0; a < 2; ++a)
#pragma unroll
        for (int b = 0; b < 2; ++b)
#pragma unroll
            for (int m = 0; m < 4; ++m)
#pragma unroll
                for (int n = 0; n < 2; ++n) acc[a][b][m][n] = (f32x4){0.f, 0.f, 0.f, 0.f};
    bf16x8 At[4][2], B0[2][2], B1[2][2];
    const char* cA = (const char*)g.A + (size_t)cur.pm * tstepA + (size_t)cur.kt0 * kstep; const char* cB = (const char*)g.Bt + (size_t)cur.pn * tstepB + (size_t)cur.kt0 * kstep;
    int nt = cur.nkt; asm volatile("" : "+s"(nt));
    PG8_STAGE(PG8_SB(0, 0), cB, voffB); PG8_STAGE(PG8_SB(0, 1), cB + hstepB, voffB); PG8_STAGE(PG8_SA(0, 0), cA, voffA); PG8_STAGE(PG8_SA(0, 1), cA + hstepA, voffA);
    if (wr == 1) PG8_BAR;
    PG8_WAIT_V(2); PG8_BAR;
    PG8_STAGE(PG8_SB(1, 0), cB + kstep, voffB); PG8_STAGE(PG8_SA(1, 0), cA + kstep, voffA); PG8_STAGE(PG8_SB(1, 1), cB + hstepB + kstep, voffB);
    PG8_WAIT_V(6); PG8_BAR;
    for (;;) {
        const bool has_next = S.next(ui + 1, nxt);
        const char* nA = has_next ? (const char*)g.A + (size_t)nxt.pm * tstepA + (size_t)nxt.kt0 * kstep : cA; const char* nB = has_next ? (const char*)g.Bt + (size_t)nxt.pn * tstepB + (size_t)nxt.kt0 * kstep : cB;
        for (int t = 0; t < nt; t += 2) {
            const bool last = (t == nt - 2);
            const char* a1 = cA + (size_t)(t + 1) * kstep;
            const char* a2 = last ? nA : cA + (size_t)(t + 2) * kstep; const char* b2 = last ? nB : cB + (size_t)(t + 2) * kstep;
            const char* a3 = a2 + kstep; const char* b3 = b2 + kstep;
            if constexpr (Epi::HAS_MID) { if (cur.kind == 0 && t == (nt >> 1)) E.mid(acc, cur, wr, wc, fr, fq); }
            PG8_LDB(B0, 0, 0); PG8_LDB(B1, 0, 1); PG8_SCHED; PG8_LDA(At, 0, 0); PG8_STAGE(PG8_SA(1, 1), a1 + hstepA, voffA);
            PG8_WAIT_V(8); PG8_WAIT_L(0); PG8_BAR; PG8_MMA(0, 0, At, B0); PG8_MMA(0, 1, At, B1); PG8_BAR; PG8_SCHED;
            PG8_LDA(At, 0, 1); PG8_STAGE(PG8_SB(0, 0), b2, voffB); PG8_STAGE(PG8_SB(0, 1), b2 + hstepB, voffB); PG8_STAGE(PG8_SA(0, 0), a2, voffA);
            PG8_WAIT_V(8); PG8_WAIT_L(0); PG8_BAR; PG8_MMA(1, 0, At, B0); PG8_MMA(1, 1, At, B1); PG8_BAR; PG8_SCHED;
            PG8_LDB(B0, 1, 0); PG8_LDB(B1, 1, 1); PG8_SCHED; PG8_LDA(At, 1, 0); PG8_STAGE(PG8_SA(0, 1), a2 + hstepA, voffA);
            PG8_WAIT_V(8); PG8_WAIT_L(0); PG8_BAR; PG8_MMA(0, 0, At, B0); PG8_MMA(0, 1, At, B1); PG8_BAR; PG8_SCHED;
            PG8_LDA(At, 1, 1); PG8_STAGE(PG8_SB(1, 0), b3, voffB); PG8_STAGE(PG8_SB(1, 1), b3 + hstepB, voffB); PG8_STAGE(PG8_SA(1, 0), a3, voffA);
            PG8_WAIT_V(8); PG8_WAIT_L(0); PG8_BAR; PG8_MMA(1, 0, At, B0); PG8_MMA(1, 1, At, B1); PG8_BAR; PG8_SCHED;
        }
        if (wr == 0) PG8_BAR;
        E(acc, cur, wr, wc, fr, fq);
        if (!has_next) break;
#pragma unroll
        for (int a = 0; a < 2; ++a)
#pragma unroll
            for (int b = 0; b < 2; ++b)
#pragma unroll
                for (int m = 0; m < 4; ++m)
#pragma unroll
                    for (int n = 0; n < 2; ++n) acc[a][b][m][n] = (f32x4){0.f, 0.f, 0.f, 0.f};
        cur = nxt; cA = nA; cB = nB; ++ui; nt = cur.nkt; asm volatile("" : "+s"(nt));
        if (wr == 1) PG8_BAR;
    }
    PG8_WAIT_V(0);
    PG8_BAR;
#undef PG8_SA
#undef PG8_SB
#undef PG8_STAGE
#undef PG8_LDA
#undef PG8_LDB
#undef PG8_MMA
#undef PG8_WAIT_V
#undef PG8_WAIT_L
#undef PG8_BAR
#undef PG8_SCHED
}
}

constexpr int NWAVES = 8, NTHR = 512;
constexpr int DM = 2048, MP = 8192, MS = 1024, MT = 9216, SEQ = 2048, NBAT = 4, DBAT = 128, DSEQ = 8;
constexpr int EA = 1024, KBW = 512, EB = 1024, NIN = 10256, N1 = 10752, PLE = 256;
constexpr int HB = 4, DK = 128, DV = 256, GR = 16, CH = 128, GC = 64  , NCH = SEQ / GC;
constexpr float EPS = 1e-6f;
constexpr int C_ALR = 6144, C_MA = 6160;

constexpr size_t OUT_Y = 0, OUT_SP = (size_t)MT * DM, OUT_SS = OUT_SP + (size_t)NBAT * HB * DK * DV, OUT_CV = OUT_SS + (size_t)DBAT * HB * DK * DV;

constexpr size_t MiB = 1u << 20;
constexpr size_t WS_CTL = 0, CTL_ZERO_BYTES = 64 * 1024;
constexpr size_t WS_WPE = 1 * MiB, WS_WPAB = 2 * MiB, WS_WO = 10 * MiB, WS_WPG = 18 * MiB, WS_PBF = 26 * MiB;
constexpr size_t WS_VSS = 30 * MiB + 512 * 1024;
constexpr size_t WS_TSS = WS_VSS + (size_t)MT * 16 * 4;
constexpr size_t WS_RSTD = WS_TSS + (size_t)MT * 32 * 4;
constexpr size_t WS_DEC = 33 * MiB;
constexpr size_t WS_W1T = 34 * MiB;
constexpr size_t WS_QT = 34 * MiB, WS_ATT = 42 * MiB, WS_KTT = 50 * MiB;
constexpr size_t WS_E = 34 * MiB;
constexpr size_t WS_XN = 76 * MiB, WS_Y = 76 * MiB;
constexpr size_t WS_U = 112 * MiB  , WS_V = 130 * MiB, WS_Q = 166 * MiB, WS_KB = 175 * MiB, WS_VB = 184 * MiB, WS_SZB = 202 * MiB, WS_GA = 220 * MiB, WS_GB = 256 * MiB;
constexpr size_t WS_LA = 292 * MiB;
constexpr size_t WS_O = 58 * MiB;
constexpr size_t WS_SLABA = 112 * MiB;
constexpr size_t WS_M = 148 * MiB;
constexpr size_t WS_T = 184 * MiB;
constexpr size_t WS_H = 112 * MiB;
constexpr size_t WS_ES = 312 * MiB;
constexpr size_t WS_END = 316 * MiB;
static_assert(WS_RSTD + (size_t)MT * 4 <= WS_DEC && WS_DEC + 16 * 32 * 128 * 4 <= WS_W1T && WS_W1T + (size_t)N1 * 2048 * 2 <= WS_XN, "ws map");
constexpr int CW_GRP = 8192;
constexpr int CW_PAN = 9216;
constexpr int CW_BAR = 4096;

constexpr int LDS_BYTES = 155648;
constexpr int MISC_OFF = LDS_BYTES - 256;

#define GAS __attribute__((address_space(1)))
#define LAS __attribute__((address_space(3)))
typedef unsigned short bf16;
typedef unsigned v4u __attribute__((ext_vector_type(4)));
typedef unsigned v2u __attribute__((ext_vector_type(2)));
typedef float f32x4 __attribute__((ext_vector_type(4)));
typedef short bf16x8 __attribute__((ext_vector_type(8)));
typedef GAS unsigned gu32;
#define RLX_AGENT __ATOMIC_RELAXED, __HIP_MEMORY_SCOPE_AGENT
__device__ __forceinline__ unsigned pk2(float lo, float hi) { return pg8::cvt_pk_bf16(lo, hi); }
__device__ __forceinline__ unsigned f2bf(float f) { return pg8::cvt_pk_bf16(f, 0.f) & 0xffffu; }
__device__ __forceinline__ float bflo(unsigned w) { return __uint_as_float(w << 16); }
__device__ __forceinline__ float bfhi(unsigned w) { return __uint_as_float(w & 0xffff0000u); }
__device__ __forceinline__ float bf2f(bf16 h) { return __uint_as_float((unsigned)h << 16); }
__device__ __forceinline__ float sigm(float x) { return __builtin_amdgcn_rcpf(1.f + __expf(-x)); }
__device__ __forceinline__ float wave_sum(float v) {
#pragma unroll
    for (int o = 1; o < 64; o <<= 1) v += __shfl_xor(v, o);
    return v;
}

#define XB_TMO      128
#define XB_XCNT(j)  (256  + 64 * (j))
#define XB_XSUB(j)  (1280 + 64 * (j))
#define XB_XGEN(j)  (2304 + 64 * (j))
#define XB_TOP      3328
#define XB_TOPGEN   3392
#define XCD_BAR_WORDS 3456
#define XB_SPIN_CAP (1u << 18)
__device__ __forceinline__ unsigned xb_ld(unsigned* p)              { return __hip_atomic_load(p, __ATOMIC_RELAXED, __HIP_MEMORY_SCOPE_AGENT); }
__device__ __forceinline__ unsigned xb_add(unsigned* p, unsigned v) { return __hip_atomic_fetch_add(p, v, __ATOMIC_RELAXED, __HIP_MEMORY_SCOPE_AGENT); }
__device__ __forceinline__ unsigned xb_xcc_id() { return (unsigned)__builtin_amdgcn_s_getreg((3 << 11) | 20) & 0xFu; }
#define XB_SPIN(cond, bar) do { unsigned _sp = 0; while (cond) { __builtin_amdgcn_s_sleep(1); \
    if ((++_sp & 255u) == 0u) { if (xb_ld(&(bar)[XB_TMO])) break; if (_sp > XB_SPIN_CAP) { atomicAdd(&(bar)[XB_TMO], 1u); break; } } } } while (0)
struct XcdBarrier { unsigned* bar; unsigned x; volatile LAS unsigned* st; };
__device__ __forceinline__ XcdBarrier xcd_barrier_post(unsigned* bar, volatile LAS unsigned* st) {
    XcdBarrier b; b.bar = bar; b.x = xb_xcc_id(); b.st = st;
    if (threadIdx.x == 0) (void)xb_add(&bar[XB_XCNT(b.x)], 1u);
    return b;
}
__device__ __forceinline__ void xcd_barrier_complete(unsigned* bar, unsigned x, unsigned& nloc, unsigned& nx) {
    const unsigned G = gridDim.x * gridDim.y * gridDim.z;
    unsigned sum, cnt, mine, sp = 0u;
    for (;;) {
        sum = 0u; cnt = 0u; mine = 0u;
#pragma unroll
        for (unsigned j = 0; j < 16; ++j) { const unsigned c = xb_ld(&bar[XB_XCNT(j)]); sum += c; cnt += (c > 0u) ? 1u : 0u; mine = (j == x) ? c : mine; }
        if (sum == G) break;
        __builtin_amdgcn_s_sleep(1);
        if ((++sp & 255u) == 0u) { if (xb_ld(&bar[XB_TMO])) break; if (sp > XB_SPIN_CAP) { atomicAdd(&bar[XB_TMO], 1u); break; } }
    }
    nloc = mine > 0u ? mine : 1u; nx = cnt > 0u ? cnt : 1u;
}
__device__ __forceinline__ void xcd_barrier(const XcdBarrier& b) {
    asm volatile("s_waitcnt vmcnt(0)" ::: "memory");
    __syncthreads();
    if (threadIdx.x == 0) {
        unsigned* bar = b.bar;
        __builtin_amdgcn_s_waitcnt(0);
        unsigned nloc = b.st[0], nx = b.st[1];
        if (nloc == 0u) { xcd_barrier_complete(bar, b.x, nloc, nx); b.st[0] = nloc; b.st[1] = nx; }
        const unsigned old = xb_add(&bar[XB_XSUB(b.x)], 1u);
        const unsigned gen = old / nloc;
        if (old + 1u == (gen + 1u) * nloc) {
            __builtin_amdgcn_fence(__ATOMIC_RELEASE, "agent");
            asm volatile("s_waitcnt vmcnt(0)" ::: "memory");
            const unsigned og = xb_add(&bar[XB_TOP], 1u);
            const unsigned tg = og / nx;
            if (og + 1u == (tg + 1u) * nx) xb_add(&bar[XB_TOPGEN], 1u);
            else XB_SPIN(xb_ld(&bar[XB_TOPGEN]) == tg, bar);
            __builtin_amdgcn_fence(__ATOMIC_ACQUIRE, "agent");
            xb_add(&bar[XB_XGEN(b.x)], 1u);
            asm volatile("s_waitcnt vmcnt(0)" ::: "memory");
        } else {
            XB_SPIN(xb_ld(&bar[XB_XGEN(b.x)]) == gen, bar);
            __builtin_amdgcn_fence(__ATOMIC_ACQUIRE, "agent");
            asm volatile("s_waitcnt vmcnt(0)" ::: "memory");
        }
    }
    __syncthreads();
}

struct Frame {
    LAS unsigned char* lds;
    unsigned char* ws;
    int wave, vcu, G;
    const float *xp, *xs, *pp, *ps, *st0, *g_pre, *w_in, *g_v, *w_s, *b_s, *w_a2, *b_a, *g_o, *w_pa, *w_pb, *w_o, *g_post, *w_pg, *w_pe;
    float* out;
};
__device__ __forceinline__ const float* xrow(const Frame& F, int m) { return m < MP ? F.xp + (size_t)m * DM : F.xs + (size_t)(m - MP) * DM; }

struct ConvItem { const float* src; bf16* dst; int spitch, dpitch; };
constexpr int I_IN = 32 * 320, I_PA = 16 * 64, I_PB = 16 * 64, I_O = 32 * 64, I_PG = 32 * 64, I_PE = 4 * 64, NITEMS = I_IN + I_PA + I_PB + I_O + I_PG + I_PE;
__device__ __forceinline__ void conv_item(const Frame& F, int it, ConvItem& d) {
    int r = it;
    if (r < I_IN) { const int kb = r / 320, n0 = (r % 320) * 32;
        const int src = n0 < 2048 ? ((n0 & 32) ? 2048 : 0) + 128 * (n0 >> 8) + 32 * ((n0 & 255) >> 6) : n0 < 3072 ? n0 - 1024 : n0 + (n0 >= C_ALR ? GR : 0);
        d.src = F.w_in + (size_t)(kb * 64) * NIN + src; d.spitch = NIN; d.dst = (bf16*)(F.ws + WS_W1T) + (size_t)n0 * 2048 + kb * 64; d.dpitch = 2048; return; } r -= I_IN;
    const int k0 = (r / 64) * 64, n0 = (r % 64) * 32; d.spitch = DM; d.dpitch = 2048;
    if (r < I_PA) { d.src = F.w_pa + (size_t)k0 * DM + n0; d.dst = (bf16*)(F.ws + WS_WPAB) + (size_t)n0 * 2048 + k0; return; } r -= I_PA;
    { const int k1 = (r / 64) * 64, n1 = (r % 64) * 32;
      if (r < I_PB) { d.src = F.w_pb + (size_t)k1 * DM + n1; d.dst = (bf16*)(F.ws + WS_WPAB) + (size_t)n1 * 2048 + 1024 + k1; return; } } r -= I_PB;
    { const int k1 = (r / 64) * 64, n1 = (r % 64) * 32;
      if (r < I_O) { d.src = F.w_o + (size_t)k1 * DM + n1; d.dst = (bf16*)(F.ws + WS_WO) + (size_t)n1 * 2048 + k1; return; } } r -= I_O;
    { const int k1 = (r / 64) * 64, n1 = (r % 64) * 32;
      if (r < I_PG) { d.src = F.w_pg + (size_t)k1 * DM + n1; d.dst = (bf16*)(F.ws + WS_WPG) + (size_t)n1 * 2048 + k1; return; } } r -= I_PG;
    { const int k1 = (r / 64) * 64, n1 = (r % 64) * 32; d.src = F.w_pe + (size_t)k1 * DM + n1; d.dst = (bf16*)(F.ws + WS_WPE) + (size_t)n1 * 256 + k1; d.dpitch = 256; }
}
__device__ __forceinline__ void conv_load(const ConvItem& d, f32x4 (&v)[8], int lane) {
    const int r = lane >> 3, c4 = (lane & 7) * 4;
#pragma unroll
    for (int i = 0; i < 8; ++i) v[i] = __builtin_nontemporal_load((const GAS f32x4*)(d.src + (size_t)(8 * i + r) * d.spitch + c4));
}
__device__ __forceinline__ void conv_finish(const ConvItem& d, const f32x4 (&v)[8], LAS float* scr, int lane) {
    const int r = lane >> 3, c4 = (lane & 7) * 4;
#pragma unroll
    for (int i = 0; i < 8; ++i) { LAS float* p = scr + (8 * i + r) * 33 + c4; p[0] = v[i].x; p[1] = v[i].y; p[2] = v[i].z; p[3] = v[i].w; }
    asm volatile("s_waitcnt lgkmcnt(0)" ::: "memory");
    const int c = lane & 7;
#pragma unroll
    for (int j = 0; j < 4; ++j) { const int n = (lane >> 3) + 8 * j; const LAS float* s = scr + (8 * c) * 33 + n;
        v4u o; o.x = pk2(s[0 * 33], s[1 * 33]); o.y = pk2(s[2 * 33], s[3 * 33]); o.z = pk2(s[4 * 33], s[5 * 33]); o.w = pk2(s[6 * 33], s[7 * 33]);
        *(GAS v4u*)(d.dst + (size_t)n * d.dpitch + 8 * c) = o; }
    asm volatile("s_waitcnt lgkmcnt(0)" ::: "memory");
}
__device__ __forceinline__ void p0_prologue(Frame& F) {
    LAS float* scr = (LAS float*)(F.lds + F.wave * 16384);
    const int gw = F.vcu * NWAVES + F.wave, NGW = F.G * NWAVES, ln = (int)(threadIdx.x & 63u);
    bf16* W1T = (bf16*)(F.ws + WS_W1T);
    { f32x4 va[8], vb[8]; ConvItem da, db; int it = gw; bool ha = it < NITEMS;
      if (ha) { conv_item(F, it, da); conv_load(da, va, ln); }
      while (ha) {
          const int it2 = it + NGW; const bool hb = it2 < NITEMS;
          if (hb) { conv_item(F, it2, db); conv_load(db, vb, ln); }
          conv_finish(da, va, scr, ln);
          if (!hb) break;
          it = it2 + NGW; ha = it < NITEMS;
          if (ha) { conv_item(F, it, da); conv_load(da, va, ln); }
          conv_finish(db, vb, scr, ln);
      } }
    {
        const int gt = F.vcu * NTHR + ((int)threadIdx.x), NGT = F.G * NTHR;
        for (int p = gt; p < 512 * 256; p += NGT) { const int ch = p & 511, k0 = (p >> 9) * 8; float wa[16];
#pragma unroll
            for (int r = 0; r < 16; ++r) wa[r] = F.w_a2[r * KBW + ch];
            float t[8];
#pragma unroll
            for (int i = 0; i < 8; ++i) { const GAS f32x4* wr4 = (const GAS f32x4*)(F.w_in + (size_t)(k0 + i) * NIN + C_ALR); float a = 0.f;
#pragma unroll
                for (int r4 = 0; r4 < 4; ++r4) { const f32x4 w = wr4[r4]; a += w.x * wa[4 * r4] + w.y * wa[4 * r4 + 1] + w.z * wa[4 * r4 + 2] + w.w * wa[4 * r4 + 3]; }
                t[i] = a; }
            v4u o; o.x = pk2(t[0], t[1]); o.y = pk2(t[2], t[3]); o.z = pk2(t[4], t[5]); o.w = pk2(t[6], t[7]);
            *(GAS v4u*)(W1T + (size_t)(10240 + ch) * 2048 + k0) = o; }
        bf16* PBF = (bf16*)(F.ws + WS_PBF);
        for (int p = gt; p < MT * PLE / 8; p += NGT) { const size_t e = (size_t)p * 8; const float* src = e < (size_t)MP * PLE ? F.pp + e : F.ps + (e - (size_t)MP * PLE);
            const f32x4 a = __builtin_nontemporal_load((const GAS f32x4*)src), b = __builtin_nontemporal_load((const GAS f32x4*)(src + 4)); v4u o; o.x = pk2(a.x, a.y); o.y = pk2(a.z, a.w); o.z = pk2(b.x, b.y); o.w = pk2(b.z, b.w);
            *(GAS v4u*)(PBF + e) = o; }
    }
    bf16* XN = (bf16*)(F.ws + WS_XN);
    { const GAS f32x4* gr = (const GAS f32x4*)F.g_pre + ln; f32x4 va[8], vb[8]; int m = gw; bool ha = m < MT;
#define XN_LOAD(v, mm) do { const GAS f32x4* xr_ = (const GAS f32x4*)xrow(F, (mm)) + ln; _Pragma("unroll") for (int j_ = 0; j_ < 8; ++j_) v[j_] = __builtin_nontemporal_load(xr_ + 64 * j_); } while (0)
#define XN_FINISH(v, mm) do { float s_ = 0.f; _Pragma("unroll") for (int j_ = 0; j_ < 8; ++j_) s_ += (v[j_].x * v[j_].x + v[j_].y * v[j_].y) + (v[j_].z * v[j_].z + v[j_].w * v[j_].w); \
        const float rstd_ = 1.0f / sqrtf(wave_sum(s_) * (1.f / DM) + EPS); GAS v2u* o8_ = (GAS v2u*)(XN + (size_t)(mm) * DM) + ln; \
        _Pragma("unroll") for (int j_ = 0; j_ < 8; ++j_) { const f32x4 gg_ = gr[64 * j_]; v2u o_; o_.x = pk2(v[j_].x * rstd_ * gg_.x, v[j_].y * rstd_ * gg_.y); o_.y = pk2(v[j_].z * rstd_ * gg_.z, v[j_].w * rstd_ * gg_.w); o8_[64 * j_] = o_; } } while (0)
      if (ha) XN_LOAD(va, m);
      while (ha) {
          const int m2 = m + NGW; const bool hb = m2 < MT;
          if (hb) XN_LOAD(vb, m2);
          XN_FINISH(va, m);
          if (!hb) break;
          m = m2 + NGW; ha = m < MT;
          if (ha) XN_LOAD(va, m);
          XN_FINISH(vb, m2);
      }
#undef XN_LOAD
#undef XN_FINISH
    }
}

using pg8::Unit;
template <int ACT>
__device__ __forceinline__ void g1_store(const pg8::f32x4 (&acc)[2][2][4][2], bf16* base, int ldc, int row0, int col0, float* vss, int wc, int fq) {
#pragma unroll
    for (int ai = 0; ai < 2; ++ai)
#pragma unroll
        for (int m = 0; m < 4; ++m) { const int row = row0 + ai * 128 + m * 16; bf16* rowp = base + (size_t)row * ldc + col0; float ss = 0.f;
#pragma unroll
            for (int bj = 0; bj < 2; ++bj) { float v[8];
#pragma unroll
                for (int e = 0; e < 8; ++e) { float x = acc[ai][bj][m][e >> 2][e & 3];
                    if (ACT == 1) x = x * sigm(x); else if (ACT == 2) x = sigm(x); else if (ACT == 3) x = x * 0.08838834764831845f;
                    if (ACT == 4) ss += x * x; v[e] = x; }
                v4u w; w.x = pg8::cvt_pk_bf16(v[0], v[1]); w.y = pg8::cvt_pk_bf16(v[2], v[3]); w.z = pg8::cvt_pk_bf16(v[4], v[5]); w.w = pg8::cvt_pk_bf16(v[6], v[7]);
                *(GAS v4u*)(rowp + bj * 32) = w; }
            if (ACT == 4) { ss += __shfl_xor(ss, 16); ss += __shfl_xor(ss, 32); if (fq == 0) vss[(size_t)row * 16 + wc] = ss; } }
}
__device__ __forceinline__ float log_sigmoid(float z) { return -(fmaxf(-z, 0.f) + __logf(1.f + __expf(-fabsf(z)))); }
__device__ __forceinline__ unsigned q8(float x) { const unsigned q = (unsigned)__builtin_fmaf(sigm(x), 255.f, 0.5f); return q < 1u ? 1u : q; }
__device__ __forceinline__ void g1_store_u8(const pg8::f32x4 (&acc)[2][2][4][2], unsigned char* base, int row0, int col0) {
#pragma unroll
    for (int ai = 0; ai < 2; ++ai)
#pragma unroll
        for (int m = 0; m < 4; ++m) { unsigned char* rowp = base + (size_t)(row0 + ai * 128 + m * 16) * DM + col0;
#pragma unroll
            for (int bj = 0; bj < 2; ++bj) { const pg8::f32x4 a = acc[ai][bj][m][0], b = acc[ai][bj][m][1]; v2u w;
                w.x = q8(a.x) | (q8(a.y) << 8) | (q8(a.z) << 16) | (q8(a.w) << 24); w.y = q8(b.x) | (q8(b.y) << 8) | (q8(b.z) << 16) | (q8(b.w) << 24);
                *(GAS v2u*)(rowp + bj * 32) = w; } }
}
__device__ __forceinline__ void u8x8_to_f32(v2u w, float (&f)[8]) {
    f[0] = (float)(w.x & 0xffu); f[1] = (float)((w.x >> 8) & 0xffu); f[2] = (float)((w.x >> 16) & 0xffu); f[3] = (float)(w.x >> 24);
    f[4] = (float)(w.y & 0xffu); f[5] = (float)((w.y >> 8) & 0xffu); f[6] = (float)((w.y >> 16) & 0xffu); f[7] = (float)(w.y >> 24);
}
struct EpiG1 {
    static constexpr bool PERM = true, HAS_MID = false;
    unsigned char* ws; const float* b_a;
    __device__ __forceinline__ void operator()(const pg8::f32x4 (&acc)[2][2][4][2], const Unit& u, int wr, int wc, int fr, int fq) const {
        const int pn = u.pn, row0 = u.pm * 256 + wr * 64 + fr, cin = wc * 64 + 8 * fq;
        if (pn < 8) {
            bf16* UZ = (bf16*)(ws + WS_U);
#pragma unroll
            for (int ai = 0; ai < 2; ++ai)
#pragma unroll
                for (int m = 0; m < 4; ++m) { const pg8::f32x4 u0 = acc[ai][0][m][0], u1 = acc[ai][0][m][1], z0 = acc[ai][1][m][0], z1 = acc[ai][1][m][1]; v4u w;
                    w.x = pg8::cvt_pk_bf16(u0.x * z0.x * sigm(z0.x), u0.y * z0.y * sigm(z0.y)); w.y = pg8::cvt_pk_bf16(u0.z * z0.z * sigm(z0.z), u0.w * z0.w * sigm(z0.w));
                    w.z = pg8::cvt_pk_bf16(u1.x * z1.x * sigm(z1.x), u1.y * z1.y * sigm(z1.y)); w.w = pg8::cvt_pk_bf16(u1.z * z1.z * sigm(z1.z), u1.w * z1.w * sigm(z1.w));
                    *(GAS v4u*)(UZ + (size_t)(row0 + ai * 128 + m * 16) * EA + pn * 128 + wc * 32 + 8 * fq) = w; } }
        else if (pn < 12) g1_store<4>(acc, (bf16*)(ws + WS_V), 1024, row0, (pn - 8) * 256 + cin, (float*)(ws + WS_VSS) + (pn - 8) * 4, wc, fq);
        else if (pn < 14) g1_store<3>(acc, (bf16*)(ws + WS_Q), 512, row0, (pn - 12) * 256 + cin, nullptr, wc, fq);
        else if (pn < 16) g1_store<0>(acc, (bf16*)(ws + WS_KB), 512, row0, (pn - 14) * 256 + cin, nullptr, wc, fq);
        else if (pn < 20) g1_store<0>(acc, (bf16*)(ws + WS_VB), 1024, row0, (pn - 16) * 256 + cin, nullptr, wc, fq);
        else if (pn < 24) g1_store<1>(acc, (bf16*)(ws + WS_SZB), 1024, row0, (pn - 20) * 256 + cin, nullptr, wc, fq);
        else if (pn < 32) g1_store_u8(acc, ws + WS_GA, row0, (pn - 24) * 256 + cin);
        else if (pn < 40) g1_store_u8(acc, ws + WS_GB, row0, (pn - 32) * 256 + cin);
        else {
            float* la = (float*)(ws + WS_LA); const int c0 = (pn - 40) * 256 + cin;
            pg8::f32x4 bb[2][2];
#pragma unroll
            for (int bj = 0; bj < 2; ++bj) { bb[bj][0] = *(const GAS pg8::f32x4*)(b_a + c0 + bj * 32); bb[bj][1] = *(const GAS pg8::f32x4*)(b_a + c0 + bj * 32 + 4); }
#pragma unroll
            for (int ai = 0; ai < 2; ++ai)
#pragma unroll
                for (int m = 0; m < 4; ++m) { float* rp = la + (size_t)(row0 + ai * 128 + m * 16) * KBW + c0;
#pragma unroll
                    for (int bj = 0; bj < 2; ++bj)
#pragma unroll
                        for (int n = 0; n < 2; ++n) { const pg8::f32x4 z = acc[ai][bj][m][n] + bb[bj][n]; pg8::f32x4 o;
                            o.x = log_sigmoid(z.x) * 0.0625f; o.y = log_sigmoid(z.y) * 0.0625f; o.z = log_sigmoid(z.z) * 0.0625f; o.w = log_sigmoid(z.w) * 0.0625f;
                            *(GAS pg8::f32x4*)(rp + bj * 32 + n * 4) = o; } }
        }
    }
};
struct EpiBf {
    static constexpr bool PERM = true, HAS_MID = false;
    bf16* O; int ldc;
    __device__ __forceinline__ void operator()(const pg8::f32x4 (&acc)[2][2][4][2], const Unit& u, int wr, int wc, int fr, int fq) const {
        g1_store<0>(acc, O, ldc, u.pm * 256 + wr * 64 + fr, u.pn * 256 + wc * 64 + 8 * fq, nullptr, wc, fq);
    }
};
template <bool PERM>
__device__ __forceinline__ void slab_store(const pg8::f32x4 (&acc)[2][2][4][2], bf16* lo, bf16* hi, const Unit& u, int wr, int wc, int fr, int fq) {
    const int ks = u.kt0 >> 2; bf16* sl = ks < 4 ? lo + (size_t)ks * MS * DM : hi + (size_t)(ks - 4) * MS * DM;
    const int row0 = (u.pm - 32) * 256 + wr * 64 + fr, col0 = u.pn * 256 + wc * 64 + (PERM ? 8 : 4) * fq;
#pragma unroll
    for (int ai = 0; ai < 2; ++ai)
#pragma unroll
        for (int m = 0; m < 4; ++m) { bf16* rp = sl + (size_t)(row0 + ai * 128 + m * 16) * DM + col0;
#pragma unroll
            for (int bj = 0; bj < 2; ++bj) {
                if (PERM) { const pg8::f32x4 a = acc[ai][bj][m][0], b = acc[ai][bj][m][1]; *(GAS v4u*)(rp + bj * 32) = (v4u){pk2(a.x, a.y), pk2(a.z, a.w), pk2(b.x, b.y), pk2(b.z, b.w)}; }
                else {
#pragma unroll
                    for (int n = 0; n < 2; ++n) { const pg8::f32x4 a = acc[ai][bj][m][n]; *(GAS v2u*)(rp + bj * 32 + n * 16) = (v2u){pk2(a.x, a.y), pk2(a.z, a.w)}; } } } }
}
__device__ __forceinline__ const bf16* slab_ptr(const bf16* lo, const bf16* hi, int ks) { return ks < 4 ? lo + (size_t)ks * MS * DM : hi + (size_t)(ks - 4) * MS * DM; }
__device__ __forceinline__ void slab_sum8(const bf16* lo, const bf16* hi, size_t off, int k0, int k1, pg8::f32x4& s0, pg8::f32x4& s1) {
    s0 = (pg8::f32x4){0.f, 0.f, 0.f, 0.f}; s1 = s0;
#pragma unroll
    for (int ks = 0; ks < 8; ++ks) if (ks >= k0 && ks < k1) { const v4u w = *(const GAS v4u*)(slab_ptr(lo, hi, ks) + off);
        s0.x += bflo(w.x); s0.y += bfhi(w.x); s0.z += bflo(w.y); s0.w += bfhi(w.y); s1.x += bflo(w.z); s1.y += bfhi(w.z); s1.z += bflo(w.w); s1.w += bfhi(w.w); }
}
__device__ __forceinline__ pg8::f32x4 slab_sum4(const bf16* lo, const bf16* hi, size_t off) {
    pg8::f32x4 a = (pg8::f32x4){0.f, 0.f, 0.f, 0.f};
#pragma unroll
    for (int ks = 0; ks < 8; ++ks) { const v2u w = *(const GAS v2u*)(slab_ptr(lo, hi, ks) + off); a.x += bflo(w.x); a.y += bfhi(w.x); a.z += bflo(w.y); a.w += bfhi(w.y); }
    return a;
}
struct EpiG2 {
    static constexpr bool PERM = true, HAS_MID = true;
    const unsigned char* GA; const unsigned char* GB; bf16* Mo; bf16* slo; bf16* shi;
    __device__ __forceinline__ void mid(pg8::f32x4 (&acc)[2][2][4][2], const Unit& u, int wr, int wc, int fr, int fq) const {
        asm volatile("" : "+v"(fr));
        const unsigned off0 = (unsigned)((u.pm * 256 + wr * 64 + fr) * DM + u.pn * 256 + wc * 64 + 8 * fq);
#pragma unroll
        for (int ai = 0; ai < 2; ++ai)
#pragma unroll
            for (int m = 0; m < 4; ++m) { const unsigned off = off0 + (unsigned)((ai * 128 + m * 16) * DM);
#pragma unroll
                for (int bj = 0; bj < 2; ++bj) { const v2u a = *(const GAS v2u*)(GA + off + bj * 32), b = *(const GAS v2u*)(GB + off + bj * 32); float fa[8], fb[8]; u8x8_to_f32(a, fa); u8x8_to_f32(b, fb);
#pragma unroll
                    for (int e = 0; e < 8; ++e) acc[ai][bj][m][e >> 2][e & 3] *= fa[e] * __builtin_amdgcn_rcpf(fb[e]); }
                if (m == 3) asm volatile("" ::: "memory"); }
    }
    __device__ __forceinline__ void operator()(const pg8::f32x4 (&acc)[2][2][4][2], const Unit& u, int wr, int wc, int fr, int fq) const {
        if (u.kind) { slab_store<true>(acc, slo, shi, u, wr, wc, fr, fq); return; }
        const int row0 = u.pm * 256 + wr * 64 + fr, col0 = u.pn * 256 + wc * 64 + 8 * fq;
#pragma unroll
        for (int ai = 0; ai < 2; ++ai)
#pragma unroll
            for (int m = 0; m < 4; ++m) { const size_t off = (size_t)(row0 + ai * 128 + m * 16) * DM + col0;
#pragma unroll
                for (int bj = 0; bj < 2; ++bj) { const v2u b = *(const GAS v2u*)(GB + off + bj * 32); float fb[8]; u8x8_to_f32(b, fb); unsigned w[4];
#pragma unroll
                    for (int p = 0; p < 4; ++p) w[p] = pg8::cvt_pk_bf16(acc[ai][bj][m][p >> 1][(p & 1) * 2] * (fb[2 * p] * (1.f / 255.f)), acc[ai][bj][m][p >> 1][(p & 1) * 2 + 1] * (fb[2 * p + 1] * (1.f / 255.f)));
                    *(GAS v4u*)(Mo + off + bj * 32) = (v4u){w[0], w[1], w[2], w[3]}; }
                if (m & 1) asm volatile("" ::: "memory"); }
    }
};
struct EpiG3 {
    static constexpr bool PERM = true, HAS_MID = false;
    bf16* T; float* tss; bf16* slo; bf16* shi;
    int fused; bf16* H; float* xs; unsigned* cnt; const float* xp; const float* gpost; LAS unsigned char* lx;
    __device__ __forceinline__ void operator()(const pg8::f32x4 (&acc)[2][2][4][2], const Unit& u, int wr, int wc, int fr, int fq) const {
        if (u.kind) { slab_store<true>(acc, slo, shi, u, wr, wc, fr, fq); return; }
        const int row0 = u.pm * 256 + wr * 64 + fr, col0 = u.pn * 256 + wc * 64 + 8 * fq;
        if (!fused) {
#pragma unroll
            for (int ai = 0; ai < 2; ++ai)
#pragma unroll
                for (int m = 0; m < 4; ++m) { const int row = row0 + ai * 128 + m * 16; bf16* rowp = T + (size_t)row * DM + col0; float ss = 0.f;
#pragma unroll
                    for (int bj = 0; bj < 2; ++bj) { const pg8::f32x4 a = acc[ai][bj][m][0], b = acc[ai][bj][m][1];
                        ss += (a.x * a.x + a.y * a.y) + (a.z * a.z + a.w * a.w) + (b.x * b.x + b.y * b.y) + (b.z * b.z + b.w * b.w);
                        v4u w; w.x = pg8::cvt_pk_bf16(a.x, a.y); w.y = pg8::cvt_pk_bf16(a.z, a.w); w.z = pg8::cvt_pk_bf16(b.x, b.y); w.w = pg8::cvt_pk_bf16(b.z, b.w);
                        *(GAS v4u*)(rowp + bj * 32) = w; }
                    ss += __shfl_xor(ss, 16); ss += __shfl_xor(ss, 32); if (fq == 0) tss[(size_t)row * 32 + u.pn * 4 + wc] = ss; }
            return;
        }
        LAS float* P = (LAS float*)lx; LAS float* S = P + 1024; volatile LAS unsigned* flag = (volatile LAS unsigned*)(S + 256);
        const int tid = threadIdx.x, lane = tid & 63, wid = __builtin_amdgcn_readfirstlane(tid >> 6);
#pragma unroll
        for (int ai = 0; ai < 2; ++ai)
#pragma unroll
            for (int m = 0; m < 4; ++m) { float ss = 0.f;
#pragma unroll
                for (int bj = 0; bj < 2; ++bj) { const pg8::f32x4 a = acc[ai][bj][m][0], b = acc[ai][bj][m][1]; ss += (a.x * a.x + a.y * a.y) + (a.z * a.z + a.w * a.w) + (b.x * b.x + b.y * b.y) + (b.z * b.z + b.w * b.w); }
                ss += __shfl_xor(ss, 16); ss += __shfl_xor(ss, 32); if (fq == 0) P[(ai * 128 + wr * 64 + m * 16 + fr) * 4 + wc] = ss; }
        asm volatile("s_waitcnt lgkmcnt(0)" ::: "memory"); __builtin_amdgcn_s_barrier(); asm volatile("" ::: "memory");
        if (tid < 256) { const pg8::f32x4 p = *(const LAS pg8::f32x4*)(P + tid * 4);
            __hip_atomic_store(xs + (size_t)(u.pm * 256 + tid) * 8 + u.pn, (p.x + p.y) + (p.z + p.w), __ATOMIC_RELAXED, __HIP_MEMORY_SCOPE_AGENT); }
        asm volatile("s_waitcnt vmcnt(0)" ::: "memory");
        if (tid < 256 && lane == 0) (void)__hip_atomic_fetch_add(cnt + 64 * u.pm, 1u, __ATOMIC_RELAXED, __HIP_MEMORY_SCOPE_AGENT);
        if (wid == 0) { unsigned sp = 0;
            while ((unsigned)__builtin_amdgcn_readfirstlane(__hip_atomic_load(cnt + 64 * u.pm, __ATOMIC_RELAXED, __HIP_MEMORY_SCOPE_AGENT)) < 32u) { __builtin_amdgcn_s_sleep(2); if (++sp > (1u << 20)) break; }
            __builtin_amdgcn_fence(__ATOMIC_ACQUIRE, "agent"); asm volatile("s_waitcnt vmcnt(0)" ::: "memory"); if (lane == 0) flag[0] = 1u; }
        asm volatile("s_waitcnt lgkmcnt(0)" ::: "memory"); __builtin_amdgcn_s_barrier(); asm volatile("" ::: "memory");
        if (tid < 256) { const float* sl = xs + (size_t)(u.pm * 256 + tid) * 8; float t = 0.f;
#pragma unroll
            for (int q = 0; q < 8; ++q) t += __hip_atomic_load(sl + q, __ATOMIC_RELAXED, __HIP_MEMORY_SCOPE_AGENT);
            S[tid] = 1.0f / sqrtf(t * (1.f / DM) + EPS); }
        asm volatile("s_waitcnt lgkmcnt(0)" ::: "memory"); __builtin_amdgcn_s_barrier(); asm volatile("" ::: "memory");
        pg8::f32x4 gp[2][2];
#pragma unroll
        for (int bj = 0; bj < 2; ++bj) { gp[bj][0] = *(const GAS pg8::f32x4*)(gpost + col0 + bj * 32); gp[bj][1] = *(const GAS pg8::f32x4*)(gpost + col0 + bj * 32 + 4); }
#pragma unroll
        for (int ai = 0; ai < 2; ++ai)
#pragma unroll
            for (int m = 0; m < 4; ++m) { const int rl = ai * 128 + wr * 64 + m * 16 + fr; const float rs = S[rl]; const size_t off = (size_t)(u.pm * 256 + rl) * DM + col0;
#pragma unroll
                for (int bj = 0; bj < 2; ++bj) { const pg8::f32x4 x0 = *(const GAS pg8::f32x4*)(xp + off + bj * 32), x1 = *(const GAS pg8::f32x4*)(xp + off + bj * 32 + 4); const pg8::f32x4 a = acc[ai][bj][m][0], b = acc[ai][bj][m][1], g0 = gp[bj][0], g1 = gp[bj][1];
                    v4u w; w.x = pg8::cvt_pk_bf16(x0.x + a.x * rs * g0.x, x0.y + a.y * rs * g0.y); w.y = pg8::cvt_pk_bf16(x0.z + a.z * rs * g0.z, x0.w + a.w * rs * g0.w);
                    w.z = pg8::cvt_pk_bf16(x1.x + b.x * rs * g1.x, x1.y + b.y * rs * g1.y); w.w = pg8::cvt_pk_bf16(x1.z + b.z * rs * g1.z, x1.w + b.w * rs * g1.w);
                    *(GAS v4u*)(H + off + bj * 32) = w; }
                if (m & 1) asm volatile("" ::: "memory"); }
    }
};
struct EpiG4 {
    static constexpr bool PERM = true, HAS_MID = false;
    const bf16 *H, *E; float* out; bf16* slo; bf16* shi;
    __device__ __forceinline__ void operator()(const pg8::f32x4 (&acc)[2][2][4][2], const Unit& u, int wr, int wc, int fr, int fq) const {
        if (u.kind) { slab_store<true>(acc, slo, shi, u, wr, wc, fr, fq); return; }
        const int row0 = u.pm * 256 + wr * 64 + fr, col0 = u.pn * 256 + wc * 64 + 8 * fq;
#pragma unroll
        for (int ai = 0; ai < 2; ++ai)
#pragma unroll
            for (int m = 0; m < 4; ++m) {
#pragma unroll
                for (int bj = 0; bj < 2; ++bj) { const size_t o2 = (size_t)(row0 + ai * 128 + m * 16) * DM + col0 + bj * 32; const v4u h4 = *(const GAS v4u*)(H + o2), e4 = *(const GAS v4u*)(E + o2);
                    const pg8::f32x4 a = acc[ai][bj][m][0], b = acc[ai][bj][m][1];
                    pg8::f32x4 o0, o1; o0.x = bflo(h4.x) + sigm(a.x) * bflo(e4.x); o0.y = bfhi(h4.x) + sigm(a.y) * bfhi(e4.x); o0.z = bflo(h4.y) + sigm(a.z) * bflo(e4.y); o0.w = bfhi(h4.y) + sigm(a.w) * bfhi(e4.y);
                    o1.x = bflo(h4.z) + sigm(b.x) * bflo(e4.z); o1.y = bfhi(h4.z) + sigm(b.y) * bfhi(e4.z); o1.z = bflo(h4.w) + sigm(b.z) * bflo(e4.w); o1.w = bfhi(h4.w) + sigm(b.w) * bfhi(e4.w);
                    *(GAS pg8::f32x4*)(out + o2) = o0; *(GAS pg8::f32x4*)(out + o2 + 4) = o1; }
                asm volatile("" ::: "memory"); }
    }
};

constexpr int GWP = 136, GVP = 68;
__device__ __forceinline__ void gate_prompt_unit(Frame& F, int unit) {
    int tid = ((int)threadIdx.x); asm volatile("" : "+v"(tid));
    const int g = unit & 3, c = (unit >> 2) & 15, b = unit >> 6, r0 = b * SEQ + c * CH, lane = tid & 63, wave = F.wave, fr = lane & 15, fq = lane >> 4;
    LAS bf16* WL = (LAS bf16*)F.lds;
    LAS unsigned* VT = (LAS unsigned*)(F.lds + 128 * GWP * 2);
    LAS float* RS = (LAS float*)(F.lds + 128 * GWP * 2 + 256 * GVP * 4);
    const bf16* U = (const bf16*)(F.ws + WS_U); const bf16* V = (const bf16*)(F.ws + WS_V); const float* VSS = (const float*)(F.ws + WS_VSS);
    bf16* Y = (bf16*)(F.ws + WS_Y);
    __syncthreads();
    if (tid < 128) { const GAS f32x4* p = (const GAS f32x4*)(VSS + (size_t)(r0 + tid) * 16); const f32x4 a = p[0], b4 = p[1], c4 = p[2], d4 = p[3];
        const float ss = ((a.x + a.y) + (a.z + a.w)) + ((b4.x + b4.y) + (b4.z + b4.w)) + ((c4.x + c4.y) + (c4.z + c4.w)) + ((d4.x + d4.y) + (d4.z + d4.w));
        RS[tid] = 1.0f / sqrtf(ss * (1.f / EA) + EPS); }
    { const float* W = F.w_s + (size_t)g * CH * CH;
#pragma unroll
      for (int i = 0; i < 4; ++i) { const int p = tid + NTHR * i, t = p >> 4, s8 = (p & 15) * 8; const f32x4 w0 = *(const GAS f32x4*)(W + t * CH + s8), w1 = *(const GAS f32x4*)(W + t * CH + s8 + 4); v4u o;
          o.x = pk2(s8 <= t ? w0.x : 0.f, s8 + 1 <= t ? w0.y : 0.f); o.y = pk2(s8 + 2 <= t ? w0.z : 0.f, s8 + 3 <= t ? w0.w : 0.f);
          o.z = pk2(s8 + 4 <= t ? w1.x : 0.f, s8 + 5 <= t ? w1.y : 0.f); o.w = pk2(s8 + 6 <= t ? w1.z : 0.f, s8 + 7 <= t ? w1.w : 0.f);
          *(LAS v4u*)(WL + t * GWP + s8) = o; } }
    __syncthreads();
#pragma unroll
    for (int i = 0; i < 4; ++i) { const int idx = tid + NTHR * i, cg = ((idx >> 5) & 3) * 8 + (idx & 7), sp = (idx >> 7) * 4 + ((idx >> 3) & 3), s0 = 2 * sp;
        const v4u ra = *(const GAS v4u*)(V + (size_t)(r0 + s0) * EA + g * DV + 8 * cg), rb = *(const GAS v4u*)(V + (size_t)(r0 + s0 + 1) * EA + g * DV + 8 * cg);
        const GAS f32x4* gv = (const GAS f32x4*)(F.g_v + g * DV + 8 * cg); const f32x4 g0 = gv[0], g1 = gv[1]; const float ra_s = RS[s0], rb_s = RS[s0 + 1];
        const float gg[8] = {g0.x, g0.y, g0.z, g0.w, g1.x, g1.y, g1.z, g1.w}; const unsigned wa[4] = {ra.x, ra.y, ra.z, ra.w}, wb[4] = {rb.x, rb.y, rb.z, rb.w};
        LAS unsigned* dst = VT + (8 * cg) * GVP + (sp ^ (4 * (cg & 7)));
#pragma unroll
        for (int e = 0; e < 4; ++e) { dst[(2 * e) * GVP] = pk2(bflo(wa[e]) * ra_s * gg[2 * e], bflo(wb[e]) * rb_s * gg[2 * e]); dst[(2 * e + 1) * GVP] = pk2(bfhi(wa[e]) * ra_s * gg[2 * e + 1], bfhi(wb[e]) * rb_s * gg[2 * e + 1]); } }
    __syncthreads();
    pg8::f32x4 acc[16];
#pragma unroll
    for (int q = 0; q < 16; ++q) acc[q] = (pg8::f32x4){0.f, 0.f, 0.f, 0.f};
    const int nkk = (wave >> 1) + 1;
    for (int kk = 0; kk < nkk; ++kk) { const bf16x8 bw = *(const LAS bf16x8*)(WL + (16 * wave + fr) * GWP + 32 * kk + 8 * fq);
#pragma unroll
        for (int q = 0; q < 16; ++q) { const int d = 64 * (q >> 2) + 16 * (fr >> 2) + 4 * (q & 3) + (fr & 3);
            const bf16x8 af = *(const LAS bf16x8*)(VT + d * GVP + ((16 * kk + 4 * fq) ^ (4 * ((d >> 3) & 7))));
            acc[q] = __builtin_amdgcn_mfma_f32_16x16x32_bf16(af, bw, acc[q], 0, 0, 0); } }
    { const int t = 16 * wave + fr; const float bs = F.b_s[g * CH + t];
#pragma unroll
      for (int G4 = 0; G4 < 4; ++G4) { const size_t o1 = (size_t)(r0 + t) * EA + g * DV + 64 * G4 + 16 * fq; const v4u u0 = *(const GAS v4u*)(U + o1), u1 = *(const GAS v4u*)(U + o1 + 8);
          const unsigned uw[8] = {u0.x, u0.y, u0.z, u0.w, u1.x, u1.y, u1.z, u1.w}; unsigned yw[8];
#pragma unroll
          for (int n = 0; n < 4; ++n) { const pg8::f32x4 sv = acc[G4 * 4 + n];
              yw[2 * n] = pk2(bflo(uw[2 * n]) * (sv.x + bs), bfhi(uw[2 * n]) * (sv.y + bs));
              yw[2 * n + 1] = pk2(bflo(uw[2 * n + 1]) * (sv.z + bs), bfhi(uw[2 * n + 1]) * (sv.w + bs)); }
          bf16* yp = Y + (size_t)(r0 + t) * DM + g * DV + 64 * G4 + 16 * fq;
          *(GAS v4u*)yp = (v4u){yw[0], yw[1], yw[2], yw[3]}; *(GAS v4u*)(yp + 8) = (v4u){yw[4], yw[5], yw[6], yw[7]}; } }
}

__device__ __forceinline__ void sample_unit(Frame& F, int unit) {
    int tid = ((int)threadIdx.x); asm volatile("" : "+v"(tid));
    const int h = unit & 3, sb = unit >> 2, r0 = MP + sb * DSEQ, lane = tid & 63, wave = F.wave;
    LAS float* L = (LAS float*)F.lds;
    LAS float* QT = L; LAS float* KT = L + 1024; LAS float* KD = L + 2048; LAS float* DC = L + 3072; LAS float* ATT = L + 3200; LAS float* RS = L + 3264; LAS float* QS = L + 3400; LAS float* RED = L + 4608;
    const bf16* Vb = (const bf16*)(F.ws + WS_V); const bf16* U = (const bf16*)(F.ws + WS_U); const float* VSS = (const float*)(F.ws + WS_VSS);
    const bf16* Q = (const bf16*)(F.ws + WS_Q); const bf16* KBp = (const bf16*)(F.ws + WS_KB); const bf16* VB = (const bf16*)(F.ws + WS_VB); const bf16* SZB = (const bf16*)(F.ws + WS_SZB);
    const float* LAg = (const float*)(F.ws + WS_LA); bf16* Y = (bf16*)(F.ws + WS_Y);
    const int d = tid & 255, th = tid >> 8, col = h * DV + d, v4 = lane, dg = wave, chp = h * DK + (tid & 127);
    f32x4 ssv[4]; float bsv = 0.f; if (tid < 8) { const GAS f32x4* p = (const GAS f32x4*)(VSS + (size_t)(r0 + tid) * 16); ssv[0] = p[0]; ssv[1] = p[1]; ssv[2] = p[2]; ssv[3] = p[3]; bsv = F.b_s[h * CH + tid]; }
    float wsv = 0.f; if (tid < 64) wsv = F.w_s[(size_t)h * CH * CH + (tid >> 3) * CH + (tid & 7)];
    bf16 vraw[8], uraw[4];
#pragma unroll
    for (int s2 = 0; s2 < 8; ++s2) vraw[s2] = Vb[(size_t)(r0 + s2) * EA + col];
#pragma unroll
    for (int i = 0; i < 4; ++i) uraw[i] = U[(size_t)(r0 + th * 4 + i) * EA + col];
    const float gv = F.g_v[col];
    float laraw[8]; bf16 qraw[8], kraw[8];
    if (tid < 128) {
#pragma unroll
        for (int t = 0; t < 8; ++t) { laraw[t] = LAg[(size_t)(r0 + t) * KBW + chp]; qraw[t] = Q[(size_t)(r0 + t) * KBW + chp]; kraw[t] = KBp[(size_t)(r0 + t) * KBW + chp]; } }
    v2u vvraw[8];
#pragma unroll
    for (int s2 = 0; s2 < 8; ++s2) vvraw[s2] = *(const GAS v2u*)(VB + (size_t)(r0 + s2) * EB + h * DV + 4 * v4);
    const v2u zz = *(const GAS v2u*)(SZB + (size_t)(r0 + wave) * EB + h * DV + 4 * v4); const f32x4 go = *(const GAS f32x4*)(F.g_o + h * DV + 4 * v4);
    const float* S0 = F.st0 + ((size_t)(sb * HB + h) * DK) * DV; float* SN = F.out + OUT_SS + ((size_t)(sb * HB + h) * DK) * DV;
    f32x4 s0r[16];
#pragma unroll
    for (int dd = 0; dd < 16; ++dd) s0r[dd] = __builtin_nontemporal_load((const GAS f32x4*)(S0 + (size_t)(dg * 16 + dd) * DV + 4 * v4));
    __syncthreads();
    if (tid < 8) { const f32x4 a = ssv[0], b4 = ssv[1], c4 = ssv[2], d4 = ssv[3];
        const float ss = ((a.x + a.y) + (a.z + a.w)) + ((b4.x + b4.y) + (b4.z + b4.w)) + ((c4.x + c4.y) + (c4.z + c4.w)) + ((d4.x + d4.y) + (d4.z + d4.w));
        RS[tid] = 1.0f / sqrtf(ss * (1.f / EA) + EPS); RS[8 + tid] = bsv; }
    if (tid < 64) RS[16 + tid] = wsv;
    __syncthreads();
    {
        float vn[8];
#pragma unroll
        for (int s2 = 0; s2 < 8; ++s2) vn[s2] = bf2f(vraw[s2]) * RS[s2] * gv;
#pragma unroll
        for (int i = 0; i < 4; ++i) { const int t = th * 4 + i; float S = RS[8 + t];
#pragma unroll
            for (int s2 = 0; s2 < 8; ++s2) if (s2 <= t) S += RS[16 + t * 8 + s2] * vn[s2];
            Y[(size_t)(r0 + t) * DM + col] = (bf16)f2bf(bf2f(uraw[i]) * S);
            float vt = 0.f;
#pragma unroll
            for (int s2 = 0; s2 < 8; ++s2) vt = (s2 == t) ? vn[s2] : vt;
            F.out[OUT_CV + (size_t)(sb * DSEQ + t) * EA + col] = vt; }
    }
    if (tid < 128) { const int dq = tid; float bc[8]; float run = 0.f;
#pragma unroll
        for (int t = 0; t < 8; ++t) { run += laraw[t]; bc[t] = run; }
        const float dcv = __expf(run); DC[dq] = dcv;
#pragma unroll
        for (int t = 0; t < 8; ++t) { const float q = bf2f(qraw[t]), k = bf2f(kraw[t]);
            const float eb = __expf(bc[t]), ek = __builtin_amdgcn_rcpf(eb); const float qt = q * eb, kt = k * ek; QT[dq * 8 + t] = qt; QS[t * 128 + dq] = qt; KT[t * 128 + dq] = kt; KD[dq * 8 + t] = kt * dcv; }
    }
    __syncthreads();
    { const int p = tid >> 3, part = tid & 7, t = p >> 3, s2 = p & 7; float a = 0.f;
      if (s2 <= t) {
#pragma unroll
          for (int dd = 0; dd < 16; ++dd) a += QS[t * 128 + part * 16 + dd] * KT[s2 * 128 + part * 16 + dd]; }
      a += __shfl_xor(a, 1); a += __shfl_xor(a, 2); a += __shfl_xor(a, 4);
      if (part == 0) ATT[p] = a; }
    f32x4 vv[8];
#pragma unroll
    for (int s2 = 0; s2 < 8; ++s2) vv[s2] = (f32x4){bflo(vvraw[s2].x), bfhi(vvraw[s2].x), bflo(vvraw[s2].y), bfhi(vvraw[s2].y)};
    f32x4 oacc[8];
#pragma unroll
    for (int t = 0; t < 8; ++t) oacc[t] = (f32x4){0.f, 0.f, 0.f, 0.f};
#pragma unroll
    for (int dd = 0; dd < 16; ++dd) { const int dr = dg * 16 + dd; const f32x4 s0 = s0r[dd];
        const f32x4 q0 = *(const LAS f32x4*)(QT + dr * 8), q1 = *(const LAS f32x4*)(QT + dr * 8 + 4), k0 = *(const LAS f32x4*)(KD + dr * 8), k1 = *(const LAS f32x4*)(KD + dr * 8 + 4);
        oacc[0] += q0.x * s0; oacc[1] += q0.y * s0; oacc[2] += q0.z * s0; oacc[3] += q0.w * s0; oacc[4] += q1.x * s0; oacc[5] += q1.y * s0; oacc[6] += q1.z * s0; oacc[7] += q1.w * s0;
        f32x4 sn = DC[dr] * s0; sn += k0.x * vv[0]; sn += k0.y * vv[1]; sn += k0.z * vv[2]; sn += k0.w * vv[3]; sn += k1.x * vv[4]; sn += k1.y * vv[5]; sn += k1.z * vv[6]; sn += k1.w * vv[7];
        __builtin_nontemporal_store(sn, (GAS f32x4*)(SN + (size_t)dr * DV + 4 * v4)); }
#pragma unroll
    for (int t = 0; t < 8; ++t) *(LAS f32x4*)(RED + (dg * 8 + t) * 256 + 4 * v4) = oacc[t];
    __syncthreads();
    { const int t = wave; f32x4 o = (f32x4){0.f, 0.f, 0.f, 0.f};
#pragma unroll
      for (int g2 = 0; g2 < 8; ++g2) o += *(const LAS f32x4*)(RED + (g2 * 8 + t) * 256 + 4 * v4);
#pragma unroll
      for (int s2 = 0; s2 < 8; ++s2) o += ATT[t * 8 + s2] * vv[s2];
      const float ss = wave_sum((o.x * o.x + o.y * o.y) + (o.z * o.z + o.w * o.w)); const float rs = 1.0f / sqrtf(ss * (1.f / DV) + EPS);
      v2u w; w.x = pk2(o.x * rs * go.x * bflo(zz.x), o.y * rs * go.y * bfhi(zz.x)); w.y = pk2(o.z * rs * go.z * bflo(zz.y), o.w * rs * go.w * bfhi(zz.y));
      *(GAS v2u*)(Y + (size_t)(r0 + t) * DM + EA + h * DV + 4 * v4) = w; }
}

constexpr int PRP = 264, PRT = 68;
__device__ __forceinline__ void prep_unit(Frame& F, int unit) {
    int tid = ((int)threadIdx.x); asm volatile("" : "+v"(tid));
    const int hp = unit & 1, cc = (unit >> 1) & 31, b = unit >> 6, r0 = b * SEQ + cc * GC, ch = tid & 255, th = tid >> 8, c0 = hp * 256;
    LAS bf16* QL = (LAS bf16*)F.lds;
    LAS bf16* KL = QL + 64 * PRP;
    LAS bf16* KTL = KL + 64 * PRP;
    LAS float* TOT = (LAS float*)(KTL + 256 * PRT);
    const float* LAg = (const float*)(F.ws + WS_LA); const bf16* Q = (const bf16*)(F.ws + WS_Q); const bf16* KBp = (const bf16*)(F.ws + WS_KB);
    bf16* QTg = (bf16*)(F.ws + WS_QT); bf16* KTT = (bf16*)(F.ws + WS_KTT); float* DEC = (float*)(F.ws + WS_DEC);
    __syncthreads();
    float bl[32]; float run = 0.f;
#pragma unroll
    for (int i2 = 0; i2 < 32; ++i2) { run += LAg[(size_t)(r0 + 32 * th + i2) * KBW + c0 + ch]; bl[i2] = run; }
    TOT[th * 256 + ch] = run;
    __syncthreads();
    const float t0 = TOT[ch], t1 = TOT[256 + ch], off = th ? t0 : 0.f;
    if (th == 0) DEC[((size_t)(b * HB + 2 * hp + (ch >> 7)) * NCH + cc) * DK + (ch & 127)] = __expf(t0 + t1);
#pragma unroll
    for (int i2 = 0; i2 < 32; ++i2) { const int t = 32 * th + i2; const float eb = __expf(bl[i2] + off), ek = __builtin_amdgcn_rcpf(eb);
        const float q = bf2f(Q[(size_t)(r0 + t) * KBW + c0 + ch]), k = bf2f(KBp[(size_t)(r0 + t) * KBW + c0 + ch]);
        const bf16 kb = (bf16)f2bf(k * ek); QL[t * PRP + ch] = (bf16)f2bf(q * eb); KL[t * PRP + ch] = kb; KTL[ch * PRT + t] = kb; }
    __syncthreads();
#pragma unroll
    for (int i2 = 0; i2 < 4; ++i2) { const int p = tid + NTHR * i2, t = p >> 5, c8 = (p & 31) * 8; const size_t o = ((size_t)(b * HB + 2 * hp + (c8 >> 7)) * SEQ + cc * GC + t) * DK + (c8 & 127);
        *(GAS v4u*)(QTg + o) = *(const LAS v4u*)(QL + t * PRP + c8); }
    { const int lane = tid & 63, fr = lane & 15, fq = lane >> 4, hl = F.wave >> 2, ti = F.wave & 3; bf16* ATg = (bf16*)(F.ws + WS_ATT) + ((size_t)(b * HB + 2 * hp + hl) * NCH + cc) * GC * GC;
      bf16x8 qf[4];
#pragma unroll
      for (int kk = 0; kk < 4; ++kk) qf[kk] = *(const LAS bf16x8*)(QL + (16 * ti + fr) * PRP + hl * 128 + 32 * kk + 8 * fq);
#pragma unroll
      for (int si = 0; si < 4; ++si) { pg8::f32x4 a = (pg8::f32x4){0.f, 0.f, 0.f, 0.f};
          if (si <= ti) {
#pragma unroll
              for (int kk = 0; kk < 4; ++kk) a = __builtin_amdgcn_mfma_f32_16x16x32_bf16(*(const LAS bf16x8*)(KL + (16 * si + fr) * PRP + hl * 128 + 32 * kk + 8 * fq), qf[kk], a, 0, 0, 0); }
          const int t = 16 * ti + fr, s0 = 16 * si + 4 * fq; v2u w;
          w.x = pk2(s0 <= t ? a.x : 0.f, s0 + 1 <= t ? a.y : 0.f); w.y = pk2(s0 + 2 <= t ? a.z : 0.f, s0 + 3 <= t ? a.w : 0.f);
          *(GAS v2u*)(ATg + t * GC + s0) = w; } }
#pragma unroll
    for (int i2 = 0; i2 < 4; ++i2) { const int p = tid + NTHR * i2, chh = p >> 3, t8 = (p & 7) * 8; const v2u a = *(const LAS v2u*)(KTL + chh * PRT + t8), c2 = *(const LAS v2u*)(KTL + chh * PRT + t8 + 4);
        *(GAS v4u*)(KTT + (((size_t)(b * HB + 2 * hp + (chh >> 7)) * NCH + cc) * DK + (chh & 127)) * GC + t8) = (v4u){a.x, a.y, c2.x, c2.y}; }
}

constexpr int PQ = 136, PS64 = 72;
__device__ __forceinline__ bf16x8 ldfrag(const LAS bf16* base, int row, int pitch, int k0) { return *(const LAS bf16x8*)(base + row * pitch + k0); }
struct GlaStage { v4u q[2], kt[2], at, v; float dec; };
template <int NVT>
__device__ __forceinline__ void gla_unit(Frame& F, int unit, bool fuse_norm) {
    constexpr int SW = 16 * NVT, NSL = DV / SW, VPR = SW / 8  ;
    int tid = ((int)threadIdx.x); asm volatile("" : "+v"(tid));
    const int bh = unit / NSL, j = unit % NSL, b = bh >> 2, h = bh & 3, lane = tid & 63, wave = F.wave, fr = lane & 15, fq = lane >> 4;
    constexpr int SET_E = 64 * PQ + 128 * PS64 + SW * PS64 + 64 * PS64 + 256;
    LAS bf16* L0 = (LAS bf16*)F.lds; LAS bf16* STL = L0 + 2 * SET_E;
    const bf16* QTg = (const bf16*)(F.ws + WS_QT) + (size_t)bh * SEQ * DK; const bf16* ATg = (const bf16*)(F.ws + WS_ATT) + (size_t)bh * NCH * GC * GC;
    const bf16* KTT = (const bf16*)(F.ws + WS_KTT) + (size_t)bh * NCH * DK * GC; const float* DEC = (const float*)(F.ws + WS_DEC) + (size_t)bh * NCH * DK;
    const bf16* VB = (const bf16*)(F.ws + WS_VB) + (size_t)(b * SEQ) * EB + h * DV + j * SW; bf16* O = (bf16*)(F.ws + WS_O) + (size_t)(b * SEQ) * EB + h * DV + j * SW;
    __syncthreads();
    for (int i = tid; i < 2 * SW * PQ / 2; i += NTHR) ((LAS unsigned*)STL)[i] = 0u;
#define GLA_LD16(dst, ptr) asm volatile("global_load_dwordx4 %0, %1, off" : "=v"(dst) : "v"(ptr) : "memory")
#define GLA_FETCH(R, c) do { const int c_ = (c) < NCH ? (c) : NCH - 1; \
        GLA_LD16(R.q[0], QTg + (size_t)c_ * GC * DK + tid * 8); GLA_LD16(R.q[1], QTg + (size_t)c_ * GC * DK + (tid + NTHR) * 8); \
        GLA_LD16(R.kt[0], KTT + (size_t)c_ * DK * GC + tid * 8); GLA_LD16(R.kt[1], KTT + (size_t)c_ * DK * GC + (tid + NTHR) * 8); \
        GLA_LD16(R.at, ATg + (size_t)c_ * GC * GC + tid * 8); \
        { const int tv_ = tid % (64 * VPR), s_ = tv_ / VPR, hf_ = tv_ % VPR; GLA_LD16(R.v, VB + (size_t)(c_ * GC + s_) * EB + hf_ * 8); } \
        asm volatile("global_load_dword %0, %1, off" : "=v"(R.dec) : "v"(DEC + c_ * DK + (tid & 127)) : "memory"); } while (0)
#define GLA_WAIT(R, n) asm volatile("s_waitcnt vmcnt(" #n ")" : "+v"(R.q[0]), "+v"(R.q[1]), "+v"(R.kt[0]), "+v"(R.kt[1]), "+v"(R.at), "+v"(R.v), "+v"(R.dec) :: "memory")
#define GLA_COMMIT(R, set) do { LAS bf16* QL_ = L0 + (set) * SET_E; LAS bf16* KTL_ = QL_ + 64 * PQ; LAS bf16* VTL_ = KTL_ + 128 * PS64; LAS bf16* ATL_ = VTL_ + SW * PS64; LAS float* DCL_ = (LAS float*)(ATL_ + 64 * PS64); \
        _Pragma("unroll") for (int i_ = 0; i_ < 2; ++i_) { const int p_ = tid + NTHR * i_; { const int r_ = p_ >> 4, cch_ = p_ & 15; *(LAS v4u*)(QL_ + r_ * PQ + cch_ * 8) = R.q[i_]; } \
            { const int r_ = p_ >> 3, cch_ = p_ & 7; *(LAS v4u*)(KTL_ + r_ * PS64 + cch_ * 8) = R.kt[i_]; } } \
        { const int r_ = tid >> 3, cch_ = tid & 7; *(LAS v4u*)(ATL_ + r_ * PS64 + cch_ * 8) = R.at; } \
        if (tid < 64 * VPR) { const int s_ = tid / VPR, hf_ = tid % VPR; const unsigned w_[4] = {R.v.x, R.v.y, R.v.z, R.v.w}; \
            _Pragma("unroll") for (int e_ = 0; e_ < 4; ++e_) { VTL_[(hf_ * 8 + 2 * e_) * PS64 + s_] = (bf16)(w_[e_] & 0xffffu); VTL_[(hf_ * 8 + 2 * e_ + 1) * PS64 + s_] = (bf16)(w_[e_] >> 16); } } \
        if (tid < 128) DCL_[tid] = R.dec; } while (0)
    pg8::f32x4 sacc[2][NVT];
#pragma unroll
    for (int e = 0; e < 2; ++e)
#pragma unroll
        for (int vt = 0; vt < NVT; ++vt) sacc[e][vt] = (pg8::f32x4){0.f, 0.f, 0.f, 0.f};
    GlaStage ra, rb, rc;
    GLA_FETCH(ra, 0); GLA_WAIT(ra, 0); GLA_COMMIT(ra, 0); GLA_FETCH(ra, 1); GLA_FETCH(rb, 2); GLA_FETCH(rc, 3);
    __syncthreads();
#define GLA_STEP(R, cc) { const int c = (cc); GLA_WAIT(R, 14); if (c + 1 < NCH) GLA_COMMIT(R, (c + 1) & 1); GLA_FETCH(R, c + 4);
    for (int c3 = 0; c3 < NCH; c3 += 3) {
        GLA_STEP(ra, c3)
        const LAS bf16* QL = L0 + (c & 1) * SET_E; const LAS bf16* KTL = QL + 64 * PQ; const LAS bf16* VTL = KTL + 128 * PS64; const LAS bf16* ATL = VTL + SW * PS64; const LAS float* DCL = (const LAS float*)(ATL + 64 * PS64);
        const LAS bf16* STc = STL + (c & 1) * SW * PQ; LAS bf16* STn = STL + ((c + 1) & 1) * SW * PQ;
        if (wave < 4) {
            const int ti = wave; pg8::f32x4 o[NVT];
#pragma unroll
            for (int vt = 0; vt < NVT; ++vt) o[vt] = (pg8::f32x4){0.f, 0.f, 0.f, 0.f};
#pragma unroll
            for (int kk = 0; kk < 2; ++kk) { const bf16x8 bf = ldfrag(ATL, 16 * ti + fr, PS64, 32 * kk + 8 * fq);
#pragma unroll
                for (int vt = 0; vt < NVT; ++vt) o[vt] = __builtin_amdgcn_mfma_f32_16x16x32_bf16(ldfrag(VTL, 16 * vt + fr, PS64, 32 * kk + 8 * fq), bf, o[vt], 0, 0, 0); }
#pragma unroll
            for (int kk = 0; kk < 4; ++kk) { const bf16x8 bf = ldfrag(QL, 16 * ti + fr, PQ, 32 * kk + 8 * fq);
#pragma unroll
                for (int vt = 0; vt < NVT; ++vt) o[vt] = __builtin_amdgcn_mfma_f32_16x16x32_bf16(ldfrag(STc, 16 * vt + fr, PQ, 32 * kk + 8 * fq), bf, o[vt], 0, 0, 0); }
#pragma unroll
            for (int vt = 0; vt < NVT; ++vt) *(GAS v2u*)(O + (size_t)(c * GC + 16 * ti + fr) * EB + 16 * vt + 4 * fq) = (v2u){pk2(o[vt].x, o[vt].y), pk2(o[vt].z, o[vt].w)};
        } else {
#pragma unroll
            for (int e = 0; e < 2; ++e) { const int dt = 2 * (wave - 4) + e; const pg8::f32x4 dc = *(const LAS pg8::f32x4*)(DCL + 16 * dt + 4 * fq);
                const bf16x8 a0 = ldfrag(KTL, 16 * dt + fr, PS64, 8 * fq), a1 = ldfrag(KTL, 16 * dt + fr, PS64, 32 + 8 * fq);
#pragma unroll
                for (int vt = 0; vt < NVT; ++vt) { pg8::f32x4 sv = sacc[e][vt];
                    sv = __builtin_amdgcn_mfma_f32_16x16x32_bf16(a0, ldfrag(VTL, 16 * vt + fr, PS64, 8 * fq), sv, 0, 0, 0);
                    sv = __builtin_amdgcn_mfma_f32_16x16x32_bf16(a1, ldfrag(VTL, 16 * vt + fr, PS64, 32 + 8 * fq), sv, 0, 0, 0);
                    sv = sv * dc; sacc[e][vt] = sv; v2u w; w.x = pk2(sv.x, sv.y); w.y = pk2(sv.z, sv.w);
                    *(LAS v2u*)(STn + (16 * vt + fr) * PQ + 16 * dt + 4 * fq) = w; } }
        }
        __syncthreads();
        }
        if (c3 + 1 < NCH) GLA_STEP(rb, c3 + 1)
        const LAS bf16* QL = L0 + (c & 1) * SET_E; const LAS bf16* KTL = QL + 64 * PQ; const LAS bf16* VTL = KTL + 128 * PS64; const LAS bf16* ATL = VTL + SW * PS64; const LAS float* DCL = (const LAS float*)(ATL + 64 * PS64);
        const LAS bf16* STc = STL + (c & 1) * SW * PQ; LAS bf16* STn = STL + ((c + 1) & 1) * SW * PQ;
        if (wave < 4) {
            const int ti = wave; pg8::f32x4 o[NVT];
#pragma unroll
            for (int vt = 0; vt < NVT; ++vt) o[vt] = (pg8::f32x4){0.f, 0.f, 0.f, 0.f};
#pragma unroll
            for (int kk = 0; kk < 2; ++kk) { const bf16x8 bf = ldfrag(ATL, 16 * ti + fr, PS64, 32 * kk + 8 * fq);
#pragma unroll
                for (int vt = 0; vt < NVT; ++vt) o[vt] = __builtin_amdgcn_mfma_f32_16x16x32_bf16(ldfrag(VTL, 16 * vt + fr, PS64, 32 * kk + 8 * fq), bf, o[vt], 0, 0, 0); }
#pragma unroll
            for (int kk = 0; kk < 4; ++kk) { const bf16x8 bf = ldfrag(QL, 16 * ti + fr, PQ, 32 * kk + 8 * fq);
#pragma unroll
                for (int vt = 0; vt < NVT; ++vt) o[vt] = __builtin_amdgcn_mfma_f32_16x16x32_bf16(ldfrag(STc, 16 * vt + fr, PQ, 32 * kk + 8 * fq), bf, o[vt], 0, 0, 0); }
#pragma unroll
            for (int vt = 0; vt < NVT; ++vt) *(GAS v2u*)(O + (size_t)(c * GC + 16 * ti + fr) * EB + 16 * vt + 4 * fq) = (v2u){pk2(o[vt].x, o[vt].y), pk2(o[vt].z, o[vt].w)};
        } else {
#pragma unroll
            for (int e = 0; e < 2; ++e) { const int dt = 2 * (wave - 4) + e; const pg8::f32x4 dc = *(const LAS pg8::f32x4*)(DCL + 16 * dt + 4 * fq);
                const bf16x8 a0 = ldfrag(KTL, 16 * dt + fr, PS64, 8 * fq), a1 = ldfrag(KTL, 16 * dt + fr, PS64, 32 + 8 * fq);
#pragma unroll
                for (int vt = 0; vt < NVT; ++vt) { pg8::f32x4 sv = sacc[e][vt];
                    sv = __builtin_amdgcn_mfma_f32_16x16x32_bf16(a0, ldfrag(VTL, 16 * vt + fr, PS64, 8 * fq), sv, 0, 0, 0);
                    sv = __builtin_amdgcn_mfma_f32_16x16x32_bf16(a1, ldfrag(VTL, 16 * vt + fr, PS64, 32 + 8 * fq), sv, 0, 0, 0);
                    sv = sv * dc; sacc[e][vt] = sv; v2u w; w.x = pk2(sv.x, sv.y); w.y = pk2(sv.z, sv.w);
                    *(LAS v2u*)(STn + (16 * vt + fr) * PQ + 16 * dt + 4 * fq) = w; } }
        }
        __syncthreads();
        }
        if (c3 + 2 < NCH) GLA_STEP(rc, c3 + 2)
        const LAS bf16* QL = L0 + (c & 1) * SET_E; const LAS bf16* KTL = QL + 64 * PQ; const LAS bf16* VTL = KTL + 128 * PS64; const LAS bf16* ATL = VTL + SW * PS64; const LAS float* DCL = (const LAS float*)(ATL + 64 * PS64);
        const LAS bf16* STc = STL + (c & 1) * SW * PQ; LAS bf16* STn = STL + ((c + 1) & 1) * SW * PQ;
        if (wave < 4) {
            const int ti = wave; pg8::f32x4 o[NVT];
#pragma unroll
            for (int vt = 0; vt < NVT; ++vt) o[vt] = (pg8::f32x4){0.f, 0.f, 0.f, 0.f};
#pragma unroll
            for (int kk = 0; kk < 2; ++kk) { const bf16x8 bf = ldfrag(ATL, 16 * ti + fr, PS64, 32 * kk + 8 * fq);
#pragma unroll
                for (int vt = 0; vt < NVT; ++vt) o[vt] = __builtin_amdgcn_mfma_f32_16x16x32_bf16(ldfrag(VTL, 16 * vt + fr, PS64, 32 * kk + 8 * fq), bf, o[vt], 0, 0, 0); }
#pragma unroll
            for (int kk = 0; kk < 4; ++kk) { const bf16x8 bf = ldfrag(QL, 16 * ti + fr, PQ, 32 * kk + 8 * fq);
#pragma unroll
                for (int vt = 0; vt < NVT; ++vt) o[vt] = __builtin_amdgcn_mfma_f32_16x16x32_bf16(ldfrag(STc, 16 * vt + fr, PQ, 32 * kk + 8 * fq), bf, o[vt], 0, 0, 0); }
#pragma unroll
            for (int vt = 0; vt < NVT; ++vt) *(GAS v2u*)(O + (size_t)(c * GC + 16 * ti + fr) * EB + 16 * vt + 4 * fq) = (v2u){pk2(o[vt].x, o[vt].y), pk2(o[vt].z, o[vt].w)};
        } else {
#pragma unroll
            for (int e = 0; e < 2; ++e) { const int dt = 2 * (wave - 4) + e; const pg8::f32x4 dc = *(const LAS pg8::f32x4*)(DCL + 16 * dt + 4 * fq);
                const bf16x8 a0 = ldfrag(KTL, 16 * dt + fr, PS64, 8 * fq), a1 = ldfrag(KTL, 16 * dt + fr, PS64, 32 + 8 * fq);
#pragma unroll
                for (int vt = 0; vt < NVT; ++vt) { pg8::f32x4 sv = sacc[e][vt];
                    sv = __builtin_amdgcn_mfma_f32_16x16x32_bf16(a0, ldfrag(VTL, 16 * vt + fr, PS64, 8 * fq), sv, 0, 0, 0);
                    sv = __builtin_amdgcn_mfma_f32_16x16x32_bf16(a1, ldfrag(VTL, 16 * vt + fr, PS64, 32 + 8 * fq), sv, 0, 0, 0);
                    sv = sv * dc; sacc[e][vt] = sv; v2u w; w.x = pk2(sv.x, sv.y); w.y = pk2(sv.z, sv.w);
                    *(LAS v2u*)(STn + (16 * vt + fr) * PQ + 16 * dt + 4 * fq) = w; } }
        }
        __syncthreads();
        }
    }
#undef GLA_STEP
    GLA_WAIT(ra, 0); GLA_WAIT(rb, 0); GLA_WAIT(rc, 0);
    if (wave >= 4) { float* SP = F.out + OUT_SP + (size_t)bh * DK * DV + j * SW;
#pragma unroll
        for (int e = 0; e < 2; ++e) { const int dt = 2 * (wave - 4) + e;
#pragma unroll
            for (int vt = 0; vt < NVT; ++vt)
#pragma unroll
                for (int i = 0; i < 4; ++i) SP[(size_t)(16 * dt + 4 * fq + i) * DV + 16 * vt + fr] = sacc[e][vt][i]; } }
#undef GLA_FETCH
#undef GLA_COMMIT
#undef GLA_WAIT
#undef GLA_LD16
    if (fuse_norm) {
        asm volatile("s_waitcnt vmcnt(0)" ::: "memory");
        __syncthreads();
        if (tid == 0) { unsigned* cnt = (unsigned*)(F.ws + WS_CTL) + CW_GRP + 64 * bh;
            __builtin_amdgcn_fence(__ATOMIC_RELEASE, "agent"); asm volatile("s_waitcnt vmcnt(0)" ::: "memory");
            (void)__hip_atomic_fetch_add(cnt, 1u, __ATOMIC_RELAXED, __HIP_MEMORY_SCOPE_AGENT); }
    }
}
__device__ __forceinline__ void head_norm(Frame& F, int bh, int rlo, unsigned need) {
    const int tid = (int)threadIdx.x, lane = tid & 63, wave = F.wave, b = bh >> 2, h = bh & 3;
    if (tid == 0) { unsigned* cnt = (unsigned*)(F.ws + WS_CTL) + CW_GRP + 64 * bh;
        unsigned sp = 0; while (__hip_atomic_load(cnt, __ATOMIC_RELAXED, __HIP_MEMORY_SCOPE_AGENT) < need) { __builtin_amdgcn_s_sleep(2); if (++sp > (1u << 20)) break; }
        __builtin_amdgcn_fence(__ATOMIC_ACQUIRE, "agent"); asm volatile("s_waitcnt vmcnt(0)" ::: "memory"); }
    __syncthreads();
    const bf16* Oh = (const bf16*)(F.ws + WS_O) + (size_t)(b * SEQ) * EB + h * DV; const bf16* SZB = (const bf16*)(F.ws + WS_SZB) + (size_t)(b * SEQ) * EB + h * DV; bf16* Y = (bf16*)(F.ws + WS_Y) + (size_t)(b * SEQ) * DM + EA + h * DV;
    const f32x4 go = *(const GAS f32x4*)(F.g_o + h * DV + 4 * lane);
    constexpr int NB = 16; v2u ob[NB], zz[NB];
#pragma unroll
    for (int q = 0; q < NB; ++q) { const int row = rlo + wave + NWAVES * q; ob[q] = *(const GAS v2u*)(Oh + (size_t)row * EB + 4 * lane); zz[q] = *(const GAS v2u*)(SZB + (size_t)row * EB + 4 * lane); }
#pragma unroll
    for (int q = 0; q < NB; ++q) { const int row = rlo + wave + NWAVES * q;
        const f32x4 o = (f32x4){bflo(ob[q].x), bfhi(ob[q].x), bflo(ob[q].y), bfhi(ob[q].y)};
        const float ss = wave_sum((o.x * o.x + o.y * o.y) + (o.z * o.z + o.w * o.w)); const float rs = 1.0f / sqrtf(ss * (1.f / DV) + EPS);
        v2u w; w.x = pk2(o.x * rs * go.x * bflo(zz[q].x), o.y * rs * go.y * bfhi(zz[q].x)); w.y = pk2(o.z * rs * go.z * bflo(zz[q].y), o.w * rs * go.w * bfhi(zz[q].y));
        *(GAS v2u*)(Y + (size_t)row * DM + 4 * lane) = w; }
}

struct Args { const float* in[19]; float* out; unsigned char* ws; int ph_lo, ph_hi, li, pad; };
constexpr int NPHASE = 11;
__global__ void __launch_bounds__(NTHR, 2) fwd_kernel(Args args) {
    extern __shared__ __attribute__((aligned(16))) unsigned char lds[];
    Frame F;
    F.lds = (LAS unsigned char*)lds; F.ws = args.ws; F.out = args.out;
    F.wave = __builtin_amdgcn_readfirstlane((int)threadIdx.x >> 6);
    F.G = gridDim.x; { const int bx = blockIdx.x; F.vcu = (F.G % 8 == 0) ? (bx % 8) * (F.G / 8) + bx / 8 : bx; }
    F.xp = args.in[0]; F.xs = args.in[1]; F.pp = args.in[2]; F.ps = args.in[3]; F.st0 = args.in[4]; F.g_pre = args.in[5]; F.w_in = args.in[6]; F.g_v = args.in[7]; F.w_s = args.in[8]; F.b_s = args.in[9];
    F.w_a2 = args.in[10]; F.b_a = args.in[11]; F.g_o = args.in[12]; F.w_pa = args.in[13]; F.w_pb = args.in[14]; F.w_o = args.in[15]; F.g_post = args.in[16]; F.w_pg = args.in[17]; F.w_pe = args.in[18];
    volatile LAS unsigned* MISC = (volatile LAS unsigned*)(F.lds + MISC_OFF);
    if (((int)threadIdx.x) < 64) MISC[((int)threadIdx.x)] = 0u;
    __syncthreads();
    XcdBarrier bar; bar.bar = (unsigned*)(F.ws + WS_CTL) + CW_BAR + args.li * XCD_BAR_WORDS; bar.x = 0; bar.st = nullptr;
    const int lo = args.ph_lo, hi = args.ph_hi;
    if (hi - lo > 1) bar = xcd_barrier_post(bar.bar, MISC + 8);
#define IN(k) (lo <= (k) && (k) < hi)
#define SEAM(k) do { if (IN(k) && IN((k) + 1)) xcd_barrier(bar); } while (0)
    unsigned char* ws = F.ws;

    if (IN(0)) { p0_prologue(F); } SEAM(0);

    if (IN(1)) {
        pg8::Gemm g{(const bf16*)(ws + WS_XN), (const bf16*)(ws + WS_W1T), DM, DM}; pg8::StaticOrder S; S.init(MT, N1, DM, F.G, (int)blockIdx.x);
        EpiG1 E{ws, F.b_a};
        pg8::gemm_phase<EpiG1, pg8::StaticOrder>(F.lds, g, S, E);
        { const int nfullc = S.nwg % F.G;
          pg8::Gemm g2{(const bf16*)(ws + WS_PBF), (const bf16*)(ws + WS_WPE), PLE, PLE}; pg8::ESampleOrder S2{nfullc ? F.G - nfullc : F.G, nfullc ? (int)blockIdx.x - nfullc : (int)blockIdx.x};
          EpiBf E2{(bf16*)(ws + WS_ES) - (size_t)MP * DM, DM};
          pg8::gemm_phase<EpiBf, pg8::ESampleOrder>(F.lds, g2, S2, E2); }
    } SEAM(1);

    const bool hetero = (F.G == 256);
    const bool fuse_norm = hetero || (F.G % 16) == 0;
    if (IN(2)) {
        if (hetero) { for (int u = F.vcu; u < 512; u += F.G) { if (u < 256) prep_unit(F, u); else gate_prompt_unit(F, u - 256); } }
        else { for (int u = F.vcu; u < 1024; u += F.G) { if (u < 256) gate_prompt_unit(F, u); else if (u < 768) sample_unit(F, u - 256); else prep_unit(F, u - 768); } }
    } SEAM(2);

    if (IN(3)) {
        if (hetero) { const int xcd = F.vcu >> 5, l = F.vcu & 31;
            if (l < 16) gla_unit<2>(F, (xcd * 2 + (l >> 3)) * 8 + (l & 7), true);
            else { for (int u = xcd * 16 + (l - 16); u < 512; u += 128) sample_unit(F, u); }
            __syncthreads(); head_norm(F, F.vcu >> 4, 128 * (F.vcu & 15), 8u); }
        else { for (int u = F.vcu; u < 256; u += F.G) gla_unit<1>(F, u, fuse_norm);
               if (fuse_norm) { for (int u = F.vcu; u < 256; u += F.G) head_norm(F, u >> 4, 128 * (u & 15), 16u); } }
    } SEAM(3);

    if (IN(4) && !fuse_norm) {
        const int gw = F.vcu * NWAVES + F.wave, NGW = F.G * NWAVES; const bf16* O = (const bf16*)(ws + WS_O); const bf16* SZB = (const bf16*)(ws + WS_SZB); bf16* Y = (bf16*)(ws + WS_Y);
        for (int m = gw; m < MP; m += NGW) {
#pragma unroll
            for (int h = 0; h < HB; ++h) { const v2u ob = *(const GAS v2u*)(O + (size_t)m * EB + h * DV + 4 * ((int)(threadIdx.x & 63u))); const f32x4 o = (f32x4){bflo(ob.x), bfhi(ob.x), bflo(ob.y), bfhi(ob.y)};
                const float ss = wave_sum((o.x * o.x + o.y * o.y) + (o.z * o.z + o.w * o.w)); const float rs = 1.0f / sqrtf(ss * (1.f / DV) + EPS);
                const f32x4 go = *(const GAS f32x4*)(F.g_o + h * DV + 4 * ((int)(threadIdx.x & 63u))); const v2u zz = *(const GAS v2u*)(SZB + (size_t)m * EB + h * DV + 4 * ((int)(threadIdx.x & 63u)));
                v2u w; w.x = pk2(o.x * rs * go.x * bflo(zz.x), o.y * rs * go.y * bfhi(zz.x)); w.y = pk2(o.z * rs * go.z * bflo(zz.y), o.w * rs * go.w * bfhi(zz.y));
                *(GAS v2u*)(Y + (size_t)m * DM + EA + h * DV + 4 * ((int)(threadIdx.x & 63u))) = w; } }
    } if (!fuse_norm) SEAM(4);

    bf16* const slabA_lo = (bf16*)(ws + WS_SLABA); bf16* const slabA_hi = slabA_lo + (size_t)4 * MS * DM;
    bf16* const slabB_lo = (bf16*)(ws + WS_GA); bf16* const slabB_hi = slabB_lo + (size_t)4 * MS * DM;
    if (IN(5)) {
        { pg8::Gemm g{(const bf16*)(ws + WS_Y), (const bf16*)(ws + WS_WPAB), DM, DM}; pg8::TailOrder S{F.G, (int)blockIdx.x, (int)((blockIdx.x >> 6) & 1)};
          EpiG2 E{ws + WS_GA, ws + WS_GB, (bf16*)(ws + WS_M), slabA_lo, slabA_hi};
          pg8::gemm_phase<EpiG2, pg8::TailOrder>(F.lds, g, S, E); }
        { pg8::Gemm g{(const bf16*)(ws + WS_PBF), (const bf16*)(ws + WS_WPE), PLE, PLE}; pg8::EPromptOrder S{F.G, (int)blockIdx.x};
          EpiBf E{(bf16*)(ws + WS_E), DM};
          pg8::gemm_phase<EpiBf, pg8::EPromptOrder>(F.lds, g, S, E); }
    } SEAM(5);

    if (IN(6)) {
        const int gt = F.vcu * NTHR + ((int)threadIdx.x), NGT = F.G * NTHR; const unsigned char* GA = ws + WS_GA; const unsigned char* GB = ws + WS_GB; bf16* Mo = (bf16*)(ws + WS_M);
        for (int p = gt; p < MS * DM / 8; p += NGT) { const size_t off = (size_t)p * 8, og = (size_t)MP * DM + off;
            f32x4 a0, a1, b0, b1; slab_sum8(slabA_lo, slabA_hi, off, 0, 4, a0, a1); slab_sum8(slabA_lo, slabA_hi, off, 4, 8, b0, b1);
            float fa[8], fb[8]; u8x8_to_f32(*(const GAS v2u*)(GA + og), fa); u8x8_to_f32(*(const GAS v2u*)(GB + og), fb); const float k = 1.f / 255.f; v4u w;
            w.x = pk2((fa[0] * a0.x + fb[0] * b0.x) * k, (fa[1] * a0.y + fb[1] * b0.y) * k); w.y = pk2((fa[2] * a0.z + fb[2] * b0.z) * k, (fa[3] * a0.w + fb[3] * b0.w) * k);
            w.z = pk2((fa[4] * a1.x + fb[4] * b1.x) * k, (fa[5] * a1.y + fb[5] * b1.y) * k); w.w = pk2((fa[6] * a1.z + fb[6] * b1.z) * k, (fa[7] * a1.w + fb[7] * b1.w) * k);
            *(GAS v4u*)(Mo + og) = w; }
    } SEAM(6);

    if (IN(7)) {
        pg8::Gemm g{(const bf16*)(ws + WS_M), (const bf16*)(ws + WS_WO), DM, DM}; pg8::TailOrder S{F.G, (int)blockIdx.x, (int)((blockIdx.x >> 6) & 1)};
        EpiG3 E{(bf16*)(ws + WS_T), (float*)(ws + WS_TSS), slabB_lo, slabB_hi, hetero ? 1 : 0, (bf16*)(ws + WS_H), (float*)(ws + WS_TSS), (unsigned*)(ws + WS_CTL) + CW_PAN, F.xp, F.g_post, F.lds + pg8::STAGE_BYTES};
        pg8::gemm_phase<EpiG3, pg8::TailOrder>(F.lds, g, S, E);
    } SEAM(7);

    if (IN(8)) {
        const bf16* T = (const bf16*)(ws + WS_T); const float* TSS = (const float*)(ws + WS_TSS); bf16* H = (bf16*)(ws + WS_H);
        for (int r = F.wave * F.G + F.vcu; r < MS; r += NWAVES * F.G) { const int m = MP + r;
            f32x4 t4[8]; float ss = 0.f;
#pragma unroll
            for (int j2 = 0; j2 < 8; ++j2) { t4[j2] = slab_sum4(slabB_lo, slabB_hi, (size_t)r * DM + 4 * ((int)(threadIdx.x & 63u)) + 256 * j2); ss += (t4[j2].x * t4[j2].x + t4[j2].y * t4[j2].y) + (t4[j2].z * t4[j2].z + t4[j2].w * t4[j2].w); }
            const float rs = 1.0f / sqrtf(wave_sum(ss) * (1.f / DM) + EPS);
            const GAS f32x4* xr = (const GAS f32x4*)xrow(F, m) + ((int)(threadIdx.x & 63u)); const GAS f32x4* gr = (const GAS f32x4*)F.g_post + ((int)(threadIdx.x & 63u)); GAS v2u* ho = (GAS v2u*)(H + (size_t)m * DM) + ((int)(threadIdx.x & 63u));
#pragma unroll
            for (int j2 = 0; j2 < 8; ++j2) { const f32x4 xv = xr[64 * j2], gg = gr[64 * j2], tv = t4[j2]; v2u o, tb; tb.x = pk2(tv.x, tv.y); tb.y = pk2(tv.z, tv.w);
                o.x = pk2(xv.x + bflo(tb.x) * rs * gg.x, xv.y + bfhi(tb.x) * rs * gg.y); o.y = pk2(xv.z + bflo(tb.y) * rs * gg.z, xv.w + bfhi(tb.y) * rs * gg.w); ho[64 * j2] = o; }
        }
        const int gw = F.vcu * NWAVES + F.wave, NGW = F.G * NWAVES;
        for (int m = hetero ? MP : gw; m < MP; m += NGW) {
            float ss = ((int)(threadIdx.x & 63u)) < 32 ? TSS[(size_t)m * 32 + ((int)(threadIdx.x & 63u))] : 0.f; ss = wave_sum(ss); const float rs = 1.0f / sqrtf(ss * (1.f / DM) + EPS);
            const GAS f32x4* xr = (const GAS f32x4*)xrow(F, m) + ((int)(threadIdx.x & 63u)); const GAS f32x4* gr = (const GAS f32x4*)F.g_post + ((int)(threadIdx.x & 63u)); const GAS v2u* tr = (const GAS v2u*)(T + (size_t)m * DM) + ((int)(threadIdx.x & 63u)); GAS v2u* ho = (GAS v2u*)(H + (size_t)m * DM) + ((int)(threadIdx.x & 63u));
#pragma unroll
            for (int j2 = 0; j2 < 8; ++j2) { const f32x4 xv = xr[64 * j2], gg = gr[64 * j2]; const v2u tv = tr[64 * j2]; v2u o;
                o.x = pk2(xv.x + bflo(tv.x) * rs * gg.x, xv.y + bfhi(tv.x) * rs * gg.y); o.y = pk2(xv.z + bflo(tv.y) * rs * gg.z, xv.w + bfhi(tv.y) * rs * gg.w); ho[64 * j2] = o; }
        }
    } SEAM(8);

    if (IN(9)) {
        pg8::Gemm g{(const bf16*)(ws + WS_H), (const bf16*)(ws + WS_WPG), DM, DM}; pg8::TailOrder S{F.G, (int)blockIdx.x, (int)((blockIdx.x >> 6) & 1)};
        EpiG4 E{(const bf16*)(ws + WS_H), (const bf16*)(ws + WS_E), F.out + OUT_Y, slabB_lo, slabB_hi};
        pg8::gemm_phase<EpiG4, pg8::TailOrder>(F.lds, g, S, E);
    } SEAM(9);

    if (IN(10)) {
        const int gt = F.vcu * NTHR + ((int)threadIdx.x), NGT = F.G * NTHR; const bf16* Hb = (const bf16*)(ws + WS_H); const bf16* Es = (const bf16*)(ws + WS_ES); float* out = F.out + OUT_Y;
        for (int p = gt; p < MS * DM / 4; p += NGT) { const size_t off = (size_t)p * 4, og = (size_t)MP * DM + off;
            const f32x4 a = slab_sum4(slabB_lo, slabB_hi, off); const v2u hv = *(const GAS v2u*)(Hb + og), ev = *(const GAS v2u*)(Es + off);
            f32x4 o; o.x = bflo(hv.x) + sigm(a.x) * bflo(ev.x); o.y = bfhi(hv.x) + sigm(a.y) * bfhi(ev.x); o.z = bflo(hv.y) + sigm(a.z) * bflo(ev.y); o.w = bfhi(hv.y) + sigm(a.w) * bfhi(ev.y);
            *(GAS f32x4*)(out + og) = o; }
    }
#undef IN
#undef SEAM
}

__global__ void dbg_dump(const unsigned short* src, float* dst, size_t n) { for (size_t i = blockIdx.x * (size_t)blockDim.x + threadIdx.x; i < n; i += (size_t)gridDim.x * blockDim.x) dst[i] = __uint_as_float((unsigned)src[i] << 16); }
extern "C" void kernel_launch(void* const* d_in, const int* in_sizes, int n_in, void* d_out, int out_size, void* d_ws, size_t ws_size, hipStream_t stream) {
    static int grid = 0;
    if (grid == 0) {
        if (n_in != 19 || ws_size < WS_END) { fprintf(stderr, "kernel_launch: built for 19 inputs and >= %zu bytes of workspace; got n_in %d, ws %zu\n", (size_t)WS_END, n_in, ws_size); grid = -1; return; }
        int dev = 0, cus = 0, per_cu = 0;
        if (hipGetDevice(&dev) != hipSuccess || hipDeviceGetAttribute(&cus, hipDeviceAttributeMultiprocessorCount, dev) != hipSuccess) { grid = -1; return; }
        if (hipFuncSetAttribute((const void*)fwd_kernel, hipFuncAttributeMaxDynamicSharedMemorySize, LDS_BYTES) != hipSuccess) { fprintf(stderr, "kernel_launch: hipFuncSetAttribute failed\n"); grid = -1; return; }
        if (hipOccupancyMaxActiveBlocksPerMultiprocessor(&per_cu, (const void*)fwd_kernel, NTHR, LDS_BYTES) != hipSuccess || per_cu < 1) { fprintf(stderr, "kernel_launch: occupancy query says %d blocks per CU\n", per_cu); per_cu = 1; }
        (void)hipGetLastError();
        grid = cus;
    }
    if (grid < 0) return;
    (void)hipMemsetAsync((char*)d_ws + WS_CTL, 0, CTL_ZERO_BYTES, stream);
    Args a{};
    for (int i = 0; i < 19; ++i) a.in[i] = (const float*)d_in[i];
    a.out = (float*)d_out; a.ws = (unsigned char*)d_ws;
#if MK_N_LAUNCHES == 1
    a.ph_lo = 0; a.ph_hi = NPHASE; a.li = 0;
    hipLaunchKernelGGL(fwd_kernel, dim3(grid), dim3(NTHR), LDS_BYTES, stream, a);
#else
#ifndef DBG_LAST
#define DBG_LAST (NPHASE - 1)
#endif
    if (DBG_LAST < NPHASE - 1) (void)hipMemsetAsync(d_out, 0, (size_t)out_size * 4, stream);
    for (int li = 0; li <= DBG_LAST; ++li) { const int rep = 1; for (int r = 0; r < rep; ++r) { a.ph_lo = li; a.ph_hi = li + 1; a.li = 0; hipLaunchKernelGGL(fwd_kernel, dim3(grid), dim3(NTHR), LDS_BYTES, stream, a); } }
#ifdef DBG_DUMP
    hipLaunchKernelGGL(dbg_dump, dim3(2048), dim3(256), 0, stream, (const unsigned short*)((char*)d_ws + DBG_DUMP), (float*)d_out, (size_t)MT * DM);
#endif
#endif
}
```

```cpp
#include <hip/hip_runtime.h>
#include <cstdio>
#include <cstdint>

#ifndef MK_N_LAUNCHES
#define MK_N_LAUNCHES 1
#endif

namespace pg8 {
#define PG8_LAS __attribute__((address_space(3)))
typedef unsigned short bf16_t;
typedef short bf16x8 __attribute__((ext_vector_type(8)));
typedef float f32x4 __attribute__((ext_vector_type(4)));
typedef unsigned u32x4 __attribute__((ext_vector_type(4)));
typedef unsigned u32x2 __attribute__((ext_vector_type(2)));
constexpr int BM = 256, BK = 64, HALF = 128, HTB = HALF * BK * 2, STAGE_BYTES = 8 * HTB, NXCD = 8, WGM = 8;

__host__ __device__ __forceinline__ int lds_byte(int r, int c) { const int st = (r >> 4) * 2 + (c >> 5), rr = r & 15, cc = c & 31, ob = rr * 64 + cc * 2; return st * 1024 + (ob ^ (((ob >> 9) & 1) << 5)); }
__host__ __device__ __forceinline__ void stage_rc(int b, int& R, int& C) { const int st = b / 1024, sb = b % 1024, swz = sb ^ (((sb >> 9) & 1) << 5); R = (st >> 1) * 16 + swz / 64; C = (st & 1) * 32 + (swz % 64) / 2; }
__host__ __device__ __forceinline__ int perm32(int rho) { const int n = rho >> 4, i = rho & 15; return 8 * (i >> 2) + 4 * n + (i & 3); }

struct Unit { int pm, pn, kt0, nkt, kind; };
struct Gemm { const bf16_t* A; const bf16_t* Bt; int lda, ldb; };

struct StaticOrder {
    int nM, nN, nwg, G, c, nkt;
    __host__ __device__ void init(int M, int N, int K, int G_, int c_) { nM = M / BM; nN = N / BM; nwg = nM * nN; G = G_; c = c_; nkt = K / BK; }
    __host__ __device__ bool next(int i, Unit& u) const {
        const long L = (long)i * G + c; if (L >= nwg) return false;
        int wgid = (int)L; { const int q = nwg / NXCD, r = nwg % NXCD, xcd = wgid % NXCD, off = wgid / NXCD; wgid = (xcd < r ? xcd * (q + 1) : r * (q + 1) + (xcd - r) * q) + off; }
        const int nig = WGM * nN, gid = wgid / nig, fm = gid * WGM, gsz = (nM - fm) < WGM ? (nM - fm) : WGM;
        u.pm = fm + ((wgid % nig) % gsz); u.pn = (wgid % nig) / gsz; u.kt0 = 0; u.nkt = nkt; u.kind = 0; return true;
    }
};
struct TailOrder {
    int G, c, swap;
    __host__ __device__ bool next(int i, Unit& u) const {
        long L = (long)i * G + c; if (swap && G == 256 && i < 2) L = (long)(1 - i) * G + c;
        if (L < 256) { const int x = (int)L & 7, kk = (int)L >> 3; u.pm = 4 * x + (kk >> 3); u.pn = kk & 7; u.kt0 = 0; u.nkt = 32; u.kind = 0; return true; }
        if (L < 512) { const int l2 = (int)L - 256, x = l2 & 7, kk = l2 >> 3; u.pm = 32 + (kk >> 3); u.pn = kk & 7; u.kt0 = 4 * x; u.nkt = 4; u.kind = 1; return true; }
        return false;
    }
};
struct EPromptOrder {
    int G, c;
    __host__ __device__ bool next(int i, Unit& u) const {
        const long L = (long)i * G + c; if (L >= 256) return false;
        const int x = (int)L & 7, kk = (int)L >> 3; u.pm = 4 * x + (kk >> 3); u.pn = kk & 7; u.kt0 = 0; u.nkt = 4; u.kind = 0; return true; }
};
struct ESampleOrder {
    int G2, c2;
    __host__ __device__ bool next(int i, Unit& u) const {
        if (c2 < 0 || G2 <= 0) return false; const long L = (long)i * G2 + c2; if (L >= 32) return false;
        u.pm = 32 + ((int)L >> 3); u.pn = (int)L & 7; u.kt0 = 0; u.nkt = 4; u.kind = 0; return true; }
};

typedef __bf16 bf2_t __attribute__((ext_vector_type(2)));
typedef float f2_t __attribute__((ext_vector_type(2)));
__device__ __forceinline__ unsigned cvt_pk_bf16(float lo, float hi) { return __builtin_bit_cast(unsigned, __builtin_convertvector((f2_t){lo, hi}, bf2_t)); }

template <class Epi, class Sched>
__device__ __forceinline__ void gemm_phase(PG8_LAS unsigned char* lds, const Gemm g, const Sched& S, const Epi& E) {
    const int tid = threadIdx.x, wid = __builtin_amdgcn_readfirstlane(tid >> 6), lane = tid & 63, wr = wid >> 2, wc = wid & 3, fr = lane & 15, fq = lane >> 4;
    unsigned voffA[2], voffB[2];
#pragma unroll
    for (int i = 0; i < 2; ++i) { int R, C; stage_rc(tid * 16 + i * 8192, R, C); const int Rb = Epi::PERM ? (64 * (R >> 5) + perm32(R & 31)) : R;
        voffA[i] = (unsigned)(R * g.lda + C) * 2u; voffB[i] = (unsigned)(Rb * g.ldb + C) * 2u; }
    const size_t kstep = (size_t)(BK * 2);
    const size_t hstepA = (size_t)HALF * g.lda * 2, hstepB = (size_t)(Epi::PERM ? 32 : HALF) * g.ldb * 2;
    const size_t tstepA = 2 * hstepA, tstepB = (size_t)BM * g.ldb * 2;
    const unsigned ldsw = (unsigned)wid * 1024u;
    const int aoff = lds_byte(wr * 64 + fr, fq * 8), boff = lds_byte(wc * 32 + fr, fq * 8);
#define PG8_SA(b, h) (((b) * 2 + (h)) * HTB)
#define PG8_SB(b, h) ((4 + (b) * 2 + (h)) * HTB)
#define PG8_STAGE(bufoff, gbase, voff) do { _Pragma("unroll") for (int _i = 0; _i < 2; ++_i) \
        __builtin_amdgcn_global_load_lds((const unsigned*)((const char*)(gbase) + (voff)[_i]), (PG8_LAS unsigned*)(lds + (bufoff) + ldsw + _i * 8192), 16, 0, 0); } while (0)
#define PG8_LDA(dst, b, h) do { _Pragma("unroll") for (int m = 0; m < 4; ++m) _Pragma("unroll") for (int k = 0; k < 2; ++k) dst[m][k] = *(const PG8_LAS bf16x8*)(lds + PG8_SA(b, h) + aoff + m * 2048 + k * 1024); } while (0)
#define PG8_LDB(dst, b, h) do { _Pragma("unroll") for (int n = 0; n < 2; ++n) _Pragma("unroll") for (int k = 0; k < 2; ++k) dst[n][k] = *(const PG8_LAS bf16x8*)(lds + PG8_SB(b, h) + boff + n * 2048 + k * 1024); } while (0)
#define PG8_MMA(ai, bj, At, Bt) do { __builtin_amdgcn_s_setprio(1); _Pragma("unroll") for (int m = 0; m < 4; ++m) _Pragma("unroll") for (int n = 0; n < 2; ++n) _Pragma("unroll") for (int k = 0; k < 2; ++k) \
        acc[ai][bj][m][n] = __builtin_amdgcn_mfma_f32_16x16x32_bf16(Bt[n][k], At[m][k], acc[ai][bj][m][n], 0, 0, 0); __builtin_amdgcn_s_setprio(0); } while (0)
#define PG8_WAIT_V(n) asm volatile("s_waitcnt vmcnt(" #n ")" ::: "memory")
#define PG8_WAIT_L(n) asm volatile("s_waitcnt lgkmcnt(" #n ")" ::: "memory")
#define PG8_BAR __builtin_amdgcn_s_barrier()
#define PG8_SCHED __builtin_amdgcn_sched_barrier(0)
    Unit cur, nxt; int ui = 0;
    if (!S.next(0, cur)) return;
    f32x4 acc[2][2][4][2];
#pragma unroll
    for (int a = 0; a < 2; ++a)
#pragma unroll
        for (int b = 0; b < 2; ++b)
#pragma unroll
            for (int m = 0; m < 4; ++m)
#pragma unroll
                for (int n = 0; n < 2; ++n) acc[a][b][m][n] = (f32x4){0.f, 0.f, 0.f, 0.f};
    bf16x8 At[4][2], B0[2][2], B1[2][2];
    const char* cA = (const char*)g.A + (size_t)cur.pm * tstepA + (size_t)cur.kt0 * kstep; const char* cB = (const char*)g.Bt + (size_t)cur.pn * tstepB + (size_t)cur.kt0 * kstep;
    int nt = cur.nkt; asm volatile("" : "+s"(nt));
    PG8_STAGE(PG8_SB(0, 0), cB, voffB); PG8_STAGE(PG8_SB(0, 1), cB + hstepB, voffB); PG8_STAGE(PG8_SA(0, 0), cA, voffA); PG8_STAGE(PG8_SA(0, 1), cA + hstepA, voffA);
    if (wr == 1) PG8_BAR;
    PG8_WAIT_V(2); PG8_BAR;
    PG8_STAGE(PG8_SB(1, 0), cB + kstep, voffB); PG8_STAGE(PG8_SA(1, 0), cA + kstep, voffA); PG8_STAGE(PG8_SB(1, 1), cB + hstepB + kstep, voffB);
    PG8_WAIT_V(6); PG8_BAR;
    for (;;) {
        const bool has_next = S.next(ui + 1, nxt);
        const char* nA = has_next ? (const char*)g.A + (size_t)nxt.pm * tstepA + (size_t)nxt.kt0 * kstep : cA; const char* nB = has_next ? (const char*)g.Bt + (size_t)nxt.pn * tstepB + (size_t)nxt.kt0 * kstep : cB;
        for (int t = 0; t < nt; t += 2) {
            const bool last = (t == nt - 2);
            const char* a1 = cA + (size_t)(t + 1) * kstep;
            const char* a2 = last ? nA : cA + (size_t)(t + 2) * kstep; const char* b2 = last ? nB : cB + (size_t)(t + 2) * kstep;
            const char* a3 = a2 + kstep; const char* b3 = b2 + kstep;
            if constexpr (Epi::HAS_MID) { if (cur.kind == 0 && t == (nt >> 1)) E.mid(acc, cur, wr, wc, fr, fq); }
            PG8_LDB(B0, 0, 0); PG8_LDB(B1, 0, 1); PG8_SCHED; PG8_LDA(At, 0, 0); PG8_STAGE(PG8_SA(1, 1), a1 + hstepA, voffA);
            PG8_WAIT_V(8); PG8_WAIT_L(0); PG8_BAR; PG8_MMA(0, 0, At, B0); PG8_MMA(0, 1, At, B1); PG8_BAR; PG8_SCHED;
            PG8_LDA(At, 0, 1); PG8_STAGE(PG8_SB(0, 0), b2, voffB); PG8_STAGE(PG8_SB(0, 1), b2 + hstepB, voffB); PG8_STAGE(PG8_SA(0, 0), a2, voffA);
            PG8_WAIT_V(8); PG8_WAIT_L(0); PG8_BAR; PG8_MMA(1, 0, At, B0); PG8_MMA(1, 1, At, B1); PG8_BAR; PG8_SCHED;
            PG8_LDB(B0, 1, 0); PG8_LDB(B1, 1, 1); PG8_SCHED; PG8_LDA(At, 1, 0); PG8_STAGE(PG8_SA(0, 1), a2 + hstepA, voffA);
            PG8_WAIT_V(8); PG8_WAIT_L(0); PG8_BAR; PG8_MMA(0, 0, At, B0); PG8_MMA(0, 1, At, B1); PG8_BAR; PG8_SCHED;
            PG8_LDA(At, 1, 1); PG8_STAGE(PG8_SB(1, 0), b3, voffB); PG8_STAGE(PG8_SB(1, 1), b3 + hstepB, voffB); PG8_STAGE(PG8_SA(1, 0), a3, voffA);
            PG8_WAIT_V(8); PG8_WAIT_L(0); PG8_BAR; PG8_MMA(1, 0, At, B0); PG8_MMA(1, 1, At, B1); PG8_BAR; PG8_SCHED;
        }
        if (wr == 0) PG8_BAR;
        E(acc, cur, wr, wc, fr, fq);
        if (!has_next) break;
#pragma unroll
        for (int a = 0; a < 2; ++a)
#pragma unroll
            for (int b = 0; b < 2; ++b)
#pragma unroll
                for (int m = 0; m < 4; ++m)
#pragma unroll
                    for (int n = 0; n < 2; ++n) acc[a][b][m][n] = (f32x4){0.f, 0.f, 0.f, 0.f};
        cur = nxt; cA = nA; cB = nB; ++ui; nt = cur.nkt; asm volatile("" : "+s"(nt));
        if (wr == 1) PG8_BAR;
    }
    PG8_WAIT_V(0);
    PG8_BAR;
#undef PG8_SA
#undef PG8_SB
#undef PG8_STAGE
#undef PG8_LDA
#undef PG8_LDB
#undef PG8_MMA
#undef PG8_WAIT_V
#undef PG8_WAIT_L
#undef PG8_BAR
#undef PG8_SCHED
}
}

constexpr int NWAVES = 8, NTHR = 512;
constexpr int DM = 2048, MP = 8192, MS = 1024, MT = 9216, SEQ = 2048, NBAT = 4, DBAT = 128, DSEQ = 8;
constexpr int EA = 1024, KBW = 512, EB = 1024, NIN = 10256, N1 = 10752, PLE = 256;
constexpr int HB = 4, DK = 128, DV = 256, GR = 16, CH = 128, GC = 64  , NCH = SEQ / GC;
constexpr float EPS = 1e-6f;
constexpr int C_ALR = 6144, C_MA = 6160;

constexpr size_t OUT_Y = 0, OUT_SP = (size_t)MT * DM, OUT_SS = OUT_SP + (size_t)NBAT * HB * DK * DV, OUT_CV = OUT_SS + (size_t)DBAT * HB * DK * DV;

constexpr size_t MiB = 1u << 20;
constexpr size_t WS_CTL = 0, CTL_ZERO_BYTES = 64 * 1024;
constexpr size_t WS_WPE = 1 * MiB, WS_WPAB = 2 * MiB, WS_WO = 10 * MiB, WS_WPG = 18 * MiB, WS_PBF = 26 * MiB;
constexpr size_t WS_VSS = 30 * MiB + 512 * 1024;
constexpr size_t WS_TSS = WS_VSS + (size_t)MT * 16 * 4;
constexpr size_t WS_RSTD = WS_TSS + (size_t)MT * 32 * 4;
constexpr size_t WS_DEC = 33 * MiB;
constexpr size_t WS_W1T = 34 * MiB;
constexpr size_t WS_QT = 34 * MiB, WS_ATT = 42 * MiB, WS_KTT = 50 * MiB;
constexpr size_t WS_E = 34 * MiB;
constexpr size_t WS_XN = 76 * MiB, WS_Y = 76 * MiB;
constexpr size_t WS_U = 112 * MiB  , WS_V = 130 * MiB, WS_Q = 166 * MiB, WS_KB = 175 * MiB, WS_VB = 184 * MiB, WS_SZB = 202 * MiB, WS_GA = 220 * MiB, WS_GB = 256 * MiB;
constexpr size_t WS_LA = 292 * MiB;
constexpr size_t WS_O = 58 * MiB;
constexpr size_t WS_SLABA = 112 * MiB;
constexpr size_t WS_M = 148 * MiB;
constexpr size_t WS_T = 184 * MiB;
constexpr size_t WS_H = 112 * MiB;
constexpr size_t WS_ES = 312 * MiB;
constexpr size_t WS_END = 316 * MiB;
static_assert(WS_RSTD + (size_t)MT * 4 <= WS_DEC && WS_DEC + 16 * 32 * 128 * 4 <= WS_W1T && WS_W1T + (size_t)N1 * 2048 * 2 <= WS_XN, "ws map");
constexpr int CW_GRP = 8192;
constexpr int CW_PAN = 9216;
constexpr int CW_BAR = 4096;

constexpr int LDS_BYTES = 155648;
constexpr int MISC_OFF = LDS_BYTES - 256;

#define GAS __attribute__((address_space(1)))
#define LAS __attribute__((address_space(3)))
typedef unsigned short bf16;
typedef unsigned v4u __attribute__((ext_vector_type(4)));
typedef unsigned v2u __attribute__((ext_vector_type(2)));
typedef float f32x4 __attribute__((ext_vector_type(4)));
typedef short bf16x8 __attribute__((ext_vector_type(8)));
typedef GAS unsigned gu32;
#define RLX_AGENT __ATOMIC_RELAXED, __HIP_MEMORY_SCOPE_AGENT
__device__ __forceinline__ unsigned pk2(float lo, float hi) { return pg8::cvt_pk_bf16(lo, hi); }
__device__ __forceinline__ unsigned f2bf(float f) { return pg8::cvt_pk_bf16(f, 0.f) & 0xffffu; }
__device__ __forceinline__ float bflo(unsigned w) { return __uint_as_float(w << 16); }
__device__ __forceinline__ float bfhi(unsigned w) { return __uint_as_float(w & 0xffff0000u); }
__device__ __forceinline__ float bf2f(bf16 h) { return __uint_as_float((unsigned)h << 16); }
__device__ __forceinline__ float sigm(float x) { return __builtin_amdgcn_rcpf(1.f + __expf(-x)); }
__device__ __forceinline__ float wave_sum(float v) {
#pragma unroll
    for (int o = 1; o < 64; o <<= 1) v += __shfl_xor(v, o);
    return v;
}

#define XB_TMO      128
#define XB_XCNT(j)  (256  + 64 * (j))
#define XB_XSUB(j)  (1280 + 64 * (j))
#define XB_XGEN(j)  (2304 + 64 * (j))
#define XB_TOP      3328
#define XB_TOPGEN   3392
#define XCD_BAR_WORDS 3456
#define XB_SPIN_CAP (1u << 18)
__device__ __forceinline__ unsigned xb_ld(unsigned* p)              { return __hip_atomic_load(p, __ATOMIC_RELAXED, __HIP_MEMORY_SCOPE_AGENT); }
__device__ __forceinline__ unsigned xb_add(unsigned* p, unsigned v) { return __hip_atomic_fetch_add(p, v, __ATOMIC_RELAXED, __HIP_MEMORY_SCOPE_AGENT); }
__device__ __forceinline__ unsigned xb_xcc_id() { return (unsigned)__builtin_amdgcn_s_getreg((3 << 11) | 20) & 0xFu; }
#define XB_SPIN(cond, bar) do { unsigned _sp = 0; while (cond) { __builtin_amdgcn_s_sleep(1); \
    if ((++_sp & 255u) == 0u) { if (xb_ld(&(bar)[XB_TMO])) break; if (_sp > XB_SPIN_CAP) { atomicAdd(&(bar)[XB_TMO], 1u); break; } } } } while (0)
struct XcdBarrier { unsigned* bar; unsigned x; volatile LAS unsigned* st; };
__device__ __forceinline__ XcdBarrier xcd_barrier_post(unsigned* bar, volatile LAS unsigned* st) {
    XcdBarrier b; b.bar = bar; b.x = xb_xcc_id(); b.st = st;
    if (threadIdx.x == 0) (void)xb_add(&bar[XB_XCNT(b.x)], 1u);
    return b;
}
__device__ __forceinline__ void xcd_barrier_complete(unsigned* bar, unsigned x, unsigned& nloc, unsigned& nx) {
    const unsigned G = gridDim.x * gridDim.y * gridDim.z;
    unsigned sum, cnt, mine, sp = 0u;
    for (;;) {
        sum = 0u; cnt = 0u; mine = 0u;
#pragma unroll
        for (unsigned j = 0; j < 16; ++j) { const unsigned c = xb_ld(&bar[XB_XCNT(j)]); sum += c; cnt += (c > 0u) ? 1u : 0u; mine = (j == x) ? c : mine; }
        if (sum == G) break;
        __builtin_amdgcn_s_sleep(1);
        if ((++sp & 255u) == 0u) { if (xb_ld(&bar[XB_TMO])) break; if (sp > XB_SPIN_CAP) { atomicAdd(&bar[XB_TMO], 1u); break; } }
    }
    nloc = mine > 0u ? mine : 1u; nx = cnt > 0u ? cnt : 1u;
}
__device__ __forceinline__ void xcd_barrier(const XcdBarrier& b) {
    asm volatile("s_waitcnt vmcnt(0)" ::: "memory");
    __syncthreads();
    if (threadIdx.x == 0) {
        unsigned* bar = b.bar;
        __builtin_amdgcn_s_waitcnt(0);
        unsigned nloc = b.st[0], nx = b.st[1];
        if (nloc == 0u) { xcd_barrier_complete(bar, b.x, nloc, nx); b.st[0] = nloc; b.st[1] = nx; }
        const unsigned old = xb_add(&bar[XB_XSUB(b.x)], 1u);
        const unsigned gen = old / nloc;
        if (old + 1u == (gen + 1u) * nloc) {
            __builtin_amdgcn_fence(__ATOMIC_RELEASE, "agent");
            asm volatile("s_waitcnt vmcnt(0)" ::: "memory");
            const unsigned og = xb_add(&bar[XB_TOP], 1u);
            const unsigned tg = og / nx;
            if (og + 1u == (tg + 1u) * nx) xb_add(&bar[XB_TOPGEN], 1u);
            else XB_SPIN(xb_ld(&bar[XB_TOPGEN]) == tg, bar);
            __builtin_amdgcn_fence(__ATOMIC_ACQUIRE, "agent");
            xb_add(&bar[XB_XGEN(b.x)], 1u);
            asm volatile("s_waitcnt vmcnt(0)" ::: "memory");
        } else {
            XB_SPIN(xb_ld(&bar[XB_XGEN(b.x)]) == gen, bar);
            __builtin_amdgcn_fence(__ATOMIC_ACQUIRE, "agent");
            asm volatile("s_waitcnt vmcnt(0)" ::: "memory");
        }
    }
    __syncthreads();
}

struct Frame {
    LAS unsigned char* lds;
    unsigned char* ws;
    int wave, vcu, G;
    const float *xp, *xs, *pp, *ps, *st0, *g_pre, *w_in, *g_v, *w_s, *b_s, *w_a2, *b_a, *g_o, *w_pa, *w_pb, *w_o, *g_post, *w_pg, *w_pe;
    float* out;
};
__device__ __forceinline__ const float* xrow(const Frame& F, int m) { return m < MP ? F.xp + (size_t)m * DM : F.xs + (size_t)(m - MP) * DM; }

struct ConvItem { const float* src; bf16* dst; int spitch, dpitch; };
constexpr int I_IN = 32 * 320, I_PA = 16 * 64, I_PB = 16 * 64, I_O = 32 * 64, I_PG = 32 * 64, I_PE = 4 * 64, NITEMS = I_IN + I_PA + I_PB + I_O + I_PG + I_PE;
__device__ __forceinline__ void conv_item(const Frame& F, int it, ConvItem& d) {
    int r = it;
    if (r < I_IN) { const int kb = r / 320, n0 = (r % 320) * 32;
        const int src = n0 < 2048 ? ((n0 & 32) ? 2048 : 0) + 128 * (n0 >> 8) + 32 * ((n0 & 255) >> 6) : n0 < 3072 ? n0 - 1024 : n0 + (n0 >= C_ALR ? GR : 0);
        d.src = F.w_in + (size_t)(kb * 64) * NIN + src; d.spitch = NIN; d.dst = (bf16*)(F.ws + WS_W1T) + (size_t)n0 * 2048 + kb * 64; d.dpitch = 2048; return; } r -= I_IN;
    const int k0 = (r / 64) * 64, n0 = (r % 64) * 32; d.spitch = DM; d.dpitch = 2048;
    if (r < I_PA) { d.src = F.w_pa + (size_t)k0 * DM + n0; d.dst = (bf16*)(F.ws + WS_WPAB) + (size_t)n0 * 2048 + k0; return; } r -= I_PA;
    { const int k1 = (r / 64) * 64, n1 = (r % 64) * 32;
      if (r < I_PB) { d.src = F.w_pb + (size_t)k1 * DM + n1; d.dst = (bf16*)(F.ws + WS_WPAB) + (size_t)n1 * 2048 + 1024 + k1; return; } } r -= I_PB;
    { const int k1 = (r / 64) * 64, n1 = (r % 64) * 32;
      if (r < I_O) { d.src = F.w_o + (size_t)k1 * DM + n1; d.dst = (bf16*)(F.ws + WS_WO) + (size_t)n1 * 2048 + k1; return; } } r -= I_O;
    { const int k1 = (r / 64) * 64, n1 = (r % 64) * 32;
      if (r < I_PG) { d.src = F.w_pg + (size_t)k1 * DM + n1; d.dst = (bf16*)(F.ws + WS_WPG) + (size_t)n1 * 2048 + k1; return; } } r -= I_PG;
    { const int k1 = (r / 64) * 64, n1 = (r % 64) * 32; d.src = F.w_pe + (size_t)k1 * DM + n1; d.dst = (bf16*)(F.ws + WS_WPE) + (size_t)n1 * 256 + k1; d.dpitch = 256; }
}
__device__ __forceinline__ void conv_load(const ConvItem& d, f32x4 (&v)[8], int lane) {
    const int r = lane >> 3, c4 = (lane & 7) * 4;
#pragma unroll
    for (int i = 0; i < 8; ++i) v[i] = __builtin_nontemporal_load((const GAS f32x4*)(d.src + (size_t)(8 * i + r) * d.spitch + c4));
}
__device__ __forceinline__ void conv_finish(const ConvItem& d, const f32x4 (&v)[8], LAS float* scr, int lane) {
    const int r = lane >> 3, c4 = (lane & 7) * 4;
#pragma unroll
    for (int i = 0; i < 8; ++i) { LAS float* p = scr + (8 * i + r) * 33 + c4; p[0] = v[i].x; p[1] = v[i].y; p[2] = v[i].z; p[3] = v[i].w; }
    asm volatile("s_waitcnt lgkmcnt(0)" ::: "memory");
    const int c = lane & 7;
#pragma unroll
    for (int j = 0; j < 4; ++j) { const int n = (lane >> 3) + 8 * j; const LAS float* s = scr + (8 * c) * 33 + n;
        v4u o; o.x = pk2(s[0 * 33], s[1 * 33]); o.y = pk2(s[2 * 33], s[3 * 33]); o.z = pk2(s[4 * 33], s[5 * 33]); o.w = pk2(s[6 * 33], s[7 * 33]);
        *(GAS v4u*)(d.dst + (size_t)n * d.dpitch + 8 * c) = o; }
    asm volatile("s_waitcnt lgkmcnt(0)" ::: "memory");
}
__device__ __forceinline__ void p0_prologue(Frame& F) {
    LAS float* scr = (LAS float*)(F.lds + F.wave * 16384);
    const int gw = F.vcu * NWAVES + F.wave, NGW = F.G * NWAVES, ln = (int)(threadIdx.x & 63u);
    bf16* W1T = (bf16*)(F.ws + WS_W1T);
    { f32x4 va[8], vb[8]; ConvItem da, db; int it = gw; bool ha = it < NITEMS;
      if (ha) { conv_item(F, it, da); conv_load(da, va, ln); }
      while (ha) {
          const int it2 = it + NGW; const bool hb = it2 < NITEMS;
          if (hb) { conv_item(F, it2, db); conv_load(db, vb, ln); }
          conv_finish(da, va, scr, ln);
          if (!hb) break;
          it = it2 + NGW; ha = it < NITEMS;
          if (ha) { conv_item(F, it, da); conv_load(da, va, ln); }
          conv_finish(db, vb, scr, ln);
      } }
    {
        const int gt = F.vcu * NTHR + ((int)threadIdx.x), NGT = F.G * NTHR;
        for (int p = gt; p < 512 * 256; p += NGT) { const int ch = p & 511, k0 = (p >> 9) * 8; float wa[16];
#pragma unroll
            for (int r = 0; r < 16; ++r) wa[r] = F.w_a2[r * KBW + ch];
            float t[8];
#pragma unroll
            for (int i = 0; i < 8; ++i) { const GAS f32x4* wr4 = (const GAS f32x4*)(F.w_in + (size_t)(k0 + i) * NIN + C_ALR); float a = 0.f;
#pragma unroll
                for (int r4 = 0; r4 < 4; ++r4) { const f32x4 w = wr4[r4]; a += w.x * wa[4 * r4] + w.y * wa[4 * r4 + 1] + w.z * wa[4 * r4 + 2] + w.w * wa[4 * r4 + 3]; }
                t[i] = a; }
            v4u o; o.x = pk2(t[0], t[1]); o.y = pk2(t[2], t[3]); o.z = pk2(t[4], t[5]); o.w = pk2(t[6], t[7]);
            *(GAS v4u*)(W1T + (size_t)(10240 + ch) * 2048 + k0) = o; }
        bf16* PBF = (bf16*)(F.ws + WS_PBF);
        for (int p = gt; p < MT * PLE / 8; p += NGT) { const size_t e = (size_t)p * 8; const float* src = e < (size_t)MP * PLE ? F.pp + e : F.ps + (e - (size_t)MP * PLE);
            const f32x4 a = __builtin_nontemporal_load((const GAS f32x4*)src), b = __builtin_nontemporal_load((const GAS f32x4*)(src + 4)); v4u o; o.x = pk2(a.x, a.y); o.y = pk2(a.z, a.w); o.z = pk2(b.x, b.y); o.w = pk2(b.z, b.w);
            *(GAS v4u*)(PBF + e) = o; }
    }
    bf16* XN = (bf16*)(F.ws + WS_XN);
    { const GAS f32x4* gr = (const GAS f32x4*)F.g_pre + ln; f32x4 va[8], vb[8]; int m = gw; bool ha = m < MT;
#define XN_LOAD(v, mm) do { const GAS f32x4* xr_ = (const GAS f32x4*)xrow(F, (mm)) + ln; _Pragma("unroll") for (int j_ = 0; j_ < 8; ++j_) v[j_] = __builtin_nontemporal_load(xr_ + 64 * j_); } while (0)
#define XN_FINISH(v, mm) do { float s_ = 0.f; _Pragma("unroll") for (int j_ = 0; j_ < 8; ++j_) s_ += (v[j_].x * v[j_].x + v[j_].y * v[j_].y) + (v[j_].z * v[j_].z + v[j_].w * v[j_].w); \
        const float rstd_ = 1.0f / sqrtf(wave_sum(s_) * (1.f / DM) + EPS); GAS v2u* o8_ = (GAS v2u*)(XN + (size_t)(mm) * DM) + ln; \
        _Pragma("unroll") for (int j_ = 0; j_ < 8; ++j_) { const f32x4 gg_ = gr[64 * j_]; v2u o_; o_.x = pk2(v[j_].x * rstd_ * gg_.x, v[j_].y * rstd_ * gg_.y); o_.y = pk2(v[j_].z * rstd_ * gg_.z, v[j_].w * rstd_ * gg_.w); o8_[64 * j_] = o_; } } while (0)
      if (ha) XN_LOAD(va, m);
      while (ha) {
          const int m2 = m + NGW; const bool hb = m2 < MT;
          if (hb) XN_LOAD(vb, m2);
          XN_FINISH(va, m);
          if (!hb) break;
          m = m2 + NGW; ha = m < MT;
          if (ha) XN_LOAD(va, m);
          XN_FINISH(vb, m2);
      }
#undef XN_LOAD
#undef XN_FINISH
    }
}

using pg8::Unit;
template <int ACT>
__device__ __forceinline__ void g1_store(const pg8::f32x4 (&acc)[2][2][4][2], bf16* base, int ldc, int row0, int col0, float* vss, int wc, int fq) {
#pragma unroll
    for (int ai = 0; ai < 2; ++ai)
#pragma unroll
        for (int m = 0; m < 4; ++m) { const int row = row0 + ai * 128 + m * 16; bf16* rowp = base + (size_t)row * ldc + col0; float ss = 0.f;
#pragma unroll
            for (int bj = 0; bj < 2; ++bj) { float v[8];
#pragma unroll
                for (int e = 0; e < 8; ++e) { float x = acc[ai][bj][m][e >> 2][e & 3];
                    if (ACT == 1) x = x * sigm(x); else if (ACT == 2) x = sigm(x); else if (ACT == 3) x = x * 0.08838834764831845f;
                    if (ACT == 4) ss += x * x; v[e] = x; }
                v4u w; w.x = pg8::cvt_pk_bf16(v[0], v[1]); w.y = pg8::cvt_pk_bf16(v[2], v[3]); w.z = pg8::cvt_pk_bf16(v[4], v[5]); w.w = pg8::cvt_pk_bf16(v[6], v[7]);
                *(GAS v4u*)(rowp + bj * 32) = w; }
            if (ACT == 4) { ss += __shfl_xor(ss, 16); ss += __shfl_xor(ss, 32); if (fq == 0) vss[(size_t)row * 16 + wc] = ss; } }
}
__device__ __forceinline__ float log_sigmoid(float z) { return -(fmaxf(-z, 0.f) + __logf(1.f + __expf(-fabsf(z)))); }
__device__ __forceinline__ unsigned q8(float x) { const unsigned q = (unsigned)__builtin_fmaf(sigm(x), 255.f, 0.5f); return q < 1u ? 1u : q; }
__device__ __forceinline__ void g1_store_u8(const pg8::f32x4 (&acc)[2][2][4][2], unsigned char* base, int row0, int col0) {
#pragma unroll
    for (int ai = 0; ai < 2; ++ai)
#pragma unroll
        for (int m = 0; m < 4; ++m) { unsigned char* rowp = base + (size_t)(row0 + ai * 128 + m * 16) * DM + col0;
#pragma unroll
            for (int bj = 0; bj < 2; ++bj) { const pg8::f32x4 a = acc[ai][bj][m][0], b = acc[ai][bj][m][1]; v2u w;
                w.x = q8(a.x) | (q8(a.y) << 8) | (q8(a.z) << 16) | (q8(a.w) << 24); w.y = q8(b.x) | (q8(b.y) << 8) | (q8(b.z) << 16) | (q8(b.w) << 24);
                *(GAS v2u*)(rowp + bj * 32) = w; } }
}
__device__ __forceinline__ void u8x8_to_f32(v2u w, float (&f)[8]) {
    f[0] = (float)(w.x & 0xffu); f[1] = (float)((w.x >> 8) & 0xffu); f[2] = (float)((w.x >> 16) & 0xffu); f[3] = (float)(w.x >> 24);
    f[4] = (float)(w.y & 0xffu); f[5] = (float)((w.y >> 8) & 0xffu); f[6] = (float)((w.y >> 16) & 0xffu); f[7] = (float)(w.y >> 24);
}
struct EpiG1 {
    static constexpr bool PERM = true, HAS_MID = false;
    unsigned char* ws; const float* b_a;
    __device__ __forceinline__ void operator()(const pg8::f32x4 (&acc)[2][2][4][2], const Unit& u, int wr, int wc, int fr, int fq) const {
        const int pn = u.pn, row0 = u.pm * 256 + wr * 64 + fr, cin = wc * 64 + 8 * fq;
        if (pn < 8) {
            bf16* UZ = (bf16*)(ws + WS_U);
#pragma unroll
            for (int ai = 0; ai < 2; ++ai)
#pragma unroll
                for (int m = 0; m < 4; ++m) { const pg8::f32x4 u0 = acc[ai][0][m][0], u1 = acc[ai][0][m][1], z0 = acc[ai][1][m][0], z1 = acc[ai][1][m][1]; v4u w;
                    w.x = pg8::cvt_pk_bf16(u0.x * z0.x * sigm(z0.x), u0.y * z0.y * sigm(z0.y)); w.y = pg8::cvt_pk_bf16(u0.z * z0.z * sigm(z0.z), u0.w * z0.w * sigm(z0.w));
                    w.z = pg8::cvt_pk_bf16(u1.x * z1.x * sigm(z1.x), u1.y * z1.y * sigm(z1.y)); w.w = pg8::cvt_pk_bf16(u1.z * z1.z * sigm(z1.z), u1.w * z1.w * sigm(z1.w));
                    *(GAS v4u*)(UZ + (size_t)(row0 + ai * 128 + m * 16) * EA + pn * 128 + wc * 32 + 8 * fq) = w; } }
        else if (pn < 12) g1_store<4>(acc, (bf16*)(ws + WS_V), 1024, row0, (pn - 8) * 256 + cin, (float*)(ws + WS_VSS) + (pn - 8) * 4, wc, fq);
        else if (pn < 14) g1_store<3>(acc, (bf16*)(ws + WS_Q), 512, row0, (pn - 12) * 256 + cin, nullptr, wc, fq);
        else if (pn < 16) g1_store<0>(acc, (bf16*)(ws + WS_KB), 512, row0, (pn - 14) * 256 + cin, nullptr, wc, fq);
        else if (pn < 20) g1_store<0>(acc, (bf16*)(ws + WS_VB), 1024, row0, (pn - 16) * 256 + cin, nullptr, wc, fq);
        else if (pn < 24) g1_store<1>(acc, (bf16*)(ws + WS_SZB), 1024, row0, (pn - 20) * 256 + cin, nullptr, wc, fq);
        else if (pn < 32) g1_store_u8(acc, ws + WS_GA, row0, (pn - 24) * 256 + cin);
        else if (pn < 40) g1_store_u8(acc, ws + WS_GB, row0, (pn - 32) * 256 + cin);
        else {
            float* la = (float*)(ws + WS_LA); const int c0 = (pn - 40) * 256 + cin;
            pg8::f32x4 bb[2][2];
#pragma unroll
            for (int bj = 0; bj < 2; ++bj) { bb[bj][0] = *(const GAS pg8::f32x4*)(b_a + c0 + bj * 32); bb[bj][1] = *(const GAS pg8::f32x4*)(b_a + c0 + bj * 32 + 4); }
#pragma unroll
            for (int ai = 0; ai < 2; ++ai)
#pragma unroll
                for (int m = 0; m < 4; ++m) { float* rp = la + (size_t)(row0 + ai * 128 + m * 16) * KBW + c0;
#pragma unroll
                    for (int bj = 0; bj < 2; ++bj)
#pragma unroll
                        for (int n = 0; n < 2; ++n) { const pg8::f32x4 z = acc[ai][bj][m][n] + bb[bj][n]; pg8::f32x4 o;
                            o.x = log_sigmoid(z.x) * 0.0625f; o.y = log_sigmoid(z.y) * 0.0625f; o.z = log_sigmoid(z.z) * 0.0625f; o.w = log_sigmoid(z.w) * 0.0625f;
                            *(GAS pg8::f32x4*)(rp + bj * 32 + n * 4) = o; } }
        }
    }
};
struct EpiBf {
    static constexpr bool PERM = true, HAS_MID = false;
    bf16* O; int ldc;
    __device__ __forceinline__ void operator()(const pg8::f32x4 (&acc)[2][2][4][2], const Unit& u, int wr, int wc, int fr, int fq) const {
        g1_store<0>(acc, O, ldc, u.pm * 256 + wr * 64 + fr, u.pn * 256 + wc * 64 + 8 * fq, nullptr, wc, fq);
    }
};
template <bool PERM>
__device__ __forceinline__ void slab_store(const pg8::f32x4 (&acc)[2][2][4][2], bf16* lo, bf16* hi, const Unit& u, int wr, int wc, int fr, int fq) {
    const int ks = u.kt0 >> 2; bf16* sl = ks < 4 ? lo + (size_t)ks * MS * DM : hi + (size_t)(ks - 4) * MS * DM;
    const int row0 = (u.pm - 32) * 256 + wr * 64 + fr, col0 = u.pn * 256 + wc * 64 + (PERM ? 8 : 4) * fq;
#pragma unroll
    for (int ai = 0; ai < 2; ++ai)
#pragma unroll
        for (int m = 0; m < 4; ++m) { bf16* rp = sl + (size_t)(row0 + ai * 128 + m * 16) * DM + col0;
#pragma unroll
            for (int bj = 0; bj < 2; ++bj) {
                if (PERM) { const pg8::f32x4 a = acc[ai][bj][m][0], b = acc[ai][bj][m][1]; *(GAS v4u*)(rp + bj * 32) = (v4u){pk2(a.x, a.y), pk2(a.z, a.w), pk2(b.x, b.y), pk2(b.z, b.w)}; }
                else {
#pragma unroll
                    for (int n = 0; n < 2; ++n) { const pg8::f32x4 a = acc[ai][bj][m][n]; *(GAS v2u*)(rp + bj * 32 + n * 16) = (v2u){pk2(a.x, a.y), pk2(a.z, a.w)}; } } } }
}
__device__ __forceinline__ const bf16* slab_ptr(const bf16* lo, const bf16* hi, int ks) { return ks < 4 ? lo + (size_t)ks * MS * DM : hi + (size_t)(ks - 4) * MS * DM; }
__device__ __forceinline__ void slab_sum8(const bf16* lo, const bf16* hi, size_t off, int k0, int k1, pg8::f32x4& s0, pg8::f32x4& s1) {
    s0 = (pg8::f32x4){0.f, 0.f, 0.f, 0.f}; s1 = s0;
#pragma unroll
    for (int ks = 0; ks < 8; ++ks) if (ks >= k0 && ks < k1) { const v4u w = *(const GAS v4u*)(slab_ptr(lo, hi, ks) + off);
        s0.x += bflo(w.x); s0.y += bfhi(w.x); s0.z += bflo(w.y); s0.w += bfhi(w.y); s1.x += bflo(w.z); s1.y += bfhi(w.z); s1.z += bflo(w.w); s1.w += bfhi(w.w); }
}
__device__ __forceinline__ pg8::f32x4 slab_sum4(const bf16* lo, const bf16* hi, size_t off) {
    pg8::f32x4 a = (pg8::f32x4){0.f, 0.f, 0.f, 0.f};
#pragma unroll
    for (int ks = 0; ks < 8; ++ks) { const v2u w = *(const GAS v2u*)(slab_ptr(lo, hi, ks) + off); a.x += bflo(w.x); a.y += bfhi(w.x); a.z += bflo(w.y); a.w += bfhi(w.y); }
    return a;
}
struct EpiG2 {
    static constexpr bool PERM = true, HAS_MID = true;
    const unsigned char* GA; const unsigned char* GB; bf16* Mo; bf16* slo; bf16* shi;
    __device__ __forceinline__ void mid(pg8::f32x4 (&acc)[2][2][4][2], const Unit& u, int wr, int wc, int fr, int fq) const {
        asm volatile("" : "+v"(fr));
        const unsigned off0 = (unsigned)((u.pm * 256 + wr * 64 + fr) * DM + u.pn * 256 + wc * 64 + 8 * fq);
#pragma unroll
        for (int ai = 0; ai < 2; ++ai)
#pragma unroll
            for (int m = 0; m < 4; ++m) { const unsigned off = off0 + (unsigned)((ai * 128 + m * 16) * DM);
#pragma unroll
                for (int bj = 0; bj < 2; ++bj) { const v2u a = *(const GAS v2u*)(GA + off + bj * 32), b = *(const GAS v2u*)(GB + off + bj * 32); float fa[8], fb[8]; u8x8_to_f32(a, fa); u8x8_to_f32(b, fb);
#pragma unroll
                    for (int e = 0; e < 8; ++e) acc[ai][bj][m][e >> 2][e & 3] *= fa[e] * __builtin_amdgcn_rcpf(fb[e]); }
                if (m == 3) asm volatile("" ::: "memory"); }
    }
    __device__ __forceinline__ void operator()(const pg8::f32x4 (&acc)[2][2][4][2], const Unit& u, int wr, int wc, int fr, int fq) const {
        if (u.kind) { slab_store<true>(acc, slo, shi, u, wr, wc, fr, fq); return; }
        const int row0 = u.pm * 256 + wr * 64 + fr, col0 = u.pn * 256 + wc * 64 + 8 * fq;
#pragma unroll
        for (int ai = 0; ai < 2; ++ai)
#pragma unroll
            for (int m = 0; m < 4; ++m) { const size_t off = (size_t)(row0 + ai * 128 + m * 16) * DM + col0;
#pragma unroll
                for (int bj = 0; bj < 2; ++bj) { const v2u b = *(const GAS v2u*)(GB + off + bj * 32); float fb[8]; u8x8_to_f32(b, fb); unsigned w[4];
#pragma unroll
                    for (int p = 0; p < 4; ++p) w[p] = pg8::cvt_pk_bf16(acc[ai][bj][m][p >> 1][(p & 1) * 2] * (fb[2 * p] * (1.f / 255.f)), acc[ai][bj][m][p >> 1][(p & 1) * 2 + 1] * (fb[2 * p + 1] * (1.f / 255.f)));
                    *(GAS v4u*)(Mo + off + bj * 32) = (v4u){w[0], w[1], w[2], w[3]}; }
                if (m & 1) asm volatile("" ::: "memory"); }
    }
};
struct EpiG3 {
    static constexpr bool PERM = true, HAS_MID = false;
    bf16* T; float* tss; bf16* slo; bf16* shi;
    int fused; bf16* H; float* xs; unsigned* cnt; const float* xp; const float* gpost; LAS unsigned char* lx;
    __device__ __forceinline__ void operator()(const pg8::f32x4 (&acc)[2][2][4][2], const Unit& u, int wr, int wc, int fr, int fq) const {
        if (u.kind) { slab_store<true>(acc, slo, shi, u, wr, wc, fr, fq); return; }
        const int row0 = u.pm * 256 + wr * 64 + fr, col0 = u.pn * 256 + wc * 64 + 8 * fq;
        if (!fused) {
#pragma unroll
            for (int ai = 0; ai < 2; ++ai)
#pragma unroll
                for (int m = 0; m < 4; ++m) { const int row = row0 + ai * 128 + m * 16; bf16* rowp = T + (size_t)row * DM + col0; float ss = 0.f;
#pragma unroll
                    for (int bj = 0; bj < 2; ++bj) { const pg8::f32x4 a = acc[ai][bj][m][0], b = acc[ai][bj][m][1];
                        ss += (a.x * a.x + a.y * a.y) + (a.z * a.z + a.w * a.w) + (b.x * b.x + b.y * b.y) + (b.z * b.z + b.w * b.w);
                        v4u w; w.x = pg8::cvt_pk_bf16(a.x, a.y); w.y = pg8::cvt_pk_bf16(a.z, a.w); w.z = pg8::cvt_pk_bf16(b.x, b.y); w.w = pg8::cvt_pk_bf16(b.z, b.w);
                        *(GAS v4u*)(rowp + bj * 32) = w; }
                    ss += __shfl_xor(ss, 16); ss += __shfl_xor(ss, 32); if (fq == 0) tss[(size_t)row * 32 + u.pn * 4 + wc] = ss; }
            return;
        }
        LAS float* P = (LAS float*)lx; LAS float* S = P + 1024; volatile LAS unsigned* flag = (volatile LAS unsigned*)(S + 256);
        const int tid = threadIdx.x, lane = tid & 63, wid = __builtin_amdgcn_readfirstlane(tid >> 6);
#pragma unroll
        for (int ai = 0; ai < 2; ++ai)
#pragma unroll
            for (int m = 0; m < 4; ++m) { float ss = 0.f;
#pragma unroll
                for (int bj = 0; bj < 2; ++bj) { const pg8::f32x4 a = acc[ai][bj][m][0], b = acc[ai][bj][m][1]; ss += (a.x * a.x + a.y * a.y) + (a.z * a.z + a.w * a.w) + (b.x * b.x + b.y * b.y) + (b.z * b.z + b.w * b.w); }
                ss += __shfl_xor(ss, 16); ss += __shfl_xor(ss, 32); if (fq == 0) P[(ai * 128 + wr * 64 + m * 16 + fr) * 4 + wc] = ss; }
        asm volatile("s_waitcnt lgkmcnt(0)" ::: "memory"); __builtin_amdgcn_s_barrier(); asm volatile("" ::: "memory");
        if (tid < 256) { const pg8::f32x4 p = *(const LAS pg8::f32x4*)(P + tid * 4);
            __hip_atomic_store(xs + (size_t)(u.pm * 256 + tid) * 8 + u.pn, (p.x + p.y) + (p.z + p.w), __ATOMIC_RELAXED, __HIP_MEMORY_SCOPE_AGENT); }
        asm volatile("s_waitcnt vmcnt(0)" ::: "memory");
        if (tid < 256 && lane == 0) (void)__hip_atomic_fetch_add(cnt + 64 * u.pm, 1u, __ATOMIC_RELAXED, __HIP_MEMORY_SCOPE_AGENT);
        if (wid == 0) { unsigned sp = 0;
            while ((unsigned)__builtin_amdgcn_readfirstlane(__hip_atomic_load(cnt + 64 * u.pm, __ATOMIC_RELAXED, __HIP_MEMORY_SCOPE_AGENT)) < 32u) { __builtin_amdgcn_s_sleep(2); if (++sp > (1u << 20)) break; }
            __builtin_amdgcn_fence(__ATOMIC_ACQUIRE, "agent"); asm volatile("s_waitcnt vmcnt(0)" ::: "memory"); if (lane == 0) flag[0] = 1u; }
        asm volatile("s_waitcnt lgkmcnt(0)" ::: "memory"); __builtin_amdgcn_s_barrier(); asm volatile("" ::: "memory");
        if (tid < 256) { const float* sl = xs + (size_t)(u.pm * 256 + tid) * 8; float t = 0.f;
#pragma unroll
            for (int q = 0; q < 8; ++q) t += __hip_atomic_load(sl + q, __ATOMIC_RELAXED, __HIP_MEMORY_SCOPE_AGENT);
            S[tid] = 1.0f / sqrtf(t * (1.f / DM) + EPS); }
        asm volatile("s_waitcnt lgkmcnt(0)" ::: "memory"); __builtin_amdgcn_s_barrier(); asm volatile("" ::: "memory");
        pg8::f32x4 gp[2][2];
#pragma unroll
        for (int bj = 0; bj < 2; ++bj) { gp[bj][0] = *(const GAS pg8::f32x4*)(gpost + col0 + bj * 32); gp[bj][1] = *(const GAS pg8::f32x4*)(gpost + col0 + bj * 32 + 4); }
#pragma unroll
        for (int ai = 0; ai < 2; ++ai)
#pragma unroll
            for (int m = 0; m < 4; ++m) { const int rl = ai * 128 + wr * 64 + m * 16 + fr; const float rs = S[rl]; const size_t off = (size_t)(u.pm * 256 + rl) * DM + col0;
#pragma unroll
                for (int bj = 0; bj < 2; ++bj) { const pg8::f32x4 x0 = *(const GAS pg8::f32x4*)(xp + off + bj * 32), x1 = *(const GAS pg8::f32x4*)(xp + off + bj * 32 + 4); const pg8::f32x4 a = acc[ai][bj][m][0], b = acc[ai][bj][m][1], g0 = gp[bj][0], g1 = gp[bj][1];
                    v4u w; w.x = pg8::cvt_pk_bf16(x0.x + a.x * rs * g0.x, x0.y + a.y * rs * g0.y); w.y = pg8::cvt_pk_bf16(x0.z + a.z * rs * g0.z, x0.w + a.w * rs * g0.w);
                    w.z = pg8::cvt_pk_bf16(x1.x + b.x * rs * g1.x, x1.y + b.y * rs * g1.y); w.w = pg8::cvt_pk_bf16(x1.z + b.z * rs * g1.z, x1.w + b.w * rs * g1.w);
                    *(GAS v4u*)(H + off + bj * 32) = w; }
                if (m & 1) asm volatile("" ::: "memory"); }
    }
};
struct EpiG4 {
    static constexpr bool PERM = true, HAS_MID = false;
    const bf16 *H, *E; float* out; bf16* slo; bf16* shi;
    __device__ __forceinline__ void operator()(const pg8::f32x4 (&acc)[2][2][4][2], const Unit& u, int wr, int wc, int fr, int fq) const {
        if (u.kind) { slab_store<true>(acc, slo, shi, u, wr, wc, fr, fq); return; }
        const int row0 = u.pm * 256 + wr * 64 + fr, col0 = u.pn * 256 + wc * 64 + 8 * fq;
#pragma unroll
        for (int ai = 0; ai < 2; ++ai)
#pragma unroll
            for (int m = 0; m < 4; ++m) {
#pragma unroll
                for (int bj = 0; bj < 2; ++bj) { const size_t o2 = (size_t)(row0 + ai * 128 + m * 16) * DM + col0 + bj * 32; const v4u h4 = *(const GAS v4u*)(H + o2), e4 = *(const GAS v4u*)(E + o2);
                    const pg8::f32x4 a = acc[ai][bj][m][0], b = acc[ai][bj][m][1];
                    pg8::f32x4 o0, o1; o0.x = bflo(h4.x) + sigm(a.x) * bflo(e4.x); o0.y = bfhi(h4.x) + sigm(a.y) * bfhi(e4.x); o0.z = bflo(h4.y) + sigm(a.z) * bflo(e4.y); o0.w = bfhi(h4.y) + sigm(a.w) * bfhi(e4.y);
                    o1.x = bflo(h4.z) + sigm(b.x) * bflo(e4.z); o1.y = bfhi(h4.z) + sigm(b.y) * bfhi(e4.z); o1.z = bflo(h4.w) + sigm(b.z) * bflo(e4.w); o1.w = bfhi(h4.w) + sigm(b.w) * bfhi(e4.w);
                    *(GAS pg8::f32x4*)(out + o2) = o0; *(GAS pg8::f32x4*)(out + o2 + 4) = o1; }
                asm volatile("" ::: "memory"); }
    }
};

constexpr int GWP = 136, GVP = 68;
__device__ __forceinline__ void gate_prompt_unit(Frame& F, int unit) {
    int tid = ((int)threadIdx.x); asm volatile("" : "+v"(tid));
    const int g = unit & 3, c = (unit >> 2) & 15, b = unit >> 6, r0 = b * SEQ + c * CH, lane = tid & 63, wave = F.wave, fr = lane & 15, fq = lane >> 4;
    LAS bf16* WL = (LAS bf16*)F.lds;
    LAS unsigned* VT = (LAS unsigned*)(F.lds + 128 * GWP * 2);
    LAS float* RS = (LAS float*)(F.lds + 128 * GWP * 2 + 256 * GVP * 4);
    const bf16* U = (const bf16*)(F.ws + WS_U); const bf16* V = (const bf16*)(F.ws + WS_V); const float* VSS = (const float*)(F.ws + WS_VSS);
    bf16* Y = (bf16*)(F.ws + WS_Y);
    __syncthreads();
    if (tid < 128) { const GAS f32x4* p = (const GAS f32x4*)(VSS + (size_t)(r0 + tid) * 16); const f32x4 a = p[0], b4 = p[1], c4 = p[2], d4 = p[3];
        const float ss = ((a.x + a.y) + (a.z + a.w)) + ((b4.x + b4.y) + (b4.z + b4.w)) + ((c4.x + c4.y) + (c4.z + c4.w)) + ((d4.x + d4.y) + (d4.z + d4.w));
        RS[tid] = 1.0f / sqrtf(ss * (1.f / EA) + EPS); }
    { const float* W = F.w_s + (size_t)g * CH * CH;
#pragma unroll
      for (int i = 0; i < 4; ++i) { const int p = tid + NTHR * i, t = p >> 4, s8 = (p & 15) * 8; const f32x4 w0 = *(const GAS f32x4*)(W + t * CH + s8), w1 = *(const GAS f32x4*)(W + t * CH + s8 + 4); v4u o;
          o.x = pk2(s8 <= t ? w0.x : 0.f, s8 + 1 <= t ? w0.y : 0.f); o.y = pk2(s8 + 2 <= t ? w0.z : 0.f, s8 + 3 <= t ? w0.w : 0.f);
          o.z = pk2(s8 + 4 <= t ? w1.x : 0.f, s8 + 5 <= t ? w1.y : 0.f); o.w = pk2(s8 + 6 <= t ? w1.z : 0.f, s8 + 7 <= t ? w1.w : 0.f);
          *(LAS v4u*)(WL + t * GWP + s8) = o; } }
    __syncthreads();
#pragma unroll
    for (int i = 0; i < 4; ++i) { const int idx = tid + NTHR * i, cg = ((idx >> 5) & 3) * 8 + (idx & 7), sp = (idx >> 7) * 4 + ((idx >> 3) & 3), s0 = 2 * sp;
        const v4u ra = *(const GAS v4u*)(V + (size_t)(r0 + s0) * EA + g * DV + 8 * cg), rb = *(const GAS v4u*)(V + (size_t)(r0 + s0 + 1) * EA + g * DV + 8 * cg);
        const GAS f32x4* gv = (const GAS f32x4*)(F.g_v + g * DV + 8 * cg); const f32x4 g0 = gv[0], g1 = gv[1]; const float ra_s = RS[s0], rb_s = RS[s0 + 1];
        const float gg[8] = {g0.x, g0.y, g0.z, g0.w, g1.x, g1.y, g1.z, g1.w}; const unsigned wa[4] = {ra.x, ra.y, ra.z, ra.w}, wb[4] = {rb.x, rb.y, rb.z, rb.w};
        LAS unsigned* dst = VT + (8 * cg) * GVP + (sp ^ (4 * (cg & 7)));
#pragma unroll
        for (int e = 0; e < 4; ++e) { dst[(2 * e) * GVP] = pk2(bflo(wa[e]) * ra_s * gg[2 * e], bflo(wb[e]) * rb_s * gg[2 * e]); dst[(2 * e + 1) * GVP] = pk2(bfhi(wa[e]) * ra_s * gg[2 * e + 1], bfhi(wb[e]) * rb_s * gg[2 * e + 1]); } }
    __syncthreads();
    pg8::f32x4 acc[16];
#pragma unroll
    for (int q = 0; q < 16; ++q) acc[q] = (pg8::f32x4){0.f, 0.f, 0.f, 0.f};
    const int nkk = (wave >> 1) + 1;
    for (int kk = 0; kk < nkk; ++kk) { const bf16x8 bw = *(const LAS bf16x8*)(WL + (16 * wave + fr) * GWP + 32 * kk + 8 * fq);
#pragma unroll
        for (int q = 0; q < 16; ++q) { const int d = 64 * (q >> 2) + 16 * (fr >> 2) + 4 * (q & 3) + (fr & 3);
            const bf16x8 af = *(const LAS bf16x8*)(VT + d * GVP + ((16 * kk + 4 * fq) ^ (4 * ((d >> 3) & 7))));
            acc[q] = __builtin_amdgcn_mfma_f32_16x16x32_bf16(af, bw, acc[q], 0, 0, 0); } }
    { const int t = 16 * wave + fr; const float bs = F.b_s[g * CH + t];
#pragma unroll
      for (int G4 = 0; G4 < 4; ++G4) { const size_t o1 = (size_t)(r0 + t) * EA + g * DV + 64 * G4 + 16 * fq; const v4u u0 = *(const GAS v4u*)(U + o1), u1 = *(const GAS v4u*)(U + o1 + 8);
          const unsigned uw[8] = {u0.x, u0.y, u0.z, u0.w, u1.x, u1.y, u1.z, u1.w}; unsigned yw[8];
#pragma unroll
          for (int n = 0; n < 4; ++n) { const pg8::f32x4 sv = acc[G4 * 4 + n];
              yw[2 * n] = pk2(bflo(uw[2 * n]) * (sv.x + bs), bfhi(uw[2 * n]) * (sv.y + bs));
              yw[2 * n + 1] = pk2(bflo(uw[2 * n + 1]) * (sv.z + bs), bfhi(uw[2 * n + 1]) * (sv.w + bs)); }
          bf16* yp = Y + (size_t)(r0 + t) * DM + g * DV + 64 * G4 + 16 * fq;
          *(GAS v4u*)yp = (v4u){yw[0], yw[1], yw[2], yw[3]}; *(GAS v4u*)(yp + 8) = (v4u){yw[4], yw[5], yw[6], yw[7]}; } }
}

__device__ __forceinline__ void sample_unit(Frame& F, int unit) {
    int tid = ((int)threadIdx.x); asm volatile("" : "+v"(tid));
    const int h = unit & 3, sb = unit >> 2, r0 = MP + sb * DSEQ, lane = tid & 63, wave = F.wave;
    LAS float* L = (LAS float*)F.lds;
    LAS float* QT = L; LAS float* KT = L + 1024; LAS float* KD = L + 2048; LAS float* DC = L + 3072; LAS float* ATT = L + 3200; LAS float* RS = L + 3264; LAS float* QS = L + 3400; LAS float* RED = L + 4608;
    const bf16* Vb = (const bf16*)(F.ws + WS_V); const bf16* U = (const bf16*)(F.ws + WS_U); const float* VSS = (const float*)(F.ws + WS_VSS);
    const bf16* Q = (const bf16*)(F.ws + WS_Q); const bf16* KBp = (const bf16*)(F.ws + WS_KB); const bf16* VB = (const bf16*)(F.ws + WS_VB); const bf16* SZB = (const bf16*)(F.ws + WS_SZB);
    const float* LAg = (const float*)(F.ws + WS_LA); bf16* Y = (bf16*)(F.ws + WS_Y);
    const int d = tid & 255, th = tid >> 8, col = h * DV + d, v4 = lane, dg = wave, chp = h * DK + (tid & 127);
    f32x4 ssv[4]; float bsv = 0.f; if (tid < 8) { const GAS f32x4* p = (const GAS f32x4*)(VSS + (size_t)(r0 + tid) * 16); ssv[0] = p[0]; ssv[1] = p[1]; ssv[2] = p[2]; ssv[3] = p[3]; bsv = F.b_s[h * CH + tid]; }
    float wsv = 0.f; if (tid < 64) wsv = F.w_s[(size_t)h * CH * CH + (tid >> 3) * CH + (tid & 7)];
    bf16 vraw[8], uraw[4];
#pragma unroll
    for (int s2 = 0; s2 < 8; ++s2) vraw[s2] = Vb[(size_t)(r0 + s2) * EA + col];
#pragma unroll
    for (int i = 0; i < 4; ++i) uraw[i] = U[(size_t)(r0 + th * 4 + i) * EA + col];
    const float gv = F.g_v[col];
    float laraw[8]; bf16 qraw[8], kraw[8];
    if (tid < 128) {
#pragma unroll
        for (int t = 0; t < 8; ++t) { laraw[t] = LAg[(size_t)(r0 + t) * KBW + chp]; qraw[t] = Q[(size_t)(r0 + t) * KBW + chp]; kraw[t] = KBp[(size_t)(r0 + t) * KBW + chp]; } }
    v2u vvraw[8];
#pragma unroll
    for (int s2 = 0; s2 < 8; ++s2) vvraw[s2] = *(const GAS v2u*)(VB + (size_t)(r0 + s2) * EB + h * DV + 4 * v4);
    const v2u zz = *(const GAS v2u*)(SZB + (size_t)(r0 + wave) * EB + h * DV + 4 * v4); const f32x4 go = *(const GAS f32x4*)(F.g_o + h * DV + 4 * v4);
    const float* S0 = F.st0 + ((size_t)(sb * HB + h) * DK) * DV; float* SN = F.out + OUT_SS + ((size_t)(sb * HB + h) * DK) * DV;
    f32x4 s0r[16];
#pragma unroll
    for (int dd = 0; dd < 16; ++dd) s0r[dd] = __builtin_nontemporal_load((const GAS f32x4*)(S0 + (size_t)(dg * 16 + dd) * DV + 4 * v4));
    __syncthreads();
    if (tid < 8) { const f32x4 a = ssv[0], b4 = ssv[1], c4 = ssv[2], d4 = ssv[3];
        const float ss = ((a.x + a.y) + (a.z + a.w)) + ((b4.x + b4.y) + (b4.z + b4.w)) + ((c4.x + c4.y) + (c4.z + c4.w)) + ((d4.x + d4.y) + (d4.z + d4.w));
        RS[tid] = 1.0f / sqrtf(ss * (1.f / EA) + EPS); RS[8 + tid] = bsv; }
    if (tid < 64) RS[16 + tid] = wsv;
    __syncthreads();
    {
        float vn[8];
#pragma unroll
        for (int s2 = 0; s2 < 8; ++s2) vn[s2] = bf2f(vraw[s2]) * RS[s2] * gv;
#pragma unroll
        for (int i = 0; i < 4; ++i) { const int t = th * 4 + i; float S = RS[8 + t];
#pragma unroll
            for (int s2 = 0; s2 < 8; ++s2) if (s2 <= t) S += RS[16 + t * 8 + s2] * vn[s2];
            Y[(size_t)(r0 + t) * DM + col] = (bf16)f2bf(bf2f(uraw[i]) * S);
            float vt = 0.f;
#pragma unroll
            for (int s2 = 0; s2 < 8; ++s2) vt = (s2 == t) ? vn[s2] : vt;
            F.out[OUT_CV + (size_t)(sb * DSEQ + t) * EA + col] = vt; }
    }
    if (tid < 128) { const int dq = tid; float bc[8]; float run = 0.f;
#pragma unroll
        for (int t = 0; t < 8; ++t) { run += laraw[t]; bc[t] = run; }
        const float dcv = __expf(run); DC[dq] = dcv;
#pragma unroll
        for (int t = 0; t < 8; ++t) { const float q = bf2f(qraw[t]), k = bf2f(kraw[t]);
            const float eb = __expf(bc[t]), ek = __builtin_amdgcn_rcpf(eb); const float qt = q * eb, kt = k * ek; QT[dq * 8 + t] = qt; QS[t * 128 + dq] = qt; KT[t * 128 + dq] = kt; KD[dq * 8 + t] = kt * dcv; }
    }
    __syncthreads();
    { const int p = tid >> 3, part = tid & 7, t = p >> 3, s2 = p & 7; float a = 0.f;
      if (s2 <= t) {
#pragma unroll
          for (int dd = 0; dd < 16; ++dd) a += QS[t * 128 + part * 16 + dd] * KT[s2 * 128 + part * 16 + dd]; }
      a += __shfl_xor(a, 1); a += __shfl_xor(a, 2); a += __shfl_xor(a, 4);
      if (part == 0) ATT[p] = a; }
    f32x4 vv[8];
#pragma unroll
    for (int s2 = 0; s2 < 8; ++s2) vv[s2] = (f32x4){bflo(vvraw[s2].x), bfhi(vvraw[s2].x), bflo(vvraw[s2].y), bfhi(vvraw[s2].y)};
    f32x4 oacc[8];
#pragma unroll
    for (int t = 0; t < 8; ++t) oacc[t] = (f32x4){0.f, 0.f, 0.f, 0.f};
#pragma unroll
    for (int dd = 0; dd < 16; ++dd) { const int dr = dg * 16 + dd; const f32x4 s0 = s0r[dd];
        const f32x4 q0 = *(const LAS f32x4*)(QT + dr * 8), q1 = *(const LAS f32x4*)(QT + dr * 8 + 4), k0 = *(const LAS f32x4*)(KD + dr * 8), k1 = *(const LAS f32x4*)(KD + dr * 8 + 4);
        oacc[0] += q0.x * s0; oacc[1] += q0.y * s0; oacc[2] += q0.z * s0; oacc[3] += q0.w * s0; oacc[4] += q1.x * s0; oacc[5] += q1.y * s0; oacc[6] += q1.z * s0; oacc[7] += q1.w * s0;
        f32x4 sn = DC[dr] * s0; sn += k0.x * vv[0]; sn += k0.y * vv[1]; sn += k0.z * vv[2]; sn += k0.w * vv[3]; sn += k1.x * vv[4]; sn += k1.y * vv[5]; sn += k1.z * vv[6]; sn += k1.w * vv[7];
        __builtin_nontemporal_store(sn, (GAS f32x4*)(SN + (size_t)dr * DV + 4 * v4)); }
#pragma unroll
    for (int t = 0; t < 8; ++t) *(LAS f32x4*)(RED + (dg * 8 + t) * 256 + 4 * v4) = oacc[t];
    __syncthreads();
    { const int t = wave; f32x4 o = (f32x4){0.f, 0.f, 0.f, 0.f};
#pragma unroll
      for (int g2 = 0; g2 < 8; ++g2) o += *(const LAS f32x4*)(RED + (g2 * 8 + t) * 256 + 4 * v4);
#pragma unroll
      for (int s2 = 0; s2 < 8; ++s2) o += ATT[t * 8 + s2] * vv[s2];
      const float ss = wave_sum((o.x * o.x + o.y * o.y) + (o.z * o.z + o.w * o.w)); const float rs = 1.0f / sqrtf(ss * (1.f / DV) + EPS);
      v2u w; w.x = pk2(o.x * rs * go.x * bflo(zz.x), o.y * rs * go.y * bfhi(zz.x)); w.y = pk2(o.z * rs * go.z * bflo(zz.y), o.w * rs * go.w * bfhi(zz.y));
      *(GAS v2u*)(Y + (size_t)(r0 + t) * DM + EA + h * DV + 4 * v4) = w; }
}

constexpr int PRP = 264, PRT = 68;
__device__ __forceinline__ void prep_unit(Frame& F, int unit) {
    int tid = ((int)threadIdx.x); asm volatile("" : "+v"(tid));
    const int hp = unit & 1, cc = (unit >> 1) & 31, b = unit >> 6, r0 = b * SEQ + cc * GC, ch = tid & 255, th = tid >> 8, c0 = hp * 256;
    LAS bf16* QL = (LAS bf16*)F.lds;
    LAS bf16* KL = QL + 64 * PRP;
    LAS bf16* KTL = KL + 64 * PRP;
    LAS float* TOT = (LAS float*)(KTL + 256 * PRT);
    const float* LAg = (const float*)(F.ws + WS_LA); const bf16* Q = (const bf16*)(F.ws + WS_Q); const bf16* KBp = (const bf16*)(F.ws + WS_KB);
    bf16* QTg = (bf16*)(F.ws + WS_QT); bf16* KTT = (bf16*)(F.ws + WS_KTT); float* DEC = (float*)(F.ws + WS_DEC);
    __syncthreads();
    float bl[32]; float run = 0.f;
#pragma unroll
    for (int i2 = 0; i2 < 32; ++i2) { run += LAg[(size_t)(r0 + 32 * th + i2) * KBW + c0 + ch]; bl[i2] = run; }
    TOT[th * 256 + ch] = run;
    __syncthreads();
    const float t0 = TOT[ch], t1 = TOT[256 + ch], off = th ? t0 : 0.f;
    if (th == 0) DEC[((size_t)(b * HB + 2 * hp + (ch >> 7)) * NCH + cc) * DK + (ch & 127)] = __expf(t0 + t1);
#pragma unroll
    for (int i2 = 0; i2 < 32; ++i2) { const int t = 32 * th + i2; const float eb = __expf(bl[i2] + off), ek = __builtin_amdgcn_rcpf(eb);
        const float q = bf2f(Q[(size_t)(r0 + t) * KBW + c0 + ch]), k = bf2f(KBp[(size_t)(r0 + t) * KBW + c0 + ch]);
        const bf16 kb = (bf16)f2bf(k * ek); QL[t * PRP + ch] = (bf16)f2bf(q * eb); KL[t * PRP + ch] = kb; KTL[ch * PRT + t] = kb; }
    __syncthreads();
#pragma unroll
    for (int i2 = 0; i2 < 4; ++i2) { const int p = tid + NTHR * i2, t = p >> 5, c8 = (p & 31) * 8; const size_t o = ((size_t)(b * HB + 2 * hp + (c8 >> 7)) * SEQ + cc * GC + t) * DK + (c8 & 127);
        *(GAS v4u*)(QTg + o) = *(const LAS v4u*)(QL + t * PRP + c8); }
    { const int lane = tid & 63, fr = lane & 15, fq = lane >> 4, hl = F.wave >> 2, ti = F.wave & 3; bf16* ATg = (bf16*)(F.ws + WS_ATT) + ((size_t)(b * HB + 2 * hp + hl) * NCH + cc) * GC * GC;
      bf16x8 qf[4];
#pragma unroll
      for (int kk = 0; kk < 4; ++kk) qf[kk] = *(const LAS bf16x8*)(QL + (16 * ti + fr) * PRP + hl * 128 + 32 * kk + 8 * fq);
#pragma unroll
      for (int si = 0; si < 4; ++si) { pg8::f32x4 a = (pg8::f32x4){0.f, 0.f, 0.f, 0.f};
          if (si <= ti) {
#pragma unroll
              for (int kk = 0; kk < 4; ++kk) a = __builtin_amdgcn_mfma_f32_16x16x32_bf16(*(const LAS bf16x8*)(KL + (16 * si + fr) * PRP + hl * 128 + 32 * kk + 8 * fq), qf[kk], a, 0, 0, 0); }
          const int t = 16 * ti + fr, s0 = 16 * si + 4 * fq; v2u w;
          w.x = pk2(s0 <= t ? a.x : 0.f, s0 + 1 <= t ? a.y : 0.f); w.y = pk2(s0 + 2 <= t ? a.z : 0.f, s0 + 3 <= t ? a.w : 0.f);
          *(GAS v2u*)(ATg + t * GC + s0) = w; } }
#pragma unroll
    for (int i2 = 0; i2 < 4; ++i2) { const int p = tid + NTHR * i2, chh = p >> 3, t8 = (p & 7) * 8; const v2u a = *(const LAS v2u*)(KTL + chh * PRT + t8), c2 = *(const LAS v2u*)(KTL + chh * PRT + t8 + 4);
        *(GAS v4u*)(KTT + (((size_t)(b * HB + 2 * hp + (chh >> 7)) * NCH + cc) * DK + (chh & 127)) * GC + t8) = (v4u){a.x, a.y, c2.x, c2.y}; }
}

constexpr int PQ = 136, PS64 = 72;
__device__ __forceinline__ bf16x8 ldfrag(const LAS bf16* base, int row, int pitch, int k0) { return *(const LAS bf16x8*)(base + row * pitch + k0); }
struct GlaStage { v4u q[2], kt[2], at, v; float dec; };
template <int NVT>
__device__ __forceinline__ void gla_unit(Frame& F, int unit, bool fuse_norm) {
    constexpr int SW = 16 * NVT, NSL = DV / SW, VPR = SW / 8  ;
    int tid = ((int)threadIdx.x); asm volatile("" : "+v"(tid));
    const int bh = unit / NSL, j = unit % NSL, b = bh >> 2, h = bh & 3, lane = tid & 63, wave = F.wave, fr = lane & 15, fq = lane >> 4;
    constexpr int SET_E = 64 * PQ + 128 * PS64 + SW * PS64 + 64 * PS64 + 256;
    LAS bf16* L0 = (LAS bf16*)F.lds; LAS bf16* STL = L0 + 2 * SET_E;
    const bf16* QTg = (const bf16*)(F.ws + WS_QT) + (size_t)bh * SEQ * DK; const bf16* ATg = (const bf16*)(F.ws + WS_ATT) + (size_t)bh * NCH * GC * GC;
    const bf16* KTT = (const bf16*)(F.ws + WS_KTT) + (size_t)bh * NCH * DK * GC; const float* DEC = (const float*)(F.ws + WS_DEC) + (size_t)bh * NCH * DK;
    const bf16* VB = (const bf16*)(F.ws + WS_VB) + (size_t)(b * SEQ) * EB + h * DV + j * SW; bf16* O = (bf16*)(F.ws + WS_O) + (size_t)(b * SEQ) * EB + h * DV + j * SW;
    __syncthreads();
    for (int i = tid; i < 2 * SW * PQ / 2; i += NTHR) ((LAS unsigned*)STL)[i] = 0u;
#define GLA_LD16(dst, ptr) asm volatile("global_load_dwordx4 %0, %1, off" : "=v"(dst) : "v"(ptr) : "memory")
#define GLA_FETCH(R, c) do { const int c_ = (c) < NCH ? (c) : NCH - 1; \
        GLA_LD16(R.q[0], QTg + (size_t)c_ * GC * DK + tid * 8); GLA_LD16(R.q[1], QTg + (size_t)c_ * GC * DK + (tid + NTHR) * 8); \
        GLA_LD16(R.kt[0], KTT + (size_t)c_ * DK * GC + tid * 8); GLA_LD16(R.kt[1], KTT + (size_t)c_ * DK * GC + (tid + NTHR) * 8); \
        GLA_LD16(R.at, ATg + (size_t)c_ * GC * GC + tid * 8); \
        { const int tv_ = tid % (64 * VPR), s_ = tv_ / VPR, hf_ = tv_ % VPR; GLA_LD16(R.v, VB + (size_t)(c_ * GC + s_) * EB + hf_ * 8); } \
        asm volatile("global_load_dword %0, %1, off" : "=v"(R.dec) : "v"(DEC + c_ * DK + (tid & 127)) : "memory"); } while (0)
#define GLA_WAIT(R, n) asm volatile("s_waitcnt vmcnt(" #n ")" : "+v"(R.q[0]), "+v"(R.q[1]), "+v"(R.kt[0]), "+v"(R.kt[1]), "+v"(R.at), "+v"(R.v), "+v"(R.dec) :: "memory")
#define GLA_COMMIT(R, set) do { LAS bf16* QL_ = L0 + (set) * SET_E; LAS bf16* KTL_ = QL_ + 64 * PQ; LAS bf16* VTL_ = KTL_ + 128 * PS64; LAS bf16* ATL_ = VTL_ + SW * PS64; LAS float* DCL_ = (LAS float*)(ATL_ + 64 * PS64); \
        _Pragma("unroll") for (int i_ = 0; i_ < 2; ++i_) { const int p_ = tid + NTHR * i_; { const int r_ = p_ >> 4, cch_ = p_ & 15; *(LAS v4u*)(QL_ + r_ * PQ + cch_ * 8) = R.q[i_]; } \
            { const int r_ = p_ >> 3, cch_ = p_ & 7; *(LAS v4u*)(KTL_ + r_ * PS64 + cch_ * 8) = R.kt[i_]; } } \
        { const int r_ = tid >> 3, cch_ = tid & 7; *(LAS v4u*)(ATL_ + r_ * PS64 + cch_ * 8) = R.at; } \
        if (tid < 64 * VPR) { const int s_ = tid / VPR, hf_ = tid % VPR; const unsigned w_[4] = {R.v.x, R.v.y, R.v.z, R.v.w}; \
            _Pragma("unroll") for (int e_ = 0; e_ < 4; ++e_) { VTL_[(hf_ * 8 + 2 * e_) * PS64 + s_] = (bf16)(w_[e_] & 0xffffu); VTL_[(hf_ * 8 + 2 * e_ + 1) * PS64 + s_] = (bf16)(w_[e_] >> 16); } } \
        if (tid < 128) DCL_[tid] = R.dec; } while (0)
    pg8::f32x4 sacc[2][NVT];
#pragma unroll
    for (int e = 0; e < 2; ++e)
#pragma unroll
        for (int vt = 0; vt < NVT; ++vt) sacc[e][vt] = (pg8::f32x4){0.f, 0.f, 0.f, 0.f};
    GlaStage ra, rb, rc;
    GLA_FETCH(ra, 0); GLA_WAIT(ra, 0); GLA_COMMIT(ra, 0); GLA_FETCH(ra, 1); GLA_FETCH(rb, 2); GLA_FETCH(rc, 3);
    __syncthreads();
#define GLA_STEP(R, cc) { const int c = (cc); GLA_WAIT(R, 14); if (c + 1 < NCH) GLA_COMMIT(R, (c + 1) & 1); GLA_FETCH(R, c + 4);
    for (int c3 = 0; c3 < NCH; c3 += 3) {
        GLA_STEP(ra, c3)
        const LAS bf16* QL = L0 + (c & 1) * SET_E; const LAS bf16* KTL = QL + 64 * PQ; const LAS bf16* VTL = KTL + 128 * PS64; const LAS bf16* ATL = VTL + SW * PS64; const LAS float* DCL = (const LAS float*)(ATL + 64 * PS64);
        const LAS bf16* STc = STL + (c & 1) * SW * PQ; LAS bf16* STn = STL + ((c + 1) & 1) * SW * PQ;
        if (wave < 4) {
            const int ti = wave; pg8::f32x4 o[NVT];
#pragma unroll
            for (int vt = 0; vt < NVT; ++vt) o[vt] = (pg8::f32x4){0.f, 0.f, 0.f, 0.f};
#pragma unroll
            for (int kk = 0; kk < 2; ++kk) { const bf16x8 bf = ldfrag(ATL, 16 * ti + fr, PS64, 32 * kk + 8 * fq);
#pragma unroll
                for (int vt = 0; vt < NVT; ++vt) o[vt] = __builtin_amdgcn_mfma_f32_16x16x32_bf16(ldfrag(VTL, 16 * vt + fr, PS64, 32 * kk + 8 * fq), bf, o[vt], 0, 0, 0); }
#pragma unroll
            for (int kk = 0; kk < 4; ++kk) { const bf16x8 bf = ldfrag(QL, 16 * ti + fr, PQ, 32 * kk + 8 * fq);
#pragma unroll
                for (int vt = 0; vt < NVT; ++vt) o[vt] = __builtin_amdgcn_mfma_f32_16x16x32_bf16(ldfrag(STc, 16 * vt + fr, PQ, 32 * kk + 8 * fq), bf, o[vt], 0, 0, 0); }
#pragma unroll
            for (int vt = 0; vt < NVT; ++vt) *(GAS v2u*)(O + (size_t)(c * GC + 16 * ti + fr) * EB + 16 * vt + 4 * fq) = (v2u){pk2(o[vt].x, o[vt].y), pk2(o[vt].z, o[vt].w)};
        } else {
#pragma unroll
            for (int e = 0; e < 2; ++e) { const int dt = 2 * (wave - 4) + e; const pg8::f32x4 dc = *(const LAS pg8::f32x4*)(DCL + 16 * dt + 4 * fq);
                const bf16x8 a0 = ldfrag(KTL, 16 * dt + fr, PS64, 8 * fq), a1 = ldfrag(KTL, 16 * dt + fr, PS64, 32 + 8 * fq);
#pragma unroll
                for (int vt = 0; vt < NVT; ++vt) { pg8::f32x4 sv = sacc[e][vt];
                    sv = __builtin_amdgcn_mfma_f32_16x16x32_bf16(a0, ldfrag(VTL, 16 * vt + fr, PS64, 8 * fq), sv, 0, 0, 0);
                    sv = __builtin_amdgcn_mfma_f32_16x16x32_bf16(a1, ldfrag(VTL, 16 * vt + fr, PS64, 32 + 8 * fq), sv, 0, 0, 0);
                    sv = sv * dc; sacc[e][vt] = sv; v2u w; w.x = pk2(sv.x, sv.y); w.y = pk2(sv.z, sv.w);
                    *(LAS v2u*)(STn + (16 * vt + fr) * PQ + 16 * dt + 4 * fq) = w; } }
        }
        __syncthreads();
        }
        if (c3 + 1 < NCH) GLA_STEP(rb, c3 + 1)
        const LAS bf16* QL = L0 + (c & 1) * SET_E; const LAS bf16* KTL = QL + 64 * PQ; const LAS bf16* VTL = KTL + 128 * PS64; const LAS bf16* ATL = VTL + SW * PS64; const LAS float* DCL = (const LAS float*)(ATL + 64 * PS64);
        const LAS bf16* STc = STL + (c & 1) * SW * PQ; LAS bf16* STn = STL + ((c + 1) & 1) * SW * PQ;
        if (wave < 4) {
            const int ti = wave; pg8::f32x4 o[NVT];
#pragma unroll
            for (int vt = 0; vt < NVT; ++vt) o[vt] = (pg8::f32x4){0.f, 0.f, 0.f, 0.f};
#pragma unroll
            for (int kk = 0; kk < 2; ++kk) { const bf16x8 bf = ldfrag(ATL, 16 * ti + fr, PS64, 32 * kk + 8 * fq);
#pragma unroll
                for (int vt = 0; vt < NVT; ++vt) o[vt] = __builtin_amdgcn_mfma_f32_16x16x32_bf16(ldfrag(VTL, 16 * vt + fr, PS64, 32 * kk + 8 * fq), bf, o[vt], 0, 0, 0); }
#pragma unroll
            for (int kk = 0; kk < 4; ++kk) { const bf16x8 bf = ldfrag(QL, 16 * ti + fr, PQ, 32 * kk + 8 * fq);
#pragma unroll
                for (int vt = 0; vt < NVT; ++vt) o[vt] = __builtin_amdgcn_mfma_f32_16x16x32_bf16(ldfrag(STc, 16 * vt + fr, PQ, 32 * kk + 8 * fq), bf, o[vt], 0, 0, 0); }
#pragma unroll
            for (int vt = 0; vt < NVT; ++vt) *(GAS v2u*)(O + (size_t)(c * GC + 16 * ti + fr) * EB + 16 * vt + 4 * fq) = (v2u){pk2(o[vt].x, o[vt].y), pk2(o[vt].z, o[vt].w)};
        } else {
#pragma unroll
            for (int e = 0; e < 2; ++e) { const int dt = 2 * (wave - 4) + e; const pg8::f32x4 dc = *(const LAS pg8::f32x4*)(DCL + 16 * dt + 4 * fq);
                const bf16x8 a0 = ldfrag(KTL, 16 * dt + fr, PS64, 8 * fq), a1 = ldfrag(KTL, 16 * dt + fr, PS64, 32 + 8 * fq);
#pragma unroll
                for (int vt = 0; vt < NVT; ++vt) { pg8::f32x4 sv = sacc[e][vt];
                    sv = __builtin_amdgcn_mfma_f32_16x16x32_bf16(a0, ldfrag(VTL, 16 * vt + fr, PS64, 8 * fq), sv, 0, 0, 0);
                    sv = __builtin_amdgcn_mfma_f32_16x16x32_bf16(a1, ldfrag(VTL, 16 * vt + fr, PS64, 32 + 8 * fq), sv, 0, 0, 0);
                    sv = sv * dc; sacc[e][vt] = sv; v2u w; w.x = pk2(sv.x, sv.y); w.y = pk2(sv.z, sv.w);
                    *(LAS v2u*)(STn + (16 * vt + fr) * PQ + 16 * dt + 4 * fq) = w; } }
        }
        __syncthreads();
        }
        if (c3 + 2 < NCH) GLA_STEP(rc, c3 + 2)
        const LAS bf16* QL = L0 + (c & 1) * SET_E; const LAS bf16* KTL = QL + 64 * PQ; const LAS bf16* VTL = KTL + 128 * PS64; const LAS bf16* ATL = VTL + SW * PS64; const LAS float* DCL = (const LAS float*)(ATL + 64 * PS64);
        const LAS bf16* STc = STL + (c & 1) * SW * PQ; LAS bf16* STn = STL + ((c + 1) & 1) * SW * PQ;
        if (wave < 4) {
            const int ti = wave; pg8::f32x4 o[NVT];
#pragma unroll
            for (int vt = 0; vt < NVT; ++vt) o[vt] = (pg8::f32x4){0.f, 0.f, 0.f, 0.f};
#pragma unroll
            for (int kk = 0; kk < 2; ++kk) { const bf16x8 bf = ldfrag(ATL, 16 * ti + fr, PS64, 32 * kk + 8 * fq);
#pragma unroll
                for (int vt = 0; vt < NVT; ++vt) o[vt] = __builtin_amdgcn_mfma_f32_16x16x32_bf16(ldfrag(VTL, 16 * vt + fr, PS64, 32 * kk + 8 * fq), bf, o[vt], 0, 0, 0); }
#pragma unroll
            for (int kk = 0; kk < 4; ++kk) { const bf16x8 bf = ldfrag(QL, 16 * ti + fr, PQ, 32 * kk + 8 * fq);
#pragma unroll
                for (int vt = 0; vt < NVT; ++vt) o[vt] = __builtin_amdgcn_mfma_f32_16x16x32_bf16(ldfrag(STc, 16 * vt + fr, PQ, 32 * kk + 8 * fq), bf, o[vt], 0, 0, 0); }
#pragma unroll
            for (int vt = 0; vt < NVT; ++vt) *(GAS v2u*)(O + (size_t)(c * GC + 16 * ti + fr) * EB + 16 * vt + 4 * fq) = (v2u){pk2(o[vt].x, o[vt].y), pk2(o[vt].z, o[vt].w)};
        } else {
#pragma unroll
            for (int e = 0; e < 2; ++e) { const int dt = 2 * (wave - 4) + e; const pg8::f32x4 dc = *(const LAS pg8::f32x4*)(DCL + 16 * dt + 4 * fq);
                const bf16x8 a0 = ldfrag(KTL, 16 * dt + fr, PS64, 8 * fq), a1 = ldfrag(KTL, 16 * dt + fr, PS64, 32 + 8 * fq);
#pragma unroll
                for (int vt = 0; vt < NVT; ++vt) { pg8::f32x4 sv = sacc[e][vt];
                    sv = __builtin_amdgcn_mfma_f32_16x16x32_bf16(a0, ldfrag(VTL, 16 * vt + fr, PS64, 8 * fq), sv, 0, 0, 0);
                    sv = __builtin_amdgcn_mfma_f32_16x16x32_bf16(a1, ldfrag(VTL, 16 * vt + fr, PS64, 32 + 8 * fq), sv, 0, 0, 0);
                    sv = sv * dc; sacc[e][vt] = sv; v2u w; w.x = pk2(sv.x, sv.y); w.y = pk2(sv.z, sv.w);
                    *(LAS v2u*)(STn + (16 * vt + fr) * PQ + 16 * dt + 4 * fq) = w; } }
        }
        __syncthreads();
        }
    }
#undef GLA_STEP
    GLA_WAIT(ra, 0); GLA_WAIT(rb, 0); GLA_WAIT(rc, 0);
    if (wave >= 4) { float* SP = F.out + OUT_SP + (size_t)bh * DK * DV + j * SW;
#pragma unroll
        for (int e = 0; e < 2; ++e) { const int dt = 2 * (wave - 4) + e;
#pragma unroll
            for (int vt = 0; vt < NVT; ++vt)
#pragma unroll
                for (int i = 0; i < 4; ++i) SP[(size_t)(16 * dt + 4 * fq + i) * DV + 16 * vt + fr] = sacc[e][vt][i]; } }
#undef GLA_FETCH
#undef GLA_COMMIT
#undef GLA_WAIT
#undef GLA_LD16
    if (fuse_norm) {
        asm volatile("s_waitcnt vmcnt(0)" ::: "memory");
        __syncthreads();
        if (tid == 0) { unsigned* cnt = (unsigned*)(F.ws + WS_CTL) + CW_GRP + 64 * bh;
            __builtin_amdgcn_fence(__ATOMIC_RELEASE, "agent"); asm volatile("s_waitcnt vmcnt(0)" ::: "memory");
            (void)__hip_atomic_fetch_add(cnt, 1u, __ATOMIC_RELAXED, __HIP_MEMORY_SCOPE_AGENT); }
    }
}
__device__ __forceinline__ void head_norm(Frame& F, int bh, int rlo, unsigned need) {
    const int tid = (int)threadIdx.x, lane = tid & 63, wave = F.wave, b = bh >> 2, h = bh & 3;
    if (tid == 0) { unsigned* cnt = (unsigned*)(F.ws + WS_CTL) + CW_GRP + 64 * bh;
        unsigned sp = 0; while (__hip_atomic_load(cnt, __ATOMIC_RELAXED, __HIP_MEMORY_SCOPE_AGENT) < need) { __builtin_amdgcn_s_sleep(2); if (++sp > (1u << 20)) break; }
        __builtin_amdgcn_fence(__ATOMIC_ACQUIRE, "agent"); asm volatile("s_waitcnt vmcnt(0)" ::: "memory"); }
    __syncthreads();
    const bf16* Oh = (const bf16*)(F.ws + WS_O) + (size_t)(b * SEQ) * EB + h * DV; const bf16* SZB = (const bf16*)(F.ws + WS_SZB) + (size_t)(b * SEQ) * EB + h * DV; bf16* Y = (bf16*)(F.ws + WS_Y) + (size_t)(b * SEQ) * DM + EA + h * DV;
    const f32x4 go = *(const GAS f32x4*)(F.g_o + h * DV + 4 * lane);
    constexpr int NB = 16; v2u ob[NB], zz[NB];
#pragma unroll
    for (int q = 0; q < NB; ++q) { const int row = rlo + wave + NWAVES * q; ob[q] = *(const GAS v2u*)(Oh + (size_t)row * EB + 4 * lane); zz[q] = *(const GAS v2u*)(SZB + (size_t)row * EB + 4 * lane); }
#pragma unroll
    for (int q = 0; q < NB; ++q) { const int row = rlo + wave + NWAVES * q;
        const f32x4 o = (f32x4){bflo(ob[q].x), bfhi(ob[q].x), bflo(ob[q].y), bfhi(ob[q].y)};
        const float ss = wave_sum((o.x * o.x + o.y * o.y) + (o.z * o.z + o.w * o.w)); const float rs = 1.0f / sqrtf(ss * (1.f / DV) + EPS);
        v2u w; w.x = pk2(o.x * rs * go.x * bflo(zz[q].x), o.y * rs * go.y * bfhi(zz[q].x)); w.y = pk2(o.z * rs * go.z * bflo(zz[q].y), o.w * rs * go.w * bfhi(zz[q].y));
        *(GAS v2u*)(Y + (size_t)row * DM + 4 * lane) = w; }
}

struct Args { const float* in[19]; float* out; unsigned char* ws; int ph_lo, ph_hi, li, pad; };
constexpr int NPHASE = 11;
__global__ void __launch_bounds__(NTHR, 2) fwd_kernel(Args args) {
    extern __shared__ __attribute__((aligned(16))) unsigned char lds[];
    Frame F;
    F.lds = (LAS unsigned char*)lds; F.ws = args.ws; F.out = args.out;
    F.wave = __builtin_amdgcn_readfirstlane((int)threadIdx.x >> 6);
    F.G = gridDim.x; { const int bx = blockIdx.x; F.vcu = (F.G % 8 == 0) ? (bx % 8) * (F.G / 8) + bx / 8 : bx; }
    F.xp = args.in[0]; F.xs = args.in[1]; F.pp = args.in[2]; F.ps = args.in[3]; F.st0 = args.in[4]; F.g_pre = args.in[5]; F.w_in = args.in[6]; F.g_v = args.in[7]; F.w_s = args.in[8]; F.b_s = args.in[9];
    F.w_a2 = args.in[10]; F.b_a = args.in[11]; F.g_o = args.in[12]; F.w_pa = args.in[13]; F.w_pb = args.in[14]; F.w_o = args.in[15]; F.g_post = args.in[16]; F.w_pg = args.in[17]; F.w_pe = args.in[18];
    volatile LAS unsigned* MISC = (volatile LAS unsigned*)(F.lds + MISC_OFF);
    if (((int)threadIdx.x) < 64) MISC[((int)threadIdx.x)] = 0u;
    __syncthreads();
    XcdBarrier bar; bar.bar = (unsigned*)(F.ws + WS_CTL) + CW_BAR + args.li * XCD_BAR_WORDS; bar.x = 0; bar.st = nullptr;
    const int lo = args.ph_lo, hi = args.ph_hi;
    if (hi - lo > 1) bar = xcd_barrier_post(bar.bar, MISC + 8);
#define IN(k) (lo <= (k) && (k) < hi)
#define SEAM(k) do { if (IN(k) && IN((k) + 1)) xcd_barrier(bar); } while (0)
    unsigned char* ws = F.ws;

    if (IN(0)) { p0_prologue(F); } SEAM(0);

    if (IN(1)) {
        pg8::Gemm g{(const bf16*)(ws + WS_XN), (const bf16*)(ws + WS_W1T), DM, DM}; pg8::StaticOrder S; S.init(MT, N1, DM, F.G, (int)blockIdx.x);
        EpiG1 E{ws, F.b_a};
        pg8::gemm_phase<EpiG1, pg8::StaticOrder>(F.lds, g, S, E);
        { const int nfullc = S.nwg % F.G;
          pg8::Gemm g2{(const bf16*)(ws + WS_PBF), (const bf16*)(ws + WS_WPE), PLE, PLE}; pg8::ESampleOrder S2{nfullc ? F.G - nfullc : F.G, nfullc ? (int)blockIdx.x - nfullc : (int)blockIdx.x};
          EpiBf E2{(bf16*)(ws + WS_ES) - (size_t)MP * DM, DM};
          pg8::gemm_phase<EpiBf, pg8::ESampleOrder>(F.lds, g2, S2, E2); }
    } SEAM(1);

    const bool hetero = (F.G == 256);
    const bool fuse_norm = hetero || (F.G % 16) == 0;
    if (IN(2)) {
        if (hetero) { for (int u = F.vcu; u < 512; u += F.G) { if (u < 256) prep_unit(F, u); else gate_prompt_unit(F, u - 256); } }
        else { for (int u = F.vcu; u < 1024; u += F.G) { if (u < 256) gate_prompt_unit(F, u); else if (u < 768) sample_unit(F, u - 256); else prep_unit(F, u - 768); } }
    } SEAM(2);

    if (IN(3)) {
        if (hetero) { const int xcd = F.vcu >> 5, l = F.vcu & 31;
            if (l < 16) gla_unit<2>(F, (xcd * 2 + (l >> 3)) * 8 + (l & 7), true);
            else { for (int u = xcd * 16 + (l - 16); u < 512; u += 128) sample_unit(F, u); }
            __syncthreads(); head_norm(F, F.vcu >> 4, 128 * (F.vcu & 15), 8u); }
        else { for (int u = F.vcu; u < 256; u += F.G) gla_unit<1>(F, u, fuse_norm);
               if (fuse_norm) { for (int u = F.vcu; u < 256; u += F.G) head_norm(F, u >> 4, 128 * (u & 15), 16u); } }
    } SEAM(3);

    if (IN(4) && !fuse_norm) {
        const int gw = F.vcu * NWAVES + F.wave, NGW = F.G * NWAVES; const bf16* O = (const bf16*)(ws + WS_O); const bf16* SZB = (const bf16*)(ws + WS_SZB); bf16* Y = (bf16*)(ws + WS_Y);
        for (int m = gw; m < MP; m += NGW) {
#pragma unroll
            for (int h = 0; h < HB; ++h) { const v2u ob = *(const GAS v2u*)(O + (size_t)m * EB + h * DV + 4 * ((int)(threadIdx.x & 63u))); const f32x4 o = (f32x4){bflo(ob.x), bfhi(ob.x), bflo(ob.y), bfhi(ob.y)};
                const float ss = wave_sum((o.x * o.x + o.y * o.y) + (o.z * o.z + o.w * o.w)); const float rs = 1.0f / sqrtf(ss * (1.f / DV) + EPS);
                const f32x4 go = *(const GAS f32x4*)(F.g_o + h * DV + 4 * ((int)(threadIdx.x & 63u))); const v2u zz = *(const GAS v2u*)(SZB + (size_t)m * EB + h * DV + 4 * ((int)(threadIdx.x & 63u)));
                v2u w; w.x = pk2(o.x * rs * go.x * bflo(zz.x), o.y * rs * go.y * bfhi(zz.x)); w.y = pk2(o.z * rs * go.z * bflo(zz.y), o.w * rs * go.w * bfhi(zz.y));
                *(GAS v2u*)(Y + (size_t)m * DM + EA + h * DV + 4 * ((int)(threadIdx.x & 63u))) = w; } }
    } if (!fuse_norm) SEAM(4);

    bf16* const slabA_lo = (bf16*)(ws + WS_SLABA); bf16* const slabA_hi = slabA_lo + (size_t)4 * MS * DM;
    bf16* const slabB_lo = (bf16*)(ws + WS_GA); bf16* const slabB_hi = slabB_lo + (size_t)4 * MS * DM;
    if (IN(5)) {
        { pg8::Gemm g{(const bf16*)(ws + WS_Y), (const bf16*)(ws + WS_WPAB), DM, DM}; pg8::TailOrder S{F.G, (int)blockIdx.x, (int)((blockIdx.x >> 6) & 1)};
          EpiG2 E{ws + WS_GA, ws + WS_GB, (bf16*)(ws + WS_M), slabA_lo, slabA_hi};
          pg8::gemm_phase<EpiG2, pg8::TailOrder>(F.lds, g, S, E); }
    } SEAM(5);

    if (IN(6)) {
        const int gt = F.vcu * NTHR + ((int)threadIdx.x), NGT = F.G * NTHR; const unsigned char* GA = ws + WS_GA; const unsigned char* GB = ws + WS_GB; bf16* Mo = (bf16*)(ws + WS_M);
        for (int p = gt; p < MS * DM / 8; p += NGT) { const size_t off = (size_t)p * 8, og = (size_t)MP * DM + off;
            f32x4 a0, a1, b0, b1; slab_sum8(slabA_lo, slabA_hi, off, 0, 4, a0, a1); slab_sum8(slabA_lo, slabA_hi, off, 4, 8, b0, b1);
            float fa[8], fb[8]; u8x8_to_f32(*(const GAS v2u*)(GA + og), fa); u8x8_to_f32(*(const GAS v2u*)(GB + og), fb); const float k = 1.f / 255.f; v4u w;
            w.x = pk2((fa[0] * a0.x + fb[0] * b0.x) * k, (fa[1] * a0.y + fb[1] * b0.y) * k); w.y = pk2((fa[2] * a0.z + fb[2] * b0.z) * k, (fa[3] * a0.w + fb[3] * b0.w) * k);
            w.z = pk2((fa[4] * a1.x + fb[4] * b1.x) * k, (fa[5] * a1.y + fb[5] * b1.y) * k); w.w = pk2((fa[6] * a1.z + fb[6] * b1.z) * k, (fa[7] * a1.w + fb[7] * b1.w) * k);
            *(GAS v4u*)(Mo + og) = w; }
    } SEAM(6);

    if (IN(7)) {
        pg8::Gemm g{(const bf16*)(ws + WS_M), (const bf16*)(ws + WS_WO), DM, DM}; pg8::TailOrder S{F.G, (int)blockIdx.x, (int)((blockIdx.x >> 6) & 1)};
        EpiG3 E{(bf16*)(ws + WS_T), (float*)(ws + WS_TSS), slabB_lo, slabB_hi, hetero ? 1 : 0, (bf16*)(ws + WS_H), (float*)(ws + WS_TSS), (unsigned*)(ws + WS_CTL) + CW_PAN, F.xp, F.g_post, F.lds + pg8::STAGE_BYTES};
        pg8::gemm_phase<EpiG3, pg8::TailOrder>(F.lds, g, S, E);
    } SEAM(7);

    if (IN(8)) {
        const bf16* T = (const bf16*)(ws + WS_T); const float* TSS = (const float*)(ws + WS_TSS); bf16* H = (bf16*)(ws + WS_H);
        for (int r = F.wave * F.G + F.vcu; r < MS; r += NWAVES * F.G) { const int m = MP + r;
            f32x4 t4[8]; float ss = 0.f;
#pragma unroll
            for (int j2 = 0; j2 < 8; ++j2) { t4[j2] = slab_sum4(slabB_lo, slabB_hi, (size_t)r * DM + 4 * ((int)(threadIdx.x & 63u)) + 256 * j2); ss += (t4[j2].x * t4[j2].x + t4[j2].y * t4[j2].y) + (t4[j2].z * t4[j2].z + t4[j2].w * t4[j2].w); }
            const float rs = 1.0f / sqrtf(wave_sum(ss) * (1.f / DM) + EPS);
            const GAS f32x4* xr = (const GAS f32x4*)xrow(F, m) + ((int)(threadIdx.x & 63u)); const GAS f32x4* gr = (const GAS f32x4*)F.g_post + ((int)(threadIdx.x & 63u)); GAS v2u* ho = (GAS v2u*)(H + (size_t)m * DM) + ((int)(threadIdx.x & 63u));
#pragma unroll
            for (int j2 = 0; j2 < 8; ++j2) { const f32x4 xv = xr[64 * j2], gg = gr[64 * j2], tv = t4[j2]; v2u o, tb; tb.x = pk2(tv.x, tv.y); tb.y = pk2(tv.z, tv.w);
                o.x = pk2(xv.x + bflo(tb.x) * rs * gg.x, xv.y + bfhi(tb.x) * rs * gg.y); o.y = pk2(xv.z + bflo(tb.y) * rs * gg.z, xv.w + bfhi(tb.y) * rs * gg.w); ho[64 * j2] = o; }
        }
        const int gw = F.vcu * NWAVES + F.wave, NGW = F.G * NWAVES;
        for (int m = hetero ? MP : gw; m < MP; m += NGW) {
            float ss = ((int)(threadIdx.x & 63u)) < 32 ? TSS[(size_t)m * 32 + ((int)(threadIdx.x & 63u))] : 0.f; ss = wave_sum(ss); const float rs = 1.0f / sqrtf(ss * (1.f / DM) + EPS);
            const GAS f32x4* xr = (const GAS f32x4*)xrow(F, m) + ((int)(threadIdx.x & 63u)); const GAS f32x4* gr = (const GAS f32x4*)F.g_post + ((int)(threadIdx.x & 63u)); const GAS v2u* tr = (const GAS v2u*)(T + (size_t)m * DM) + ((int)(threadIdx.x & 63u)); GAS v2u* ho = (GAS v2u*)(H + (size_t)m * DM) + ((int)(threadIdx.x & 63u));
#pragma unroll
            for (int j2 = 0; j2 < 8; ++j2) { const f32x4 xv = xr[64 * j2], gg = gr[64 * j2]; const v2u tv = tr[64 * j2]; v2u o;
                o.x = pk2(xv.x + bflo(tv.x) * rs * gg.x, xv.y + bfhi(tv.x) * rs * gg.y); o.y = pk2(xv.z + bflo(tv.y) * rs * gg.z, xv.w + bfhi(tv.y) * rs * gg.w); ho[64 * j2] = o; }
        }
    } SEAM(8);

    if (IN(9)) {
        { pg8::Gemm g{(const bf16*)(ws + WS_PBF), (const bf16*)(ws + WS_WPE), PLE, PLE}; pg8::EPromptOrder S{F.G, (int)blockIdx.x};
          EpiBf E{(bf16*)(ws + WS_E), DM};
          pg8::gemm_phase<EpiBf, pg8::EPromptOrder>(F.lds, g, S, E); }
        pg8::Gemm g{(const bf16*)(ws + WS_H), (const bf16*)(ws + WS_WPG), DM, DM}; pg8::TailOrder S{F.G, (int)blockIdx.x, (int)((blockIdx.x >> 6) & 1)};
        EpiG4 E{(const bf16*)(ws + WS_H), (const bf16*)(ws + WS_E), F.out + OUT_Y, slabB_lo, slabB_hi};
        pg8::gemm_phase<EpiG4, pg8::TailOrder>(F.lds, g, S, E);
    } SEAM(9);

    if (IN(10)) {
        const int gt = F.vcu * NTHR + ((int)threadIdx.x), NGT = F.G * NTHR; const bf16* Hb = (const bf16*)(ws + WS_H); const bf16* Es = (const bf16*)(ws + WS_ES); float* out = F.out + OUT_Y;
        for (int p = gt; p < MS * DM / 4; p += NGT) { const size_t off = (size_t)p * 4, og = (size_t)MP * DM + off;
            const f32x4 a = slab_sum4(slabB_lo, slabB_hi, off); const v2u hv = *(const GAS v2u*)(Hb + og), ev = *(const GAS v2u*)(Es + off);
            f32x4 o; o.x = bflo(hv.x) + sigm(a.x) * bflo(ev.x); o.y = bfhi(hv.x) + sigm(a.y) * bfhi(ev.x); o.z = bflo(hv.y) + sigm(a.z) * bflo(ev.y); o.w = bfhi(hv.y) + sigm(a.w) * bfhi(ev.y);
            *(GAS f32x4*)(out + og) = o; }
    }
#undef IN
#undef SEAM
}

__global__ void dbg_dump(const unsigned short* src, float* dst, size_t n) { for (size_t i = blockIdx.x * (size_t)blockDim.x + threadIdx.x; i < n; i += (size_t)gridDim.x * blockDim.x) dst[i] = __uint_as_float((unsigned)src[i] << 16); }
extern "C" void kernel_launch(void* const* d_in, const int* in_sizes, int n_in, void* d_out, int out_size, void* d_ws, size_t ws_size, hipStream_t stream) {
    static int grid = 0;
    if (grid == 0) {
        if (n_in != 19 || ws_size < WS_END) { fprintf(stderr, "kernel_launch: built for 19 inputs and >= %zu bytes of workspace; got n_in %d, ws %zu\n", (size_t)WS_END, n_in, ws_size); grid = -1; return; }
        int dev = 0, cus = 0, per_cu = 0;
        if (hipGetDevice(&dev) != hipSuccess || hipDeviceGetAttribute(&cus, hipDeviceAttributeMultiprocessorCount, dev) != hipSuccess) { grid = -1; return; }
        if (hipFuncSetAttribute((const void*)fwd_kernel, hipFuncAttributeMaxDynamicSharedMemorySize, LDS_BYTES) != hipSuccess) { fprintf(stderr, "kernel_launch: hipFuncSetAttribute failed\n"); grid = -1; return; }
        if (hipOccupancyMaxActiveBlocksPerMultiprocessor(&per_cu, (const void*)fwd_kernel, NTHR, LDS_BYTES) != hipSuccess || per_cu < 1) { fprintf(stderr, "kernel_launch: occupancy query says %d blocks per CU\n", per_cu); per_cu = 1; }
        (void)hipGetLastError();
        grid = cus;
    }
    if (grid < 0) return;
    (void)hipMemsetAsync((char*)d_ws + WS_CTL, 0, CTL_ZERO_BYTES, stream);
    Args a{};
    for (int i = 0; i < 19; ++i) a.in[i] = (const float*)d_in[i];
    a.out = (float*)d_out; a.ws = (unsigned char*)d_ws;
#if MK_N_LAUNCHES == 1
    a.ph_lo = 0; a.ph_hi = NPHASE; a.li = 0;
    hipLaunchKernelGGL(fwd_kernel, dim3(grid), dim3(NTHR), LDS_BYTES, stream, a);
#else
#ifndef DBG_LAST
#define DBG_LAST (NPHASE - 1)
#endif
    if (DBG_LAST < NPHASE - 1) (void)hipMemsetAsync(d_out, 0, (size_t)out_size * 4, stream);
    for (int li = 0; li <= DBG_LAST; ++li) { const int rep = 1; for (int r = 0; r < rep; ++r) { a.ph_lo = li; a.ph_hi = li + 1; a.li = 0; hipLaunchKernelGGL(fwd_kernel, dim3(grid), dim3(NTHR), LDS_BYTES, stream, a); } }
#ifdef DBG_DUMP
    hipLaunchKernelGGL(dbg_dump, dim3(2048), dim3(256), 0, stream, (const unsigned short*)((char*)d_ws + DBG_DUMP), (float*)d_out, (size_t)MT * DM);
#endif
#endif
}
```
